# Optimizing an MI355X kernel written in HIP

```python
import math
import jax, jax.numpy as jnp
from jax import lax
import numpy as np

D_MODEL = 1024
BATCH = 8
SEQ = 4096
DEPTH = 1

DA_HEADS = 4
DA_QK_DIM = 64
DA_V_DIM = 2 * DA_QK_DIM
DA_WIDTH = DA_HEADS * DA_V_DIM
ML_HEADS = 4
ML_DIM = 128
ML_WIDTH = ML_HEADS * ML_DIM
MIX_WIDTH = DA_WIDTH + ML_WIDTH
ROPE_THETA = 500000.0
ROPE_DIM = DA_QK_DIM // 4
D_FF = 2816
CONV_K = 4
CHUNK = 64
Q_BLOCK = 128
EPS = 1e-6
IN_SIZES = (2 * DA_HEADS * DA_QK_DIM,
            2 * DA_HEADS * DA_QK_DIM,
            DA_WIDTH,
            2 * ML_WIDTH,
            ML_WIDTH,
            ML_WIDTH,
            ML_HEADS,
            ML_HEADS)
N_IN = sum(IN_SIZES)
IN_SPLITS = tuple(int(s) for s in np.cumsum(IN_SIZES)[:-1])

kernel_name = "hybrid_diffattn_mlstm_macaron_adaln"


def rmsnorm(t, g):
    tf = t.astype(jnp.float32)
    tf = tf * lax.rsqrt(jnp.mean(tf * tf, axis=-1, keepdims=True) + EPS)
    return tf.astype(t.dtype) * g


def swiglu(h, w12, w3):
    a, b = jnp.split(h @ w12, 2, axis=-1)
    return (jax.nn.silu(a) * b) @ w3


def causal_conv(u, w, b):
    s = u.shape[1]
    up = jnp.pad(u, ((0, 0), (CONV_K - 1, 0), (0, 0)))
    out = b
    for j in range(CONV_K):
        out = out + up[:, j:j + s] * w[j]
    return out


def partial_rope(t, cos, sin):
    tr, tp = t[..., :ROPE_DIM], t[..., ROPE_DIM:]
    x1, x2 = jnp.split(tr, 2, axis=-1)
    rot = jnp.concatenate([-x2, x1], axis=-1)
    return jnp.concatenate([tr * cos + rot * sin, tp], axis=-1)


def diff_attention(q, k, v, g_q, g_k, lam_vecs, g_out, lambda_init):
    bsz, s, _ = q.shape
    q = rmsnorm(q.reshape(bsz, s, DA_HEADS, 2, DA_QK_DIM), g_q)
    k = rmsnorm(k.reshape(bsz, s, DA_HEADS, 2, DA_QK_DIM), g_k)
    pos = jnp.arange(s, dtype=jnp.float32)
    inv_freq = ROPE_THETA ** (-jnp.arange(0, ROPE_DIM, 2, dtype=jnp.float32) / ROPE_DIM)
    ang = pos[:, None] * inv_freq[None, :]
    ang = jnp.concatenate([ang, ang], axis=-1)[:, None, None, :]
    cos, sin = jnp.cos(ang).astype(q.dtype), jnp.sin(ang).astype(q.dtype)
    q = partial_rope(q, cos, sin).transpose(0, 2, 3, 1, 4)
    k = partial_rope(k, cos, sin).transpose(0, 2, 3, 1, 4)
    v = v.reshape(bsz, s, DA_HEADS, DA_V_DIM).transpose(0, 2, 1, 3)
    lv = lam_vecs.astype(jnp.float32)
    lam = jnp.exp(jnp.sum(lv[0] * lv[1])) - jnp.exp(jnp.sum(lv[2] * lv[3])) + lambda_init
    scale = DA_QK_DIM ** -0.5
    kpos = jnp.arange(s)

    def block(i):
        qs = lax.dynamic_slice_in_dim(q, i * Q_BLOCK, Q_BLOCK, axis=3)
        sc = jnp.einsum('bhcqd,bhckd->bhcqk', qs, k).astype(jnp.float32) * scale
        qpos = i * Q_BLOCK + jnp.arange(Q_BLOCK)
        sc = jnp.where(kpos[None, :] <= qpos[:, None], sc, -jnp.inf)
        p = jax.nn.softmax(sc, axis=-1)
        a = (p[:, :, 0] - lam * p[:, :, 1]).astype(v.dtype)
        return jnp.einsum('bhqk,bhkd->bhqd', a, v)

    o = lax.map(block, jnp.arange(s // Q_BLOCK))
    o = o.transpose(1, 0, 3, 2, 4).reshape(bsz, s, DA_HEADS, DA_V_DIM)
    o = rmsnorm(o, g_out) * (1.0 - lambda_init)
    return o.reshape(bsz, s, DA_WIDTH)


def mlstm(q, k, v, o_pre, i_pre, f_pre, g_out):
    dtype = q.dtype
    bsz, s, _ = q.shape
    nc = s // CHUNK

    def to_chunks(t):
        return t.astype(jnp.float32).reshape(bsz, nc, CHUNK, ML_HEADS, ML_DIM).transpose(1, 0, 3, 2, 4)

    def gates_to_chunks(t):
        return t.astype(jnp.float32).reshape(bsz, nc, CHUNK, ML_HEADS).transpose(1, 0, 3, 2)

    qc = to_chunks(q) * (ML_DIM ** -0.5)
    kc, vc = to_chunks(k), to_chunks(v)
    ic = gates_to_chunks(i_pre)
    fc = jax.nn.log_sigmoid(gates_to_chunks(f_pre))
    tri = jnp.arange(CHUNK)[:, None] >= jnp.arange(CHUNK)[None, :]

    def step(carry, inp):
        C, n, m = carry
        qb, kb, vb, ib, fb = inp
        b = jnp.cumsum(fb, axis=-1)
        D = jnp.where(tri, b[..., :, None] - b[..., None, :] + ib[..., None, :], -jnp.inf)
        inter = b + m[..., None]
        m_t = jnp.maximum(inter, jnp.max(D, axis=-1))
        W = jnp.einsum('bhtd,bhsd->bhts', qb, kb) * jnp.exp(D - m_t[..., None])
        e_inter = jnp.exp(inter - m_t)
        num = e_inter[..., None] * jnp.einsum('bhtd,bhde->bhte', qb, C) + jnp.einsum('bhts,bhse->bhte', W, vb)
        den = e_inter * jnp.einsum('bhtd,bhd->bht', qb, n) + jnp.sum(W, axis=-1)
        h = num / jnp.maximum(jnp.abs(den), jnp.exp(-m_t))[..., None]
        g = b[..., -1]
        a = g[..., None] - b + ib
        m_new = jnp.maximum(g + m, jnp.max(a, axis=-1))
        decay = jnp.exp(g + m - m_new)
        w = jnp.exp(a - m_new[..., None])
        C_new = decay[..., None, None] * C + jnp.einsum('bhs,bhsd,bhse->bhde', w, kb, vb)
        n_new = decay[..., None] * n + jnp.einsum('bhs,bhsd->bhd', w, kb)
        return (C_new, n_new, m_new), h

    init = (jnp.zeros((bsz, ML_HEADS, ML_DIM, ML_DIM), jnp.float32),
            jnp.zeros((bsz, ML_HEADS, ML_DIM), jnp.float32),
            jnp.zeros((bsz, ML_HEADS), jnp.float32))
    _, h = lax.scan(step, init, (qc, kc, vc, ic, fc))
    h = h.transpose(1, 0, 3, 2, 4).reshape(bsz, s, ML_HEADS, ML_DIM).astype(dtype)
    h = rmsnorm(h, 1.0).reshape(bsz, s, ML_WIDTH) * g_out
    return jax.nn.sigmoid(o_pre) * h


def token_mix(h, w_in, conv_w, conv_b, b_igate, b_fgate, g_qnorm, g_knorm,
              lambda_qk, g_da_out, g_ml_out, w_out, lambda_init):
    u = h @ w_in
    da_q, da_k, da_v, ml_qk, ml_v, ml_o, ml_i, ml_f = jnp.split(u, IN_SPLITS, axis=-1)
    y_da = diff_attention(da_q, da_k, da_v, g_qnorm, g_knorm, lambda_qk, g_da_out, lambda_init)
    ml_qk = jax.nn.silu(causal_conv(ml_qk, conv_w, conv_b))
    ml_q, ml_k = jnp.split(ml_qk, 2, axis=-1)
    y_ml = mlstm(ml_q, ml_k, ml_v, ml_o, ml_i + b_igate, ml_f + b_fgate, g_ml_out)
    return jnp.concatenate([y_da, y_ml], axis=-1) @ w_out


def setup_inputs(seed: int = 0) -> dict:
    key = jax.random.key(seed)
    ks = jax.random.split(key, 24)
    f32 = jnp.float32
    nrm = lambda k, shape, s: jax.random.normal(k, shape, f32) * s
    L = DEPTH
    return {
        "x": jax.random.normal(ks[0], (BATCH, SEQ, D_MODEL), f32),
        "c": jax.random.normal(ks[1], (BATCH, D_MODEL), f32),
        "w_ada": nrm(ks[2], (L, D_MODEL, 9 * D_MODEL), 0.1 * D_MODEL ** -0.5),
        "b_ada": nrm(ks[3], (L, 9 * D_MODEL), 0.02),
        "g_norm": 1.0 + nrm(ks[4], (L, 3, D_MODEL), 0.02),
        "ffn1_w12": nrm(ks[5], (L, D_MODEL, 2 * D_FF), D_MODEL ** -0.5),
        "ffn1_w3": nrm(ks[6], (L, D_FF, D_MODEL), D_FF ** -0.5),
        "w_in": nrm(ks[7], (L, D_MODEL, N_IN), D_MODEL ** -0.5),
        "conv_w": nrm(ks[8], (L, CONV_K, 2 * ML_WIDTH), CONV_K ** -0.5),
        "conv_b": nrm(ks[9], (L, 2 * ML_WIDTH), 0.02),
        "b_igate": nrm(ks[10], (L, ML_HEADS), 0.1),
        "b_fgate": 3.0 + 3.0 * jax.random.uniform(ks[11], (L, ML_HEADS), f32),
        "g_qnorm": 1.0 + nrm(ks[12], (L, DA_QK_DIM), 0.02),
        "g_knorm": 1.0 + nrm(ks[13], (L, DA_QK_DIM), 0.02),
        "lambda_qk": nrm(ks[14], (L, 4, DA_QK_DIM), 0.1),
        "g_da_out": 1.0 + nrm(ks[15], (L, DA_V_DIM), 0.02),
        "g_ml_out": 1.0 + nrm(ks[16], (L, ML_WIDTH), 0.02),
        "w_out": nrm(ks[17], (L, MIX_WIDTH, D_MODEL), MIX_WIDTH ** -0.5),
        "ffn2_w12": nrm(ks[18], (L, D_MODEL, 2 * D_FF), D_MODEL ** -0.5),
        "ffn2_w3": nrm(ks[19], (L, D_FF, D_MODEL), D_FF ** -0.5),
    }


def reference(x, c, w_ada, b_ada, g_norm, ffn1_w12, ffn1_w3, w_in, conv_w, conv_b,
              b_igate, b_fgate, g_qnorm, g_knorm, lambda_qk, g_da_out, g_ml_out,
              w_out, ffn2_w12, ffn2_w3):
    bsz = x.shape[0]
    cs = jax.nn.silu(c)
    for l in range(DEPTH):
        lambda_init = 0.8 - 0.6 * math.exp(-0.3 * l)
        mod = (cs @ w_ada[l] + b_ada[l]).reshape(bsz, 3, 3, D_MODEL)
        shift, scale, gate = mod[:, :, 0], mod[:, :, 1], mod[:, :, 2]

        h = rmsnorm(x, g_norm[l, 0]) * (1.0 + scale[:, 0, None]) + shift[:, 0, None]
        x = x + 0.5 * (1.0 + gate[:, 0, None]) * swiglu(h, ffn1_w12[l], ffn1_w3[l])

        h = rmsnorm(x, g_norm[l, 1]) * (1.0 + scale[:, 1, None]) + shift[:, 1, None]
        x = x + (1.0 + gate[:, 1, None]) * token_mix(
            h, w_in[l], conv_w[l], conv_b[l], b_igate[l], b_fgate[l], g_qnorm[l], g_knorm[l],
            lambda_qk[l], g_da_out[l], g_ml_out[l], w_out[l], lambda_init)

        h = rmsnorm(x, g_norm[l, 2]) * (1.0 + scale[:, 2, None]) + shift[:, 2, None]
        x = x + 0.5 * (1.0 + gate[:, 2, None]) * swiglu(h, ffn2_w12[l], ffn2_w3[l])
    return x
```

```cpp
#include <hip/hip_runtime.h>
#include <hip/hip_cooperative_groups.h>
#include <cstdio>
#include <cstdint>
__device__ __forceinline__ int __tid_l() { int t = threadIdx.x; asm volatile("" : "+v"(t)); return t; }
namespace pg8 {
#define PG8_LAS __attribute__((address_space(3)))
typedef unsigned short bf16_t;
typedef short bf16x8 __attribute__((ext_vector_type(8)));
typedef float f32x4 __attribute__((ext_vector_type(4)));
typedef unsigned u32x4 __attribute__((ext_vector_type(4)));
constexpr int BM = 256, BK = 64, HALF = 128, HTB = HALF * BK * 2  , STAGE_BYTES = 8 * HTB, NXCD = 8, WGM = 8;

__host__ __device__ __forceinline__ int lds_byte(int r, int c) { const int st = (r >> 4) * 2 + (c >> 5), rr = r & 15, cc = c & 31, ob = rr * 64 + cc * 2; return st * 1024 + (ob ^ (((ob >> 9) & 1) << 5)); }
__host__ __device__ __forceinline__ void stage_rc(int b, int& R, int& C) { const int st = b / 1024, sb = b % 1024, swz = sb ^ (((sb >> 9) & 1) << 5); R = (st >> 1) * 16 + swz / 64; C = (st & 1) * 32 + (swz % 64) / 2; }
__host__ __device__ __forceinline__ int perm32(int rho) { const int n = rho >> 4, i = rho & 15; return 8 * (i >> 2) + 4 * n + (i & 3); }

struct Unit { int pm, pn; };
struct Gemm { const bf16_t* A; const bf16_t* Bt; int M, N, K; };

struct StaticOrder {
    int nM, nN, nwg, G, c;
    __host__ __device__ void init(int M, int N, int G_, int c_) { nM = M / BM; nN = N / BM; nwg = nM * nN; G = G_; c = c_; }
    __host__ __device__ bool next(int i, Unit& u) const {
        const long L = (long)i * G + c; if (L >= nwg) return false;
        int wgid = (int)L; { const int q = nwg / NXCD, r = nwg % NXCD, xcd = wgid % NXCD, off = wgid / NXCD; wgid = (xcd < r ? xcd * (q + 1) : r * (q + 1) + (xcd - r) * q) + off; }
        const int nig = WGM * nN, gid = wgid / nig, fm = gid * WGM, gsz = (nM - fm) < WGM ? (nM - fm) : WGM;
        u.pm = fm + ((wgid % nig) % gsz); u.pn = (wgid % nig) / gsz; return true;
    }
    __device__ __forceinline__ void a_ready(const Unit&) const {}
    __device__ __forceinline__ void done(const Unit&) const {}
};

__device__ __forceinline__ unsigned cvt_pk_bf16(float lo, float hi) { unsigned r; asm volatile("v_cvt_pk_bf16_f32 %0, %1, %2" : "=v"(r) : "v"(lo), "v"(hi)); return r; }
__device__ __forceinline__ f32x4 silu4(f32x4 x) {
    f32x4 r;
#pragma unroll
    for (int i = 0; i < 4; ++i) r[i] = x[i] * __builtin_amdgcn_rcpf(1.0f + __builtin_amdgcn_exp2f(-1.4426950408889634f * x[i]));
    return r;
}
struct EpiSwiGLU {
    static constexpr bool PERM = true, AFTER_DRAIN = false;
    bf16_t* O; int ldo;
    __device__ __forceinline__ void operator()(const f32x4 (&acc)[2][2][4][2], const Unit& u, int wr, int wc, int fr, int fq) const {
        const int row0 = u.pm * BM + wr * 64 + fr, col0 = u.pn * HALF + wc * 32 + 8 * fq;
#pragma unroll
        for (int ai = 0; ai < 2; ++ai)
#pragma unroll
            for (int m = 0; m < 4; ++m) {
                bf16_t* p = O + (size_t)(row0 + ai * HALF + m * 16) * ldo + col0;
                const f32x4 h0 = silu4(acc[ai][0][m][0]) * acc[ai][1][m][0], h1 = silu4(acc[ai][0][m][1]) * acc[ai][1][m][1];
                u32x4 w; w.x = cvt_pk_bf16(h0[0], h0[1]); w.y = cvt_pk_bf16(h0[2], h0[3]); w.z = cvt_pk_bf16(h1[0], h1[1]); w.w = cvt_pk_bf16(h1[2], h1[3]);
                *(u32x4*)p = w;
            }
    }
};
template <int BT, int OT>
struct EpiResid {
    static constexpr bool PERM = true, AFTER_DRAIN = false;
    const void* base; void* out; const float* gate; float gs;
    __device__ __forceinline__ void operator()(const f32x4 (&acc)[2][2][4][2], const Unit& u, int wr, int wc, int fr, int fq) const {
        const int row0 = u.pm * BM + wr * 64 + fr, col0 = u.pn * BM + wc * 32 + 8 * fq;
        const float* gp = gate + (size_t)(u.pm >> 4) * 9216 + col0;
        f32x4 gv[2][2];
#pragma unroll
        for (int bj = 0; bj < 2; ++bj)
#pragma unroll
            for (int n = 0; n < 2; ++n) gv[bj][n] = (*(const f32x4*)(gp + bj * HALF + 4 * n) + 1.0f) * gs;
#pragma unroll
        for (int ai = 0; ai < 2; ++ai) {
            f32x4 pre[4][2][2];
#pragma unroll
            for (int m = 0; m < 4; ++m) { const size_t off = (size_t)(row0 + ai * HALF + m * 16) * 1024 + col0;
#pragma unroll
                for (int bj = 0; bj < 2; ++bj) {
                    if (BT == 0) { pre[m][bj][0] = *(const f32x4*)((const float*)base + off + bj * HALF); pre[m][bj][1] = *(const f32x4*)((const float*)base + off + bj * HALF + 4); }
                    else { const u32x4 w = *(const u32x4*)((const bf16_t*)base + off + bj * HALF);
                        pre[m][bj][0] = (f32x4){__builtin_bit_cast(float, w.x << 16), __builtin_bit_cast(float, w.x & 0xffff0000u), __builtin_bit_cast(float, w.y << 16), __builtin_bit_cast(float, w.y & 0xffff0000u)};
                        pre[m][bj][1] = (f32x4){__builtin_bit_cast(float, w.z << 16), __builtin_bit_cast(float, w.z & 0xffff0000u), __builtin_bit_cast(float, w.w << 16), __builtin_bit_cast(float, w.w & 0xffff0000u)}; } } }
            asm volatile("" ::: "memory");
#pragma unroll
            for (int m = 0; m < 4; ++m) { const size_t off = (size_t)(row0 + ai * HALF + m * 16) * 1024 + col0;
#pragma unroll
                for (int bj = 0; bj < 2; ++bj) { const f32x4 o0 = pre[m][bj][0] + gv[bj][0] * acc[ai][bj][m][0], o1 = pre[m][bj][1] + gv[bj][1] * acc[ai][bj][m][1];
                    if (OT == 0) { *(f32x4*)((float*)out + off + bj * HALF) = o0; *(f32x4*)((float*)out + off + bj * HALF + 4) = o1; }
                    else { u32x4 w; w.x = cvt_pk_bf16(o0[0], o0[1]); w.y = cvt_pk_bf16(o0[2], o0[3]); w.z = cvt_pk_bf16(o1[0], o1[1]); w.w = cvt_pk_bf16(o1[2], o1[3]); *(u32x4*)((bf16_t*)out + off + bj * HALF) = w; } } }
            asm volatile("" ::: "memory");
        }
    }
};
struct EpiResidXg {
    static constexpr bool PERM = true, AFTER_DRAIN = false;
    const bf16_t* base; bf16_t* out; const float* gate; float gs; bf16_t* xg; const float* gn; const float* scn; float* rss;
    __device__ __forceinline__ void operator()(const f32x4 (&acc)[2][2][4][2], const Unit& u, int wr, int wc, int fr, int fq) const {
        const int row0 = u.pm * BM + wr * 64 + fr, col0 = u.pn * BM + wc * 32 + 8 * fq;
        const float* gp = gate + (size_t)(u.pm >> 4) * 9216 + col0; const float* sp = scn + (size_t)(u.pm >> 4) * 9216 + col0;
        f32x4 gv[2][2], gsn[2][2];
#pragma unroll
        for (int bj = 0; bj < 2; ++bj)
#pragma unroll
            for (int n = 0; n < 2; ++n) { gv[bj][n] = (*(const f32x4*)(gp + bj * HALF + 4 * n) + 1.0f) * gs; gsn[bj][n] = *(const f32x4*)(gn + col0 + bj * HALF + 4 * n) * (*(const f32x4*)(sp + bj * HALF + 4 * n) + 1.0f); }
#pragma unroll
        for (int ai = 0; ai < 2; ++ai)
#pragma unroll
        for (int mb = 0; mb < 4; mb += 2) {
            u32x4 prb[2][2];
#pragma unroll
            for (int mm = 0; mm < 2; ++mm) { const size_t off = (size_t)(row0 + ai * HALF + (mb + mm) * 16) * 1024 + col0;
#pragma unroll
                for (int bj = 0; bj < 2; ++bj) prb[mm][bj] = *(const u32x4*)(base + off + bj * HALF); }
            asm volatile("" ::: "memory");
#pragma unroll
            for (int mm = 0; mm < 2; ++mm) { const int m = mb + mm; const int row = row0 + ai * HALF + m * 16; const size_t off = (size_t)row * 1024 + col0; float ss = 0.f;
#pragma unroll
                for (int bj = 0; bj < 2; ++bj) { const u32x4 w = prb[mm][bj];
                    const f32x4 p0 = (f32x4){__builtin_bit_cast(float, w.x << 16), __builtin_bit_cast(float, w.x & 0xffff0000u), __builtin_bit_cast(float, w.y << 16), __builtin_bit_cast(float, w.y & 0xffff0000u)};
                    const f32x4 p1 = (f32x4){__builtin_bit_cast(float, w.z << 16), __builtin_bit_cast(float, w.z & 0xffff0000u), __builtin_bit_cast(float, w.w << 16), __builtin_bit_cast(float, w.w & 0xffff0000u)};
                    const f32x4 o0 = p0 + gv[bj][0] * acc[ai][bj][m][0], o1 = p1 + gv[bj][1] * acc[ai][bj][m][1];
                    u32x4 xo; xo.x = cvt_pk_bf16(o0[0], o0[1]); xo.y = cvt_pk_bf16(o0[2], o0[3]); xo.z = cvt_pk_bf16(o1[0], o1[1]); xo.w = cvt_pk_bf16(o1[2], o1[3]); *(u32x4*)(out + off + bj * HALF) = xo;
                    const f32x4 g0 = o0 * gsn[bj][0], g1 = o1 * gsn[bj][1];
                    u32x4 xw; xw.x = cvt_pk_bf16(g0[0], g0[1]); xw.y = cvt_pk_bf16(g0[2], g0[3]); xw.z = cvt_pk_bf16(g1[0], g1[1]); xw.w = cvt_pk_bf16(g1[2], g1[3]); *(u32x4*)(xg + off + bj * HALF) = xw;
                    ss += ((o0[0] * o0[0] + o0[1] * o0[1]) + (o0[2] * o0[2] + o0[3] * o0[3])) + ((o1[0] * o1[0] + o1[1] * o1[1]) + (o1[2] * o1[2] + o1[3] * o1[3])); }
                ss += __shfl_xor(ss, 16); ss += __shfl_xor(ss, 32);
                if (fq == 0) atomicAdd(rss + row, ss); }
            asm volatile("" ::: "memory");
        }
    }
};
struct EpiSwiGLUN {
    static constexpr bool PERM = true, AFTER_DRAIN = false;
    bf16_t* O; int ldo; const float* rss; const float* sb; int nphys;
    __device__ __forceinline__ void operator()(const f32x4 (&acc)[2][2][4][2], const Unit& u, int wr, int wc, int fr, int fq) const {
        const int row0 = u.pm * BM + wr * 64 + fr, col0 = u.pn * HALF + wc * 32 + 8 * fq;
        const float* sp = sb + (size_t)(u.pm >> 4) * nphys + u.pn * BM + wc * 32 + 8 * fq;
        f32x4 sv[2][2];
#pragma unroll
        for (int bj = 0; bj < 2; ++bj)
#pragma unroll
            for (int n = 0; n < 2; ++n) sv[bj][n] = *(const f32x4*)(sp + bj * HALF + 4 * n);
        float rinv[2][4];
#pragma unroll
        for (int ai = 0; ai < 2; ++ai)
#pragma unroll
            for (int m = 0; m < 4; ++m) rinv[ai][m] = __builtin_amdgcn_rsqf(rss[row0 + ai * HALF + m * 16] * (1.0f / 1024.0f) + 1e-6f);
#pragma unroll
        for (int ai = 0; ai < 2; ++ai)
#pragma unroll
            for (int m = 0; m < 4; ++m) {
                bf16_t* p = O + (size_t)(row0 + ai * HALF + m * 16) * ldo + col0; const float ri = rinv[ai][m];
                const f32x4 h0 = silu4(acc[ai][0][m][0] * ri + sv[0][0]) * (acc[ai][1][m][0] * ri + sv[1][0]), h1 = silu4(acc[ai][0][m][1] * ri + sv[0][1]) * (acc[ai][1][m][1] * ri + sv[1][1]);
                u32x4 w; w.x = cvt_pk_bf16(h0[0], h0[1]); w.y = cvt_pk_bf16(h0[2], h0[3]); w.z = cvt_pk_bf16(h1[0], h1[1]); w.w = cvt_pk_bf16(h1[2], h1[3]);
                *(u32x4*)p = w;
            }
    }
};
struct EpiMix {
    static constexpr bool PERM = true, AFTER_DRAIN = false;
    bf16_t *Q, *K, *V, *MLQK, *MLV, *MLO; const float *gq, *gk, *rope; float c2;
    __device__ __forceinline__ void operator()(const f32x4 (&acc)[2][2][4][2], const Unit& u, int wr, int wc, int fr, int fq) const {
        const int pn = u.pn, row0 = u.pm * BM + wr * 64 + fr;
        if (pn < 4) {
            const bool isq = pn < 2; const int grp = (pn & 1) * 4 + wc;
            bf16_t* dst = (isq ? Q : K) + grp * 64 + 8 * fq; const float* gvec = isq ? gq : gk; const float sc = isq ? c2 : 1.0f;
            f32x4 gv[2][2];
#pragma unroll
            for (int bj = 0; bj < 2; ++bj)
#pragma unroll
                for (int n = 0; n < 2; ++n) gv[bj][n] = *(const f32x4*)(gvec + 32 * bj + 8 * fq + 4 * n) * sc;
#pragma unroll
            for (int ai = 0; ai < 2; ++ai) {
                f32x4 cs[4][2][2];
#pragma unroll
                for (int m = 0; m < 4; ++m)
#pragma unroll
                    for (int n = 0; n < 2; ++n) { cs[m][n][0] = (f32x4){1.f, 0.f, 1.f, 0.f}; cs[m][n][1] = (f32x4){1.f, 0.f, 1.f, 0.f}; }
                if (fq < 2) {
#pragma unroll
                    for (int m = 0; m < 4; ++m) { const int pos = (row0 + ai * HALF + m * 16) & 4095;
#pragma unroll
                        for (int n = 0; n < 2; ++n) { cs[m][n][0] = *(const f32x4*)(rope + (size_t)pos * 16 + n * 8); cs[m][n][1] = *(const f32x4*)(rope + (size_t)pos * 16 + n * 8 + 4); } }
                }
#pragma unroll
                for (int m = 0; m < 4; ++m) {
                    const int row = row0 + ai * HALF + m * 16;
                    float ss = 0.f;
#pragma unroll
                    for (int bj = 0; bj < 2; ++bj)
#pragma unroll
                        for (int n = 0; n < 2; ++n) { const f32x4 x = acc[ai][bj][m][n]; ss += (x[0] * x[0] + x[1] * x[1]) + (x[2] * x[2] + x[3] * x[3]); }
                    ss += __shfl_xor(ss, 16); ss += __shfl_xor(ss, 32);
                    const float rinv = 1.0f / sqrtf(ss * (1.0f / 64.0f) + 1e-6f);
                    f32x4 v[2][2];
#pragma unroll
                    for (int bj = 0; bj < 2; ++bj)
#pragma unroll
                        for (int n = 0; n < 2; ++n) v[bj][n] = acc[ai][bj][m][n] * rinv * gv[bj][n];
                    const float sg = (fq == 0) ? -1.0f : 1.0f;
#pragma unroll
                    for (int n = 0; n < 2; ++n) {
                        const f32x4 x = v[0][n]; f32x4 pr;
#pragma unroll
                        for (int e = 0; e < 4; ++e) pr[e] = __shfl_xor(x[e], 16);
                        const f32x4 cs0 = cs[m][n][0], cs1 = cs[m][n][1];
                        f32x4 o;
                        o[0] = x[0] * cs0[0] + sg * pr[0] * cs0[1]; o[1] = x[1] * cs0[2] + sg * pr[1] * cs0[3];
                        o[2] = x[2] * cs1[0] + sg * pr[2] * cs1[1]; o[3] = x[3] * cs1[2] + sg * pr[3] * cs1[3];
                        v[0][n] = o;
                    }
#pragma unroll
                    for (int bj = 0; bj < 2; ++bj) {
                        u32x4 w; w.x = cvt_pk_bf16(v[bj][0][0], v[bj][0][1]); w.y = cvt_pk_bf16(v[bj][0][2], v[bj][0][3]); w.z = cvt_pk_bf16(v[bj][1][0], v[bj][1][1]); w.w = cvt_pk_bf16(v[bj][1][2], v[bj][1][3]);
                        *(u32x4*)(dst + (size_t)row * 512 + 32 * bj) = w;
                    }
                }
                asm volatile("" ::: "memory");
            }
        } else {
            bf16_t* dst; int ld; const int lc = 64 * wc + 8 * fq;
            if (pn < 6) { dst = V + (pn - 4) * 256 + lc; ld = 512; }
            else if (pn < 10) { dst = MLQK + (pn - 6) * 256 + lc; ld = 1024; }
            else if (pn < 12) { dst = MLV + (pn - 10) * 256 + lc; ld = 512; }
            else { dst = MLO + (pn - 12) * 256 + lc; ld = 512; }
#pragma unroll
            for (int ai = 0; ai < 2; ++ai)
#pragma unroll
                for (int m = 0; m < 4; ++m) {
                    bf16_t* p = dst + (size_t)(row0 + ai * HALF + m * 16) * ld;
#pragma unroll
                    for (int bj = 0; bj < 2; ++bj) {
                        const f32x4 a = acc[ai][bj][m][0], b = acc[ai][bj][m][1];
                        u32x4 w; w.x = cvt_pk_bf16(a[0], a[1]); w.y = cvt_pk_bf16(a[2], a[3]); w.z = cvt_pk_bf16(b[0], b[1]); w.w = cvt_pk_bf16(b[2], b[3]);
                        *(u32x4*)(p + 32 * bj) = w;
                    }
                }
        }
    }
};
template <class Epi, class Sched, bool ALIGN_EPI = false, bool SP2 = false>
__device__ __forceinline__ void gemm_phase(PG8_LAS unsigned char* lds, const Gemm g, const Sched& S, const Epi& E) {
    const int tid = __tid_l(), wid = __builtin_amdgcn_readfirstlane(tid >> 6), lane = tid & 63, wr = wid >> 2, wc = wid & 3, fr = lane & 15, fq = lane >> 4;
    const int K = g.K, nt = K / BK;
    unsigned voffA[2], voffB[2];
#pragma unroll
    for (int i = 0; i < 2; ++i) { int R, C; stage_rc(tid * 16 + i * 8192, R, C); const int Rb = Epi::PERM ? ((R & ~31) + perm32(R & 31)) : R;
        voffA[i] = (unsigned)(R * K + C) * 2u; voffB[i] = (unsigned)(Rb * K + C) * 2u; }
    const size_t kstep = (size_t)(BK * 2);
    const size_t hstep = (size_t)HALF * K * 2;
    const size_t tstep = 2 * hstep;
    const unsigned ldsw = (unsigned)wid * 1024u;
    const int aoff = lds_byte(wr * 64 + fr, fq * 8), boff = lds_byte(wc * 32 + fr, fq * 8);
#define PG8_SA(b, h) (((b) * 2 + (h)) * HTB)
#define PG8_SB(b, h) ((4 + (b) * 2 + (h)) * HTB)
#define PG8_STAGE(bufoff, gbase, voff) do { _Pragma("unroll") for (int _i = 0; _i < 2; ++_i) \
        __builtin_amdgcn_global_load_lds((const unsigned*)((const char*)(gbase) + (voff)[_i]), (PG8_LAS unsigned*)(lds + (bufoff) + ldsw + _i * 8192), 16, 0, 0); } while (0)
#define PG8_LDA(dst, b, h) do { _Pragma("unroll") for (int m = 0; m < 4; ++m) _Pragma("unroll") for (int k = 0; k < 2; ++k) dst[m][k] = *(const PG8_LAS bf16x8*)(lds + PG8_SA(b, h) + aoff + m * 2048 + k * 1024); } while (0)
#define PG8_LDB(dst, b, h) do { _Pragma("unroll") for (int n = 0; n < 2; ++n) _Pragma("unroll") for (int k = 0; k < 2; ++k) dst[n][k] = *(const PG8_LAS bf16x8*)(lds + PG8_SB(b, h) + boff + n * 2048 + k * 1024); } while (0)
#define PG8_MMA(ai, bj, At, Bt) do { __builtin_amdgcn_s_setprio(1); _Pragma("unroll") for (int m = 0; m < 4; ++m) _Pragma("unroll") for (int n = 0; n < 2; ++n) _Pragma("unroll") for (int k = 0; k < 2; ++k) \
        acc[ai][bj][m][n] = __builtin_amdgcn_mfma_f32_16x16x32_bf16(Bt[n][k], At[m][k], acc[ai][bj][m][n], 0, 0, 0); __builtin_amdgcn_s_setprio(0); } while (0)
#define PG8_WAIT_V(n) asm volatile("s_waitcnt vmcnt(" #n ")" ::: "memory")
#define PG8_WAIT_L(n) asm volatile("s_waitcnt lgkmcnt(" #n ")" ::: "memory")
#define PG8_BAR __builtin_amdgcn_s_barrier()
#define PG8_SCHED __builtin_amdgcn_sched_barrier(0)
    Unit cur, nxt; int ui = 0;
    if (!S.next(0, cur)) return;
    f32x4 acc[2][2][4][2];
#pragma unroll
    for (int a = 0; a < 2; ++a)
#pragma unroll
        for (int b = 0; b < 2; ++b)
#pragma unroll
            for (int m = 0; m < 4; ++m)
#pragma unroll
                for (int n = 0; n < 2; ++n) acc[a][b][m][n] = (f32x4){0.f, 0.f, 0.f, 0.f};
    bf16x8 At[4][2], B0[2][2], B1[2][2];
    const char* cA = (const char*)g.A + (size_t)cur.pm * tstep; const char* cB = (const char*)g.Bt + (size_t)cur.pn * tstep;
    S.a_ready(cur);
    if constexpr (SP2) {
        PG8_STAGE(PG8_SB(0, 0), cB, voffB); PG8_STAGE(PG8_SB(0, 1), cB + hstep, voffB); PG8_STAGE(PG8_SA(0, 0), cA, voffA); PG8_STAGE(PG8_SA(0, 1), cA + hstep, voffA);
        if (wr == 1) PG8_BAR;
        PG8_WAIT_V(2); PG8_BAR;
        PG8_STAGE(PG8_SB(1, 0), cB + kstep, voffB); PG8_STAGE(PG8_SA(1, 0), cA + kstep, voffA); PG8_STAGE(PG8_SB(1, 1), cB + hstep + kstep, voffB);
        PG8_WAIT_V(6); PG8_BAR;
    } else {
        PG8_STAGE(PG8_SB(0, 0), cB, voffB); PG8_STAGE(PG8_SA(0, 0), cA, voffA); PG8_STAGE(PG8_SB(0, 1), cB + hstep, voffB); PG8_STAGE(PG8_SA(0, 1), cA + hstep, voffA);
        if (wr == 1) PG8_BAR;
        PG8_WAIT_V(4); PG8_BAR;
        PG8_STAGE(PG8_SB(1, 0), cB + kstep, voffB); PG8_STAGE(PG8_SA(1, 0), cA + kstep, voffA); PG8_STAGE(PG8_SB(1, 1), cB + hstep + kstep, voffB);
        PG8_WAIT_V(6); PG8_BAR;
    }
    for (;;) {
        const bool has_next = S.next(ui + 1, nxt);
        const char* nA = has_next ? (const char*)g.A + (size_t)nxt.pm * tstep : cA; const char* nB = has_next ? (const char*)g.Bt + (size_t)nxt.pn * tstep : cB;
        for (int t = 0; t < nt; t += 2) {
            const bool last = (t == nt - 2);
            const char* a1 = cA + (size_t)(t + 1) * kstep;
            const char* a2 = last ? nA : cA + (size_t)(t + 2) * kstep; const char* b2 = last ? nB : cB + (size_t)(t + 2) * kstep;
            const char* a3 = a2 + kstep; const char* b3 = b2 + kstep;
            if (last && has_next) S.a_ready(nxt);
            if constexpr (SP2) {
            PG8_LDB(B0, 0, 0); PG8_LDB(B1, 0, 1); PG8_SCHED; PG8_LDA(At, 0, 0); PG8_STAGE(PG8_SA(1, 1), a1 + hstep, voffA);
            PG8_WAIT_V(8); PG8_WAIT_L(0); PG8_BAR; PG8_MMA(0, 0, At, B0); PG8_MMA(0, 1, At, B1); PG8_BAR; PG8_SCHED;
            PG8_LDA(At, 0, 1); PG8_STAGE(PG8_SB(0, 0), b2, voffB); PG8_STAGE(PG8_SB(0, 1), b2 + hstep, voffB); PG8_STAGE(PG8_SA(0, 0), a2, voffA);
            PG8_WAIT_V(8); PG8_WAIT_L(0); PG8_BAR; PG8_MMA(1, 0, At, B0); PG8_MMA(1, 1, At, B1); PG8_BAR; PG8_SCHED;
            PG8_LDB(B0, 1, 0); PG8_LDB(B1, 1, 1); PG8_SCHED; PG8_LDA(At, 1, 0); PG8_STAGE(PG8_SA(0, 1), a2 + hstep, voffA);
            PG8_WAIT_V(8); PG8_WAIT_L(0); PG8_BAR; PG8_MMA(0, 0, At, B0); PG8_MMA(0, 1, At, B1); PG8_BAR; PG8_SCHED;
            PG8_LDA(At, 1, 1); PG8_STAGE(PG8_SB(1, 0), b3, voffB); PG8_STAGE(PG8_SB(1, 1), b3 + hstep, voffB); PG8_STAGE(PG8_SA(1, 0), a3, voffA);
            PG8_WAIT_V(8); PG8_WAIT_L(0); PG8_BAR; PG8_MMA(1, 0, At, B0); PG8_MMA(1, 1, At, B1); PG8_BAR; PG8_SCHED;
            } else {
            PG8_LDB(B0, 0, 0); PG8_SCHED; PG8_LDA(At, 0, 0); PG8_STAGE(PG8_SA(1, 1), a1 + hstep, voffA);
            PG8_WAIT_L(8); PG8_BAR; PG8_WAIT_L(0); PG8_MMA(0, 0, At, B0); PG8_BAR; PG8_SCHED;
            PG8_LDB(B1, 0, 1); PG8_STAGE(PG8_SB(0, 0), b2, voffB);
            PG8_BAR; PG8_WAIT_L(0); PG8_MMA(0, 1, At, B1); PG8_BAR;
            PG8_LDA(At, 0, 1); PG8_STAGE(PG8_SA(0, 0), a2, voffA);
            PG8_BAR; PG8_WAIT_L(0); PG8_MMA(1, 0, At, B0); PG8_BAR; PG8_SCHED;
            PG8_STAGE(PG8_SB(0, 1), b2 + hstep, voffB);
            PG8_WAIT_V(6); PG8_BAR; PG8_MMA(1, 1, At, B1); PG8_BAR;
            PG8_LDB(B0, 1, 0); PG8_SCHED; PG8_LDA(At, 1, 0); PG8_STAGE(PG8_SA(0, 1), a2 + hstep, voffA);
            PG8_WAIT_L(8); PG8_BAR; PG8_WAIT_L(0); PG8_MMA(0, 0, At, B0); PG8_BAR; PG8_SCHED;
            PG8_LDB(B1, 1, 1); PG8_STAGE(PG8_SB(1, 0), b3, voffB);
            PG8_BAR; PG8_WAIT_L(0); PG8_MMA(0, 1, At, B1); PG8_BAR;
            PG8_LDA(At, 1, 1); PG8_STAGE(PG8_SA(1, 0), a3, voffA);
            PG8_BAR; PG8_WAIT_L(0); PG8_MMA(1, 0, At, B0); PG8_BAR; PG8_SCHED;
            PG8_STAGE(PG8_SB(1, 1), b3 + hstep, voffB);
            PG8_WAIT_V(6); PG8_BAR; PG8_MMA(1, 1, At, B1); PG8_BAR;
            }
        }
        if constexpr (ALIGN_EPI) { if (wr == 0) PG8_BAR; }
        if constexpr (!Epi::AFTER_DRAIN) { E(acc, cur, wr, wc, fr, fq); S.done(cur); }
        if (!has_next) break;
#pragma unroll
        for (int a = 0; a < 2; ++a)
#pragma unroll
            for (int b = 0; b < 2; ++b)
#pragma unroll
                for (int m = 0; m < 4; ++m)
#pragma unroll
                    for (int n = 0; n < 2; ++n) acc[a][b][m][n] = (f32x4){0.f, 0.f, 0.f, 0.f};
        cur = nxt; cA = nA; cB = nB; ++ui;
        if constexpr (ALIGN_EPI) { if (wr == 1) PG8_BAR; }
    }
    PG8_WAIT_V(0);
    if constexpr (!ALIGN_EPI) { if (wr == 0) PG8_BAR; }
    PG8_BAR;
    if constexpr (Epi::AFTER_DRAIN) { E.fused(acc, cur, wr, wc, fr, fq, lds, wid, lane); S.done(cur); }
#undef PG8_SA
#undef PG8_SB
#undef PG8_STAGE
#undef PG8_LDA
#undef PG8_LDB
#undef PG8_MMA
#undef PG8_WAIT_V
#undef PG8_WAIT_L
#undef PG8_BAR
#undef PG8_SCHED
}
}
#include <hip/hip_bf16.h>
#include <cmath>
namespace attn_body {
using bf16=__hip_bfloat16;
using bf16x8=__attribute__((ext_vector_type(8)))short;
using s16x4=__attribute__((ext_vector_type(4)))short;
using f32x16=__attribute__((ext_vector_type(16)))float;
using u32x4=__attribute__((ext_vector_type(4)))unsigned;
constexpr int BATCH=8,NHEAD=16,SEQ=4096,D=64,DM=NHEAD*D,QP=512,KP=512,VP=512,OP=1024;
constexpr int NW=8,QBLK=32,QB=QBLK*NW,KVBLK=64,NQB=SEQ/QB;
constexpr int ATTN_PITCH=DM, ATTN_UNIT_ROWS=QB;
__device__ __forceinline__ int crow(int r,int hi){return (r&3)+8*(r>>2)+4*hi;}
#define SBAR() __builtin_amdgcn_sched_barrier(0)
__device__ __forceinline__ void cmask(f32x16&p0,f32x16&p1,int jb,int qrel,int hi){
  const float NEG=-INFINITY; int kb=64*jb+4*hi;
  #pragma unroll
  for(int r=0;r<16;++r){int kv=kb+(r&3)+8*(r>>2); if(kv>qrel)p0[r]=NEG; if(kv+32>qrel)p1[r]=NEG;}
}

constexpr int NSLOT=3, SLOTB=8192;
constexpr int LDS_K=0, LDS_V=NSLOT*SLOTB, LDS_WS=2*NSLOT*SLOTB, LDS_OST=LDS_WS+NW*64*4, LDS_BYTES=LDS_OST+NW*4096;
constexpr float C2=0.125f*1.4426950408889634f;
__device__ __forceinline__ void glds16(const void*gsrc,unsigned lds_dst){unsigned keep;
  asm volatile("s_mov_b32 %0, m0\n\ts_mov_b32 m0, %2\n\ts_nop 0\n\tglobal_load_lds_dwordx4 %1, off\n\ts_mov_b32 m0, %0":"=&s"(keep):"v"(gsrc),"s"(lds_dst):"memory");}
__device__ __forceinline__ float max3f(float a,float b,float c){float r;asm("v_max3_f32 %0, %1, %2, %3":"=v"(r):"v"(a),"v"(b),"v"(c));return r;}
__device__ __forceinline__ float max2f(float a,float b){float r;asm("v_max_f32_e32 %0, %1, %2":"=v"(r):"v"(a),"v"(b));return r;}
__device__ __forceinline__ float fadd_s(float a,float b){float r;asm("v_add_f32_e32 %0, %1, %2":"=v"(r):"v"(a),"v"(b));return r;}
__device__ __forceinline__ float fsub_s(float a,float b){float r;asm("v_sub_f32_e32 %0, %1, %2":"=v"(r):"v"(a),"v"(b));return r;}
typedef float f32x2_t __attribute__((ext_vector_type(2))); typedef __bf16 bf16x2_t __attribute__((ext_vector_type(2)));
__device__ __forceinline__ unsigned cvtpk_s(float lo,float hi){f32x2_t v={lo,hi};bf16x2_t b=__builtin_convertvector(v,bf16x2_t);return __builtin_bit_cast(unsigned,b);}
#define WAIT_BAR(N) asm volatile("s_waitcnt vmcnt(" #N ") lgkmcnt(0)\n\ts_barrier":::"memory")

__device__ __forceinline__ void qkt(f32x16&p0,f32x16&p1,const char*Kslot,const bf16x8*qr,const f32x16&negm,int r32,int hi){
  const char*kb=Kslot+hi*1024+r32*16;
  #pragma unroll
  for(int d0=0;d0<4;++d0){
    const bf16x8 b0=*reinterpret_cast<const bf16x8*>(kb+d0*2048);
    const bf16x8 b1=*reinterpret_cast<const bf16x8*>(kb+d0*2048+512);
    if(d0==0){p0=__builtin_amdgcn_mfma_f32_32x32x16_bf16(b0,qr[0],negm,0,0,0);p1=__builtin_amdgcn_mfma_f32_32x32x16_bf16(b1,qr[0],negm,0,0,0);}
    else{p0=__builtin_amdgcn_mfma_f32_32x32x16_bf16(b0,qr[d0],p0,0,0,0);p1=__builtin_amdgcn_mfma_f32_32x32x16_bf16(b1,qr[d0],p1,0,0,0);}}
}
typedef __attribute__((address_space(3))) const char* lds_cptr;
typedef short v4i16_t __attribute__((ext_vector_type(4)));
__device__ __forceinline__ void kload8(bf16x8*kf,lds_cptr kp){
  kf[0]=*(const __attribute__((address_space(3))) bf16x8*)(kp);      kf[1]=*(const __attribute__((address_space(3))) bf16x8*)(kp+512);
  kf[2]=*(const __attribute__((address_space(3))) bf16x8*)(kp+2048); kf[3]=*(const __attribute__((address_space(3))) bf16x8*)(kp+2560);
  kf[4]=*(const __attribute__((address_space(3))) bf16x8*)(kp+4096); kf[5]=*(const __attribute__((address_space(3))) bf16x8*)(kp+4608);
  kf[6]=*(const __attribute__((address_space(3))) bf16x8*)(kp+6144); kf[7]=*(const __attribute__((address_space(3))) bf16x8*)(kp+6656);
}
__device__ __forceinline__ void kload2(bf16x8*kf,lds_cptr kp,int j){ kf[2*j]=*(const __attribute__((address_space(3))) bf16x8*)(kp+j*2048); kf[2*j+1]=*(const __attribute__((address_space(3))) bf16x8*)(kp+j*2048+512); }
__device__ __forceinline__ s16x4 vtr(lds_cptr p){ return __builtin_bit_cast(s16x4,__builtin_amdgcn_ds_read_tr16_b64_v4i16((__attribute__((address_space(3))) v4i16_t*)p)); }
__device__ __forceinline__ float rowmax(const f32x16&p0,const f32x16&p1){
  float a=max3f(p0[0],p0[1],p1[0]),b=max3f(p0[2],p0[3],p1[1]);a=max3f(a,p1[2],p1[3]);
  #pragma unroll
  for(int r=4;r<16;r+=4){a=max3f(a,p0[r],p0[r+1]);b=max3f(b,p0[r+2],p0[r+3]);a=max3f(a,p1[r],p1[r+1]);b=max3f(b,p1[r+2],p1[r+3]);}
  const float m=max2f(a,b);
  auto rr=__builtin_amdgcn_permlane32_swap(__float_as_uint(m),__float_as_uint(m),false,false);
  return max2f(__uint_as_float(rr[0]),__uint_as_float(rr[1]));
}
__device__ __forceinline__ void pv(f32x16*o,int vb,bf16x8 pa0,bf16x8 pa1,bf16x8 pa2,bf16x8 pa3){
  #pragma unroll
  for(int d0=0;d0<2;++d0){s16x4 lo[4],hi[4];
    #pragma unroll
    for(int ks=0;ks<4;++ks){
      asm volatile("ds_read_b64_tr_b16 %0,%1 offset:%c2":"=&v"(lo[ks]):"v"(vb),"i"(d0*4096+ks*1024):"memory");
      asm volatile("ds_read_b64_tr_b16 %0,%1 offset:%c2":"=&v"(hi[ks]):"v"(vb),"i"(d0*4096+ks*1024+512):"memory");}
    asm volatile("s_waitcnt lgkmcnt(0)":::"memory");SBAR();
    #define PK(k) (bf16x8){lo[k][0],lo[k][1],lo[k][2],lo[k][3],hi[k][0],hi[k][1],hi[k][2],hi[k][3]}
    o[d0]=__builtin_amdgcn_mfma_f32_32x32x16_bf16(pa0,PK(0),o[d0],0,0,0);
    o[d0]=__builtin_amdgcn_mfma_f32_32x32x16_bf16(pa1,PK(1),o[d0],0,0,0);
    o[d0]=__builtin_amdgcn_mfma_f32_32x32x16_bf16(pa2,PK(2),o[d0],0,0,0);
    o[d0]=__builtin_amdgcn_mfma_f32_32x32x16_bf16(pa3,PK(3),o[d0],0,0,0);
    #undef PK
  }
}

#ifndef ATTN_STORE16
#define ATTN_STORE16(p,v) (*(u32x4*)(p)=(v))
#endif
template<int THRL> __device__ __forceinline__ void attn_unit(int b,int qcol,int vcol,int ocol,int qb,const bf16*Q,const bf16*__restrict__ K,const bf16*__restrict__ V,bf16*O,char*shm){
  const int tid=__tid_l(),lane=tid&63,r32=lane&31,hi=lane>>5; const int wid=__builtin_amdgcn_readfirstlane(tid>>6);
  const long rowbase=(long)b*SEQ; const int q0=qb*QB;
  const bf16*Qw=Q+(rowbase+q0+wid*QBLK)*QP+qcol;
  const bf16*Kh=K+rowbase*KP+qcol,*Vh=V+rowbase*VP+vcol;
  const unsigned lds0=(unsigned)(uintptr_t)shm;
  float*wsf=(float*)(shm+LDS_WS)+wid*64;
  const bf16*ksrc=Kh+(long)lane*KP+wid*8;
  const bf16*vsrc=Vh+(long)(16*(wid&3)+(lane>>2))*VP+(wid>>2)*32+(lane&3)*8;
  const unsigned kdst=lds0+LDS_K+wid*1024, vdst=lds0+LDS_V+wid*1024;
  #define DMA_K(t,slot) glds16(ksrc+(long)(t)*KVBLK*KP,(unsigned)__builtin_amdgcn_readfirstlane(kdst+(slot)))
  #define DMA_V(t,slot) glds16(vsrc+(long)(t)*KVBLK*VP,(unsigned)__builtin_amdgcn_readfirstlane(vdst+(slot)))
  const int vb0=(int)(lds0+LDS_V)+((lane>>4)&1)*32+(lane&3)*8+(4*hi+((lane&15)>>2))*64;
  const char*Kbase=shm+LDS_K; bf16x8 kf[8];
  const lds_cptr shm3=(lds_cptr)shm; const lds_cptr kp0=shm3+LDS_K+hi*1024+r32*16; const lds_cptr vp0=shm3+LDS_V+((lane>>4)&1)*32+(lane&3)*8+(4*hi+((lane&15)>>2))*64;
  const int NT=(q0+QB)/KVBLK;
  DMA_K(0,0);DMA_V(0,0);DMA_K(1,SLOTB);
  bf16x8 qr[4];
  #pragma unroll
  for(int d0=0;d0<4;++d0)qr[d0]=*reinterpret_cast<const bf16x8*>(&Qw[(long)r32*QP+d0*16+hi*8]);
  float mhat=0.f,l_reg=0.f;f32x16 o[2];o[0]=f32x16{};o[1]=f32x16{};f32x16 negm=f32x16{};asm volatile("":"+v"(negm));
  const int qrel=wid*QBLK+r32;
  #define CMASK(P0,P1,t) do{int jb_=(t)-(NT-4); if(jb_>=0)cmask(P0,P1,jb_,qrel,hi);}while(0)
  bool resc=false;
  #define START(P0,P1) do{ const float rm=rowmax(P0,P1); resc=false; \
    { const float dl=rm; mhat=fadd_s(mhat,dl); \
      _Pragma("unroll") for(int r=0;r<16;++r){P0[r]=fsub_s(P0[r],dl);P1[r]=fsub_s(P1[r],dl);} \
      _Pragma("unroll") for(int r=0;r<16;++r)negm[r]=-mhat; asm volatile("":"+v"(negm)); } \
    _Pragma("unroll") for(int r=0;r<16;++r)P0[r]=__builtin_amdgcn_exp2f(P0[r]); }while(0)
  #define RESC() do{ if(resc){ asm volatile("s_waitcnt lgkmcnt(0)":::"memory"); \
      _Pragma("unroll") for(int d_=0;d_<2;++d_) _Pragma("unroll") for(int r=0;r<16;++r)o[d_][r]*=wsf[crow(r,hi)]; } }while(0)
  f32x16 pA0,pA1,pB0,pB1;
  int sl_prev=0,sl_cur=0,sl_next=SLOTB;
  #define ROT() do{sl_prev=sl_cur;sl_cur=sl_next;sl_next=(sl_next==(NSLOT-1)*SLOTB)?0:sl_next+SLOTB;}while(0)
  DMA_K(2,2*SLOTB);
  WAIT_BAR(3);
  qkt(pA0,pA1,Kbase,qr,negm,r32,hi);asm volatile("s_nop 15\n\ts_nop 7":"+v"(pA0),"+v"(pA1));CMASK(pA0,pA1,0);
  START(pA0,pA1);
  _Pragma("unroll") for(int r=0;r<16;++r)pA1[r]=__builtin_amdgcn_exp2f(pA1[r]);
  WAIT_BAR(0);
  DMA_K(3,0);DMA_V(1,SLOTB);
  ROT();
  kload8(kf,kp0+sl_cur);
  WAIT_BAR(2);
  s16x4 vlo[8],vhi[8]; u32x4 pw0,pw1,pw2,pw3;
  #define PKW(P,B) cvtpk_s(P[B],P[B+1])
  #define PAF(k) __builtin_bit_cast(bf16x8,pw##k)
  #define VFR(i) (bf16x8){vlo[i][0],vlo[i][1],vlo[i][2],vlo[i][3],vhi[i][0],vhi[i][1],vhi[i][2],vhi[i][3]}
  #define PIN(x) asm volatile("":"+v"(x))
  #define MX3(a,b,c) __builtin_fmaxf(__builtin_fmaxf((a),(b)),(c))
  #define GAPA(MF,A0,A1,A2,A3,W0,W1,PW) do{ MF; sacc+=A0; sacc+=A1; sacc+=A2; sacc+=A3; PIN(sacc); W0; W1; PIN(PW); SBAR(); }while(0)
  #define EX(v) __builtin_amdgcn_exp2f(v)
  #define GAPB(MF,X,B) do{ MF; X[B]=EX(X[B]); X[B+1]=EX(X[B+1]); X[B+2]=EX(X[B+2]); X[B+3]=EX(X[B+3]); PIN(X); SBAR(); }while(0)
  #define VRD(i) do{ vlo[i]=vtr(vp_+(((i)>>2)*4096+((i)&3)*1024)); vhi[i]=vtr(vp_+(((i)>>2)*4096+((i)&3)*1024+512)); }while(0)
  #define KRD(G,j) do{ if(G){ kload2(kf,kp0+sl_next,j); SBAR(); } }while(0)
  #define STEP(C0,C1,P0,P1,t,GK,GV,GL) do{ SBAR(); \
    const lds_cptr vp_=vp0+sl_prev; \
    VRD(0); SBAR(); float sacc=(P0[0]+P0[1]); \
    GAPA(C0=__builtin_amdgcn_mfma_f32_32x32x16_bf16(kf[0],qr[0],negm,0,0,0), P0[2],P0[3],P0[4],P0[5],     pw0[0]=PKW(P0,0), pw0[1]=PKW(P0,2), pw0); \
    VRD(4); SBAR(); GAPA(C1=__builtin_amdgcn_mfma_f32_32x32x16_bf16(kf[1],qr[0],negm,0,0,0), P0[6],P0[7],P0[8],P0[9],     pw0[2]=PKW(P0,4), pw0[3]=PKW(P0,6), pw0); \
    VRD(1); SBAR(); GAPA(C0=__builtin_amdgcn_mfma_f32_32x32x16_bf16(kf[2],qr[1],C0,0,0,0),   P0[10],P0[11],P0[12],P0[13], pw1[0]=PKW(P0,8), pw1[1]=PKW(P0,10), pw1); \
    VRD(5); SBAR(); GAPA(C1=__builtin_amdgcn_mfma_f32_32x32x16_bf16(kf[3],qr[1],C1,0,0,0),   P0[14],P0[15],P1[0],P1[1],   pw1[2]=PKW(P0,12),pw1[3]=PKW(P0,14), pw1); \
    VRD(2); SBAR(); GAPA(C0=__builtin_amdgcn_mfma_f32_32x32x16_bf16(kf[4],qr[2],C0,0,0,0),   P1[2],P1[3],P1[4],P1[5],     pw2[0]=PKW(P1,0), pw2[1]=PKW(P1,2), pw2); \
    VRD(6); SBAR(); GAPA(C1=__builtin_amdgcn_mfma_f32_32x32x16_bf16(kf[5],qr[2],C1,0,0,0),   P1[6],P1[7],P1[8],P1[9],     pw2[2]=PKW(P1,4), pw2[3]=PKW(P1,6), pw2); \
    VRD(3); SBAR(); GAPA(C0=__builtin_amdgcn_mfma_f32_32x32x16_bf16(kf[6],qr[3],C0,0,0,0),   P1[10],P1[11],P1[12],P1[13], pw3[0]=PKW(P1,8), pw3[1]=PKW(P1,10), pw3); \
    VRD(7); SBAR(); GAPA(C1=__builtin_amdgcn_mfma_f32_32x32x16_bf16(kf[7],qr[3],C1,0,0,0),   P1[14],P1[15],0.f,0.f,       pw3[2]=PKW(P1,12),pw3[3]=PKW(P1,14), pw3); \
    l_reg+=sacc; \
    if(GK){DMA_K((t)+3,sl_cur);} if(GV){DMA_V((t)+1,sl_next);} \
    CMASK(C0,C1,t); \
    { float a=MX3(C0[0],C0[1],C1[0]),b=MX3(C0[2],C0[3],C1[1]); a=MX3(a,C1[2],C1[3]); \
      _Pragma("unroll") for(int r=4;r<16;r+=4){a=MX3(a,C0[r],C0[r+1]);b=MX3(b,C0[r+2],C0[r+3]);a=MX3(a,C1[r],C1[r+1]);b=MX3(b,C1[r+2],C1[r+3]);} \
      float rm=__builtin_fmaxf(a,b); { auto rr=__builtin_amdgcn_permlane32_swap(__float_as_uint(rm),__float_as_uint(rm),false,false); rm=__builtin_fmaxf(__uint_as_float(rr[0]),__uint_as_float(rr[1])); } \
      resc=false; \
      if(__builtin_expect(__any(rm>(float)THRL),0)){ const float dl=__builtin_fmaxf(rm,0.f); mhat+=dl; \
        _Pragma("unroll") for(int r=0;r<16;++r){C0[r]-=dl;C1[r]-=dl;} \
        _Pragma("unroll") for(int r=0;r<16;++r)negm[r]=-mhat; asm volatile("":"+v"(negm)); \
        const float f=__builtin_amdgcn_exp2f(-dl); l_reg*=f; if(hi==0)wsf[r32]=f; resc=true; } } \
    SBAR(); \
    GAPB(o[0]=__builtin_amdgcn_mfma_f32_32x32x16_bf16(PAF(0),VFR(0),o[0],0,0,0), C0,0); \
    GAPB(o[1]=__builtin_amdgcn_mfma_f32_32x32x16_bf16(PAF(0),VFR(4),o[1],0,0,0), C0,4); \
    KRD(GL,0); GAPB(o[0]=__builtin_amdgcn_mfma_f32_32x32x16_bf16(PAF(1),VFR(1),o[0],0,0,0), C0,8); \
    KRD(GL,1); GAPB(o[1]=__builtin_amdgcn_mfma_f32_32x32x16_bf16(PAF(1),VFR(5),o[1],0,0,0), C0,12); \
    KRD(GL,2); GAPB(o[0]=__builtin_amdgcn_mfma_f32_32x32x16_bf16(PAF(2),VFR(2),o[0],0,0,0), C1,0); \
    KRD(GL,3); GAPB(o[1]=__builtin_amdgcn_mfma_f32_32x32x16_bf16(PAF(2),VFR(6),o[1],0,0,0), C1,4); \
    GAPB(o[0]=__builtin_amdgcn_mfma_f32_32x32x16_bf16(PAF(3),VFR(3),o[0],0,0,0), C1,8); \
    GAPB(o[1]=__builtin_amdgcn_mfma_f32_32x32x16_bf16(PAF(3),VFR(7),o[1],0,0,0), C1,12); \
    }while(0)
  int t=1;
  #undef CMASK
  #define CMASK(P0,P1,t) do{}while(0)
  for(;t+5<NT;t+=2){
    STEP(pB0,pB1,pA0,pA1,t,true,true,true);     WAIT_BAR(2); RESC(); ROT();
    STEP(pA0,pA1,pB0,pB1,t+1,true,true,true);   WAIT_BAR(2); RESC(); ROT();
  }
  #undef CMASK
  #define CMASK(P0,P1,t) do{int jb_=(t)-(NT-4); if(jb_>=0)cmask(P0,P1,jb_,qrel,hi);}while(0)
  #define ENDW(tt) do{ if((tt)+3<NT){WAIT_BAR(2);} else if((tt)+2<NT){WAIT_BAR(1);} else {WAIT_BAR(0);} }while(0)
  for(;t+1<NT;t+=2){
    STEP(pB0,pB1,pA0,pA1,t,(t+3<NT),(t+1<NT),(t+1<NT));       ENDW(t);   RESC(); ROT();
    STEP(pA0,pA1,pB0,pB1,t+1,(t+4<NT),(t+2<NT),(t+2<NT));     ENDW(t+1); RESC(); ROT();
  }
  STEP(pB0,pB1,pA0,pA1,NT-1,false,false,false); RESC();
  { float sacc=pB0[0]+pB0[1]; _Pragma("unroll") for(int r=2;r<16;++r)sacc+=pB0[r]; _Pragma("unroll") for(int r=0;r<16;++r)sacc+=pB1[r]; l_reg+=sacc;
    pw0=(u32x4){PKW(pB0,0),PKW(pB0,2),PKW(pB0,4),PKW(pB0,6)};pw1=(u32x4){PKW(pB0,8),PKW(pB0,10),PKW(pB0,12),PKW(pB0,14)};pw2=(u32x4){PKW(pB1,0),PKW(pB1,2),PKW(pB1,4),PKW(pB1,6)};pw3=(u32x4){PKW(pB1,8),PKW(pB1,10),PKW(pB1,12),PKW(pB1,14)};
    SBAR(); pv(o,vb0+sl_cur,PAF(0),PAF(1),PAF(2),PAF(3)); }
  #undef PKW
  #undef PAF
  #undef VFR
  #undef PIN
  #undef MX3
  #undef GAPA
  #undef GAPB
  #undef EX
  #undef VRD
  #undef KRD
  #undef STEP
  #undef ENDW
  {auto rr=__builtin_amdgcn_permlane32_swap(__float_as_uint(l_reg),__float_as_uint(l_reg),false,false);l_reg=__uint_as_float(rr[0])+__uint_as_float(rr[1]);}
  if(hi==0)wsf[32+r32]=l_reg;asm volatile("s_waitcnt lgkmcnt(0)":::"memory");
  float rli[16];
  #pragma unroll
  for(int r=0;r<16;++r)rli[r]=__builtin_amdgcn_rcpf(wsf[32+crow(r,hi)]);
  bf16*Ow=O+(rowbase+q0+wid*QBLK)*OP+ocol;
  { bf16*stg=(bf16*)(shm+LDS_OST)+wid*2048;
    #pragma unroll
    for(int r=0;r<16;++r){const int orow=crow(r,hi);
      #pragma unroll
      for(int d0=0;d0<2;++d0)stg[orow*64+d0*32+r32]=__float2bfloat16(o[d0][r]*rli[r]);}
    asm volatile("s_waitcnt lgkmcnt(0)":::"memory");
    #pragma unroll
    for(int i=0;i<4;++i){const int row=i*8+(lane>>3),ch=lane&7; const u32x4 v=*(const u32x4*)(stg+row*64+ch*8); ATTN_STORE16(Ow+(long)row*OP+ch*8,v);} }
  asm volatile("s_waitcnt lgkmcnt(0)\n\ts_barrier":::"memory");
  #undef DMA_K
  #undef DMA_V
  #undef CMASK
  #undef START
  #undef RESC
  #undef ROT
}
#undef SBAR
#undef WAIT_BAR
}
namespace cg = cooperative_groups;
#define LAS __attribute__((address_space(3)))
typedef unsigned short bf16;
typedef unsigned v4u __attribute__((ext_vector_type(4)));
typedef unsigned v2u __attribute__((ext_vector_type(2)));
typedef float f32x4 __attribute__((ext_vector_type(4)));
typedef float f32x16 __attribute__((ext_vector_type(16)));
typedef short bf16x8 __attribute__((ext_vector_type(8)));

constexpr int NB = 8, SEQ = 4096, DM = 1024, TOK = NB * SEQ, FF = 2816, NIN = 3592, NINP = 3584, NMOD = 9216;
constexpr size_t MiB = 1u << 20;
constexpr size_t WS_CTL = 0, WS_MOD = 64 * 1024, WS_ROPE = 512 * 1024, WS_GATES = 1 * MiB;
constexpr size_t WS_W12A = 2 * MiB, WS_W3A = 13 * MiB, WS_W12B = 19 * MiB, WS_W3B = 30 * MiB, WS_WIN = 36 * MiB, WS_WOUT = 43 * MiB;
constexpr size_t WS_HN = 48 * MiB, WS_HID = 112 * MiB;
constexpr size_t WS_Q = WS_HID, WS_K = WS_HID + 32 * MiB, WS_V = WS_HID + 64 * MiB, WS_MLQK = WS_HID + 96 * MiB;
constexpr size_t WS_MLV = 288 * MiB, WS_MLO = 320 * MiB, WS_AO = 352 * MiB, WS_MLH = 416 * MiB, WS_IMGB = 448 * MiB, WS_END = 512 * MiB;
constexpr size_t WS_RSS = 47 * MiB, WS_SB3 = 47 * MiB + 256 * 1024, WS_XG3 = WS_AO;
constexpr size_t WS_BP = 45 * MiB, WS_RK = 46 * MiB, WS_IMGA = WS_HN;
constexpr int LDS_BYTES = 147456, MISC_OFF = 131072 + 320;
constexpr float C2Q = 0.125f * 1.4426950408889634f;

__device__ __forceinline__ unsigned f2bf(float f) { unsigned u = __builtin_bit_cast(unsigned, f); return (u + 0x7fffu + ((u >> 16) & 1u)) >> 16; }
__device__ __forceinline__ unsigned pk2(float lo, float hi) { return pg8::cvt_pk_bf16(lo, hi); }
__device__ __forceinline__ float bflo(unsigned u) { return __builtin_bit_cast(float, u << 16); }
__device__ __forceinline__ float bfhi(unsigned u) { return __builtin_bit_cast(float, u & 0xffff0000u); }
__device__ __forceinline__ float wave_sum(float v) {
#pragma unroll
    for (int o = 1; o < 64; o <<= 1) v += __shfl_xor(v, o);
    return v;
}
#define LDS_WAIT() asm volatile("s_waitcnt lgkmcnt(0)" ::: "memory")

#define XB_TMO      128
#define XB_XCNT(j)  (256  + 64 * (j))
#define XB_XSUB(j)  (1280 + 64 * (j))
#define XB_XGEN(j)  (2304 + 64 * (j))
#define XB_TOP      3328
#define XB_TOPGEN   3392
#define XCD_BAR_WORDS 3456
#define XB_SPIN_CAP (1u << 18)

__device__ __forceinline__ unsigned xb_ld(unsigned* p)              { return __hip_atomic_load(p, __ATOMIC_RELAXED, __HIP_MEMORY_SCOPE_AGENT); }
__device__ __forceinline__ unsigned xb_add(unsigned* p, unsigned v) { return __hip_atomic_fetch_add(p, v, __ATOMIC_RELAXED, __HIP_MEMORY_SCOPE_AGENT); }
__device__ __forceinline__ unsigned xb_xcc_id() { return (unsigned)__builtin_amdgcn_s_getreg((3 << 11) | 20) & 0xFu; }
#define XB_SPIN(cond, bar) do { unsigned _sp = 0; while (cond) { __builtin_amdgcn_s_sleep(1); \
    if ((++_sp & 255u) == 0u) { if (xb_ld(&(bar)[XB_TMO])) break; if (_sp > XB_SPIN_CAP) { atomicAdd(&(bar)[XB_TMO], 1u); break; } } } } while (0)

struct XcdBarrier {
    unsigned* bar; unsigned x;
    volatile LAS unsigned* st;
};

__device__ __forceinline__ XcdBarrier xcd_barrier_post(unsigned* bar, volatile LAS unsigned* st) {
    XcdBarrier b; b.bar = bar; b.x = xb_xcc_id(); b.st = st;
    if (threadIdx.x == 0) (void)xb_add(&bar[XB_XCNT(b.x)], 1u);
    return b;
}
__device__ __forceinline__ void xcd_barrier_complete(unsigned* bar, unsigned x, unsigned& nloc, unsigned& nx) {
    const unsigned G = gridDim.x * gridDim.y * gridDim.z;
    unsigned sum, cnt, mine, sp = 0u;
    for (;;) {
        sum = 0u; cnt = 0u; mine = 0u;
#pragma unroll
        for (unsigned j = 0; j < 16; ++j) { const unsigned c = xb_ld(&bar[XB_XCNT(j)]); sum += c; cnt += (c > 0u) ? 1u : 0u; mine = (j == x) ? c : mine; }
        if (sum == G) break;
        __builtin_amdgcn_s_sleep(1);
        if ((++sp & 255u) == 0u) { if (xb_ld(&bar[XB_TMO])) break; if (sp > XB_SPIN_CAP) { atomicAdd(&bar[XB_TMO], 1u); break; } }
    }
    nloc = mine > 0u ? mine : 1u; nx = cnt > 0u ? cnt : 1u;
}

__device__ __forceinline__ void xcd_barrier(const XcdBarrier& b) {
    asm volatile("s_waitcnt vmcnt(0)" ::: "memory");
    __syncthreads();
    if (threadIdx.x == 0) {
        unsigned* bar = b.bar;
        __builtin_amdgcn_s_waitcnt(0);
        unsigned nloc = b.st[0], nx = b.st[1];
        if (nloc == 0u) { xcd_barrier_complete(bar, b.x, nloc, nx); b.st[0] = nloc; b.st[1] = nx; }
        const unsigned old = xb_add(&bar[XB_XSUB(b.x)], 1u);
        const unsigned gen = old / nloc;
        if (old + 1u == (gen + 1u) * nloc) {
            __builtin_amdgcn_fence(__ATOMIC_RELEASE, "agent");
            asm volatile("s_waitcnt vmcnt(0)" ::: "memory");
            const unsigned og = xb_add(&bar[XB_TOP], 1u);
            const unsigned tg = og / nx;
            if (og + 1u == (tg + 1u) * nx) xb_add(&bar[XB_TOPGEN], 1u);
            else XB_SPIN(xb_ld(&bar[XB_TOPGEN]) == tg, bar);
            __builtin_amdgcn_fence(__ATOMIC_ACQUIRE, "agent");
            xb_add(&bar[XB_XGEN(b.x)], 1u);
            asm volatile("s_waitcnt vmcnt(0)" ::: "memory");
        } else {
            XB_SPIN(xb_ld(&bar[XB_XGEN(b.x)]) == gen, bar);
            __builtin_amdgcn_fence(__ATOMIC_ACQUIRE, "agent");
            asm volatile("s_waitcnt vmcnt(0)" ::: "memory");
        }
    }
    __syncthreads();
}


struct Args { const float* in[20]; float* out; unsigned char* ws; int ph_lo, ph_hi; };
enum { I_X = 0, I_C, I_WADA, I_BADA, I_GNORM, I_F1W12, I_F1W3, I_WIN, I_CONVW, I_CONVB, I_BIG, I_BFG, I_GQ, I_GK, I_LAMQK, I_GDA, I_GML, I_WOUT, I_F2W12, I_F2W3 };

__device__ __forceinline__ void transpose_item(const float* W, int K, int ldw, int nsrc0, bf16* WT, int ndst0, LAS float* scr, int k0, int lane) {
#pragma unroll 8
    for (int i = 0; i < 32; ++i) { const int kk = 2 * i + (lane >> 5); scr[kk * 33 + (lane & 31)] = W[(size_t)(k0 + kk) * ldw + nsrc0 + (lane & 31)]; }
    LDS_WAIT();
    const int c = lane & 7;
#pragma unroll
    for (int j = 0; j < 4; ++j) { const int n = (lane >> 3) + 8 * j; const LAS float* s = scr + (8 * c) * 33 + n;
        v4u o; o.x = pk2(s[0 * 33], s[1 * 33]); o.y = pk2(s[2 * 33], s[3 * 33]); o.z = pk2(s[4 * 33], s[5 * 33]); o.w = pk2(s[6 * 33], s[7 * 33]);
        *(v4u*)(WT + (size_t)(ndst0 + n) * K + k0 + 8 * c) = o; }
    LDS_WAIT();
}
__device__ __forceinline__ void p0_prologue(const Args& a, LAS unsigned char* lds) {
    const int tid = __tid_l(), lane = tid & 63, wave = __builtin_amdgcn_readfirstlane(tid >> 6), G = gridDim.x, bx = blockIdx.x;
    unsigned char* ws = a.ws;
    if (bx == 0 && tid < 64) ((unsigned*)(ws + WS_CTL))[tid * 64] = 0u;
    for (int i = bx * 512 + tid; i < TOK; i += G * 512) ((float*)(ws + WS_RSS))[i] = 0.f;
    {
        LAS float* sc = (LAS float*)lds;
        LAS float* red = (LAS float*)(lds + 32768);
        const float* c = a.in[I_C];
        for (int i = tid; i < 8192; i += 512) { const int b = i >> 10, k = i & 1023; const float v = c[i]; sc[k * 8 + b] = v / (1.0f + __expf(-v)); }
        __syncthreads();
        const float* wada = a.in[I_WADA]; const float* bada = a.in[I_BADA]; float* mod = (float*)(ws + WS_MOD);
        for (int jb = bx; jb < 256; jb += G) {
            const int j0 = jb * 36; float acc[8];
#pragma unroll
            for (int b = 0; b < 8; ++b) acc[b] = 0.f;
            if (lane < 36) {
                const float* wp = wada + (size_t)(wave * 128) * NMOD + j0 + lane;
#pragma unroll 32
                for (int k = 0; k < 128; ++k) {
                    const float wv = wp[(size_t)k * NMOD];
                    const f32x4 s0 = *(const LAS f32x4*)(sc + (wave * 128 + k) * 8), s1 = *(const LAS f32x4*)(sc + (wave * 128 + k) * 8 + 4);
                    acc[0] += wv * s0[0]; acc[1] += wv * s0[1]; acc[2] += wv * s0[2]; acc[3] += wv * s0[3];
                    acc[4] += wv * s1[0]; acc[5] += wv * s1[1]; acc[6] += wv * s1[2]; acc[7] += wv * s1[3];
                }
#pragma unroll
                for (int b = 0; b < 8; ++b) red[(wave * 8 + b) * 36 + lane] = acc[b];
            }
            __syncthreads();
            if (tid < 288) { const int b = tid / 36, j = tid % 36; float s = bada[j0 + j];
#pragma unroll
                for (int w = 0; w < 8; ++w) s += red[(w * 8 + b) * 36 + j];
                mod[(size_t)b * NMOD + j0 + j] = s; }
            __syncthreads();
        }
    }
    {
        float* rope = (float*)(ws + WS_ROPE);
        for (int e = bx * 512 + tid; e < SEQ * 8; e += G * 512) {
            const int pos = e >> 3, i = e & 7;
            const float invf = powf(500000.0f, -(float)i * 0.125f);
            const float ang = (float)pos * invf;
            const double k = rint((double)ang * 0.15915494309189535);
            const float r = (float)((double)ang - k * 6.283185307179586);
            rope[2 * e] = cosf(r); rope[2 * e + 1] = sinf(r);
        }
    }
    {
        LAS float* scr = (LAS float*)(lds + wave * 16384);
        const int gw = bx * 8 + wave, NGW = G * 8;
        constexpr int I_12 = 16 * 176, I_3 = 44 * 32, I_IN = 16 * 112, I_O = 16 * 32, NITEMS = 2 * I_12 + 2 * I_3 + I_IN + I_O;
        for (int it = gw; it < NITEMS; it += NGW) {
            int r = it;
            if (r < 2 * I_12) {
                const int which = r >= I_12; r -= which * I_12; const int kb = r / 176, nb = r % 176, n0 = nb * 32;
                const int src = ((n0 >> 7) & 1) * FF + (n0 >> 8) * 128 + (n0 & 127);
                transpose_item(a.in[which ? I_F2W12 : I_F1W12], 1024, 2 * FF, src, (bf16*)(ws + (which ? WS_W12B : WS_W12A)), n0, scr, kb * 64, lane); continue; }
            r -= 2 * I_12;
            if (r < 2 * I_3) { const int which = r >= I_3; r -= which * I_3; const int kb = r / 32, nb = r % 32;
                transpose_item(a.in[which ? I_F2W3 : I_F1W3], FF, 1024, nb * 32, (bf16*)(ws + (which ? WS_W3B : WS_W3A)), nb * 32, scr, kb * 64, lane); continue; }
            r -= 2 * I_3;
            if (r < I_IN) { const int kb = r / 112, nb = r % 112, n0 = nb * 32;
                const int src = (n0 & ~255) + ((n0 >> 5) & 3) * 64 + ((n0 >> 7) & 1) * 32;
                transpose_item(a.in[I_WIN], 1024, NIN, src, (bf16*)(ws + WS_WIN), n0, scr, kb * 64, lane); continue; }
            r -= I_IN;
            { const int kb = r / 32, nb = r % 32; transpose_item(a.in[I_WOUT], 1024, 1024, nb * 32, (bf16*)(ws + WS_WOUT), nb * 32, scr, kb * 64, lane); }
        }
    }
}

template <bool GATES, bool XBF>
__device__ __forceinline__ void norm_phase(const Args& a, const void* xin_, int sub, LAS unsigned char* lds) {
    const int tid = __tid_l(), lane = tid & 63, wave = __builtin_amdgcn_readfirstlane(tid >> 6), G = gridDim.x, bx = blockIdx.x;
    bf16* hn = (bf16*)(a.ws + WS_HN); const float* mod = (const float*)(a.ws + WS_MOD); float* gates = (float*)(a.ws + WS_GATES);
    const float* gn = a.in[I_GNORM] + sub * 1024;
    LAS float* wg = (LAS float*)lds;
    if (GATES) {
        const float* win = a.in[I_WIN];
        for (int i = tid; i < 8192; i += 512) { const int k = i >> 3, j = i & 7; wg[j * 1024 + k] = win[(size_t)k * NIN + NINP + j]; }
        __syncthreads();
    }
    const int gw = bx * 8 + wave, NGW = G * 8;
    if (!GATES && !XBF) {
        const bf16* Wt = (const bf16*)(a.ws + WS_W12B); float* sb = (float*)(a.ws + WS_SB3);
        for (int n = gw; n < 2 * FF; n += NGW) {
            float wv[16];
#pragma unroll
            for (int j = 0; j < 4; ++j) { const v2u w = *(const v2u*)(Wt + (size_t)n * 1024 + 256 * j + 4 * lane); wv[4 * j] = bflo(w.x); wv[4 * j + 1] = bfhi(w.x); wv[4 * j + 2] = bflo(w.y); wv[4 * j + 3] = bfhi(w.y); }
#pragma unroll
            for (int b = 0; b < 8; ++b) { const float* sh = mod + (size_t)b * NMOD + 6 * 1024 + 4 * lane; float s = 0.f;
#pragma unroll
                for (int j = 0; j < 4; ++j) { const f32x4 sv = *(const f32x4*)(sh + 256 * j); s += (wv[4 * j] * sv[0] + wv[4 * j + 1] * sv[1]) + (wv[4 * j + 2] * sv[2] + wv[4 * j + 3] * sv[3]); }
                s = wave_sum(s);
                if (lane == 0) sb[(size_t)b * (2 * FF) + n] = s; }
        }
    }
    for (int rb = gw; rb < TOK / 16; rb += NGW) {
        const int row0 = rb * 16, b = row0 >> 12;
        const float* mb = mod + (size_t)b * NMOD + sub * 3072;
        f32x4 gs[4], sh[4];
#pragma unroll
        for (int j = 0; j < 4; ++j) { const int col = 256 * j + 4 * lane; gs[j] = *(const f32x4*)(gn + col) * (*(const f32x4*)(mb + 1024 + col) + 1.0f); sh[j] = *(const f32x4*)(mb + col); }
#pragma unroll 2
        for (int r = 0; r < 16; ++r) {
            f32x4 v[4]; float ss = 0.f;
#pragma unroll
            for (int j = 0; j < 4; ++j) {
                if (XBF) { const v2u w = *(const v2u*)((const bf16*)xin_ + (size_t)(row0 + r) * 1024 + 4 * lane + 256 * j); v[j] = (f32x4){bflo(w.x), bfhi(w.x), bflo(w.y), bfhi(w.y)}; }
                else v[j] = *(const f32x4*)((const float*)xin_ + (size_t)(row0 + r) * 1024 + 4 * lane + 256 * j);
                ss += (v[j][0] * v[j][0] + v[j][1] * v[j][1]) + (v[j][2] * v[j][2] + v[j][3] * v[j][3]); }
            const float rinv = 1.0f / sqrtf(wave_sum(ss) * (1.0f / 1024.0f) + 1e-6f);
            bf16* orow = hn + (size_t)(row0 + r) * 1024 + 4 * lane;
#pragma unroll
            for (int j = 0; j < 4; ++j) { v[j] = v[j] * rinv * gs[j] + sh[j]; v2u o; o.x = pk2(v[j][0], v[j][1]); o.y = pk2(v[j][2], v[j][3]); *(v2u*)(orow + 256 * j) = o; }
            if (GATES) {
                float gsum[8];
#pragma unroll
                for (int jj = 0; jj < 8; ++jj) { float s = 0.f;
#pragma unroll
                    for (int j = 0; j < 4; ++j) { const f32x4 w = *(const LAS f32x4*)(wg + jj * 1024 + 256 * j + 4 * lane); s += (v[j][0] * w[0] + v[j][1] * w[1]) + (v[j][2] * w[2] + v[j][3] * w[3]); }
                    gsum[jj] = wave_sum(s); }
                if (lane == 0) { float* gp = gates + (size_t)(row0 + r) * 8; *(f32x4*)gp = (f32x4){gsum[0], gsum[1], gsum[2], gsum[3]}; *(f32x4*)(gp + 4) = (f32x4){gsum[4], gsum[5], gsum[6], gsum[7]}; }
            }
        }
    }
}

namespace ml {
constexpr int QP = 136, SP = 72;
constexpr int L_QS = 0, L_KS = 17408, LP_EP = 71680;
constexpr int L_VS = 33792, L_WS = 41984, L_CT = 51200, L_N = 68608, L_QN = 69120, L_RS = 69376, L_RK = 69888, L_G = 70400, GSTRIDE = 1024, L_BPL = 72448;
typedef short v4i16_t __attribute__((ext_vector_type(4)));
__device__ __forceinline__ bf16x8 tr_frag(const LAS unsigned char* p0, const LAS unsigned char* p1) {
    const v4i16_t lo = __builtin_amdgcn_ds_read_tr16_b64_v4i16((LAS v4i16_t*)p0), hi = __builtin_amdgcn_ds_read_tr16_b64_v4i16((LAS v4i16_t*)p1);
    return (bf16x8){lo[0], lo[1], lo[2], lo[3], hi[0], hi[1], hi[2], hi[3]};
}
__device__ __forceinline__ float scan_add(float v, int lane) {
#pragma unroll
    for (int o = 1; o < 64; o <<= 1) { const float t = __shfl_up(v, o); if (lane >= o) v += t; }
    return v;
}
__device__ __forceinline__ float scan_max(float v, int lane) {
#pragma unroll
    for (int o = 1; o < 64; o <<= 1) { const float t = __shfl_up(v, o); if (lane >= o) v = fmaxf(v, t); }
    return v;
}
}

__device__ __forceinline__ void mlprep_phase(const Args& a, LAS unsigned char* lds) {
    using namespace ml;
    const int tid = __tid_l(), lane = tid & 63, wave = __builtin_amdgcn_readfirstlane(tid >> 6), G = gridDim.x, bx = blockIdx.x;
    const bf16* MLQK = (const bf16*)(a.ws + WS_MLQK);
    LAS bf16* Qs = (LAS bf16*)(lds + L_QS); LAS bf16* Ks = (LAS bf16*)(lds + L_KS); LAS float* EP = (LAS float*)(lds + LP_EP);
    const int cg_ = tid & 31, rg = tid >> 5; const bool isq = cg_ < 16;
    for (int it = bx; it < 2048; it += G) {
        const int bh = it >> 6, c = it & 63, b = bh >> 2, h = bh & 3;
        const int colq = isq ? (h * 128 + cg_ * 8) : (512 + h * 128 + (cg_ - 16) * 8);
        const bf16* qk_base = MLQK + (size_t)b * SEQ * 1024 + colq;
        v4u uq[7];
        { const int t0 = c * 64 + rg * 4 - 3;
#pragma unroll
          for (int i = 0; i < 7; ++i) { const int t = t0 + i; uq[i] = *(const v4u*)(qk_base + (size_t)(t < 0 ? 0 : t) * 1024); if (t < 0) uq[i] = (v4u){0u, 0u, 0u, 0u}; }
 }
        float cw[4][8], cb[8];
#pragma unroll
        for (int j = 0; j < 4; ++j) { const f32x4 w0 = *(const f32x4*)(a.in[I_CONVW] + j * 1024 + colq), w1 = *(const f32x4*)(a.in[I_CONVW] + j * 1024 + colq + 4);
            cw[j][0] = w0[0]; cw[j][1] = w0[1]; cw[j][2] = w0[2]; cw[j][3] = w0[3]; cw[j][4] = w1[0]; cw[j][5] = w1[1]; cw[j][6] = w1[2]; cw[j][7] = w1[3]; }
        { const f32x4 w0 = *(const f32x4*)(a.in[I_CONVB] + colq), w1 = *(const f32x4*)(a.in[I_CONVB] + colq + 4);
          cb[0] = w0[0]; cb[1] = w0[1]; cb[2] = w0[2]; cb[3] = w0[3]; cb[4] = w1[0]; cb[5] = w1[1]; cb[6] = w1[2]; cb[7] = w1[3]; }
        if (wave == 0) {
            const float* gp = (const float*)(a.ws + WS_GATES) + ((size_t)b * SEQ + c * 64 + lane) * 8;
            const float ig = gp[h] + a.in[I_BIG][h], fg = gp[4 + h] + a.in[I_BFG][h];
            const float fl = fminf(fg, 0.f) - log1pf(__expf(-fabsf(fg)));
            const float bb = scan_add(fl, lane), p = ig - bb;
            EP[lane] = __expf(p);
            float* bpo = (float*)(a.ws + WS_BP) + ((size_t)bh * SEQ + c * 64 + lane) * 2; bpo[0] = bb; bpo[1] = p;
        }
        __syncthreads();
        {
#pragma unroll
          for (int r = 0; r < 4; ++r) { float o[8];
#pragma unroll
              for (int i = 0; i < 8; ++i) o[i] = cb[i];
#pragma unroll
              for (int j = 0; j < 4; ++j) { const v4u u_ = uq[r + j];
                  o[0] += cw[j][0] * bflo(u_.x); o[1] += cw[j][1] * bfhi(u_.x); o[2] += cw[j][2] * bflo(u_.y); o[3] += cw[j][3] * bfhi(u_.y);
                  o[4] += cw[j][4] * bflo(u_.z); o[5] += cw[j][5] * bfhi(u_.z); o[6] += cw[j][6] * bflo(u_.w); o[7] += cw[j][7] * bfhi(u_.w); }
              const int t_ = rg * 4 + r;
              const float qs_ = isq ? 0.08838834764831845f : EP[t_];
#pragma unroll
              for (int i = 0; i < 8; ++i) o[i] = o[i] * __builtin_amdgcn_rcpf(1.0f + __builtin_amdgcn_exp2f(-1.4426950408889634f * o[i])) * qs_;
              v4u w_; w_.x = pk2(o[0], o[1]); w_.y = pk2(o[2], o[3]); w_.z = pk2(o[4], o[5]); w_.w = pk2(o[6], o[7]);
              if (isq) *(LAS v4u*)(Qs + t_ * QP + cg_ * 8) = w_; else *(LAS v4u*)(Ks + t_ * QP + (cg_ - 16) * 8) = w_;
          }
        }
        __syncthreads();
        { bf16* ga = (bf16*)(a.ws + WS_IMGA) + (size_t)it * 16384;
#pragma unroll
          for (int k = 0; k < 2; ++k) { const int idx = tid + 512 * k, row = idx >> 4, ch = idx & 15;
              *(v4u*)(ga + idx * 8) = *(const LAS v4u*)(Qs + row * QP + ch * 8); *(v4u*)(ga + 8192 + idx * 8) = *(const LAS v4u*)(Ks + row * QP + ch * 8); }
          { const int d = tid & 127, sq = tid >> 7; float s = 0.f;
#pragma unroll
            for (int k = 0; k < 16; ++k) s += __builtin_bit_cast(float, (unsigned)Ks[(sq * 16 + k) * QP + d] << 16);
            ((LAS float*)(lds + LP_EP + 1024))[sq * 128 + d] = s; }
        }
        __syncthreads();
        if (tid < 128) { LAS float* rp = (LAS float*)(lds + LP_EP + 1024); ((float*)(a.ws + WS_RK))[(size_t)it * 128 + tid] = (rp[tid] + rp[128 + tid]) + (rp[256 + tid] + rp[384 + tid]); }
        __syncthreads();
    }
}

__device__ __forceinline__ void mlstm_item(const Args& a, int item, LAS unsigned char* lds) {
    using namespace ml;
    const int tid = __tid_l(), lane = tid & 63, wave = __builtin_amdgcn_readfirstlane(tid >> 6), l31 = lane & 31, g = lane >> 5;
    const int b = item >> 3, h = (item >> 1) & 3, half = item & 1, bh = b * 4 + h;
    const bf16* imgA = (const bf16*)(a.ws + WS_IMGA) + (size_t)bh * 64 * 16384 + tid * 8;
    const bf16* vsrc = (const bf16*)(a.ws + WS_MLV) + ((size_t)b * SEQ + (tid >> 3)) * 512 + h * 128 + half * 64 + (tid & 7) * 8;
    const float* bp = (const float*)(a.ws + WS_BP) + (size_t)bh * SEQ * 2;
    const float* rkg = (const float*)(a.ws + WS_RK) + (size_t)bh * 64 * 128;
    bf16* h_base = (bf16*)(a.ws + WS_MLH) + (size_t)b * SEQ * 512 + h * 128 + half * 64;

    LAS bf16* Qs = (LAS bf16*)(lds + L_QS); LAS bf16* Ws = (LAS bf16*)(lds + L_WS); LAS bf16* CT = (LAS bf16*)(lds + L_CT);
    LAS unsigned char* KsB = lds + L_KS; LAS unsigned char* VsB = lds + L_VS;
    const int li_ = lane & 15, tq_ = li_ >> 2, tp_ = li_ & 3, tc16_ = (lane >> 4) & 1;
    const int vtrb = 1024 * g + 64 * tq_ + 16 * (2 * tc16_ + (tp_ >> 1)) + 8 * (tp_ & 1);
    LAS float* Nv = (LAS float*)(lds + L_N); LAS float* QN = (LAS float*)(lds + L_QN); LAS float* RS = (LAS float*)(lds + L_RS); LAS float* RK = (LAS float*)(lds + L_RK);
#define GB(buf) ((LAS float*)(lds + L_G + (buf) * GSTRIDE))
#define ML_BAR() asm volatile("s_waitcnt lgkmcnt(0)\n\ts_barrier" ::: "memory")
    v4u pfA[5], pfB[5]; unsigned rkA = 0u, rkB = 0u;
    const int crow_ = tid >> 4, cch = tid & 15, crow8 = tid >> 3, cch8 = tid & 7;
    const float* rkl = rkg + (tid & 127);
#define ALOAD4(r, p) asm volatile("global_load_dwordx4 %0, %1, off" : "=&v"(r) : "v"(p) : "memory")
#define ALOAD1(r, p) asm volatile("global_load_dword %0, %1, off" : "=&v"(r) : "v"(p) : "memory")
#define TILE_LOAD(c, pf, rk) do { const bf16* ga_ = imgA + (size_t)(c) * 16384; \
        ALOAD4(pf[0], ga_); ALOAD4(pf[1], ga_ + 4096); ALOAD4(pf[2], ga_ + 8192); ALOAD4(pf[3], ga_ + 12288); \
        ALOAD4(pf[4], vsrc + (size_t)(c) * 64 * 512); ALOAD1(rk, rkl + (c) * 128); } while (0)
#define TILE_WAIT(N, pf, rk) asm volatile("s_waitcnt vmcnt(" #N ")" : "+v"(pf[0]), "+v"(pf[1]), "+v"(pf[2]), "+v"(pf[3]), "+v"(pf[4]), "+v"(rk) : : "memory")
#define KSWZ(row) ((((row) & 3) << 2) | (((row) >> 2) & 3))
#define TILE_WRITE(pf, rk) do { \
        *(LAS v4u*)(Qs + crow_ * QP + cch * 8) = pf[0]; *(LAS v4u*)(Qs + (crow_ + 32) * QP + cch * 8) = pf[1]; \
        *(LAS v4u*)(KsB + 256 * crow_ + 16 * (cch ^ KSWZ(crow_))) = pf[2]; *(LAS v4u*)(KsB + 256 * (crow_ + 32) + 16 * (cch ^ KSWZ(crow_))) = pf[3];     \
        *(LAS v4u*)(VsB + 1024 * (crow8 >> 3) + 512 * (cch8 >> 2) + 64 * (crow8 & 7) + 16 * (cch8 & 3)) = pf[4]; \
        if (tid < 128) RK[tid] = __builtin_bit_cast(float, rk); } while (0)
#define TRF(p0_) tr_frag((p0_), (p0_) + 256)
    float Mc = 0.f;
    LAS float* BPL = (LAS float*)(lds + L_BPL);
#define GATE_SCAN(c, buf) do { LAS float* o_ = GB(buf); const float gb_b = BPL[((c) * 64 + lane) * 2], gb_p = BPL[((c) * 64 + lane) * 2 + 1]; \
        const float P_ = scan_max(gb_p, lane); const float gg_ = __shfl(gb_b, 63), Pm_ = __shfl(P_, 63); \
        const float mt_ = gb_b + fmaxf(Mc, P_); const float al_ = gb_b - mt_; const float Mn_ = gg_ + fmaxf(Mc, Pm_); \
        o_[lane] = __expf(al_); o_[64 + lane] = __expf(al_ + Mc); o_[128 + lane] = __expf(-mt_); \
        if (lane == 0) { o_[192] = __expf(gg_ + Mc - Mn_); o_[193] = __expf(gg_ - Mn_); } Mc = Mn_; } while (0)

    f32x16 C;
#pragma unroll
    for (int r = 0; r < 16; ++r) C[r] = 0.f;
    const int dq = wave & 3, eh2 = wave >> 2;
    const int kch_ = 4 * dq + 2 * tc16_ + (tp_ >> 1);
    const int kt0 = 256 * (8 * g + tq_) + 16 * (kch_ ^ ((tq_ << 2) | (2 * g))) + 8 * (tp_ & 1), kt1 = 256 * (8 * g + 4 + tq_) + 16 * (kch_ ^ ((tq_ << 2) | (2 * g + 1))) + 8 * (tp_ & 1);
    for (int i = tid; i < 64 * QP / 2; i += 512) ((LAS unsigned*)CT)[i] = 0u;
    if (tid < 128) Nv[tid] = 0.f;
#pragma unroll
    for (int k = 0; k < 4; ++k) *(LAS f32x4*)(BPL + (tid + 512 * k) * 4) = *(const f32x4*)(bp + (tid + 512 * k) * 4);
    asm volatile("s_waitcnt vmcnt(0)" ::: "memory");
    TILE_LOAD(0, pfA, rkA); TILE_WAIT(0, pfA, rkA); TILE_WRITE(pfA, rkA);
    TILE_LOAD(1, pfB, rkB); TILE_LOAD(2, pfA, rkA);
    __syncthreads();
    if (wave == 4) GATE_SCAN(0, 0);
    __syncthreads();

    for (int c2 = 0; c2 < 64; c2 += 2) {
        { const int c = c2; const int cur = c & 1; LAS float* gb = GB(cur);
        if (wave == 4 && c + 1 < 64) GATE_SCAN(c + 1, cur ^ 1);
        { const int t = tid >> 3, d0 = (tid & 7) * 16; float s = 0.f;
#pragma unroll
          for (int k = 0; k < 2; ++k) { const v4u q8 = *(const LAS v4u*)(Qs + t * QP + d0 + 8 * k); const f32x4 n0 = *(const LAS f32x4*)(Nv + d0 + 8 * k), n1 = *(const LAS f32x4*)(Nv + d0 + 8 * k + 4);
              s += bflo(q8.x) * n0[0] + bfhi(q8.x) * n0[1] + bflo(q8.y) * n0[2] + bfhi(q8.y) * n0[3] + bflo(q8.z) * n1[0] + bfhi(q8.z) * n1[1] + bflo(q8.w) * n1[2] + bfhi(q8.w) * n1[3]; }
          s += __shfl_xor(s, 1); s += __shfl_xor(s, 2); s += __shfl_xor(s, 4);
          if ((tid & 7) == 0) QN[t] = s; }
        f32x16 acc;
#pragma unroll
        for (int r = 0; r < 16; ++r) acc[r] = 0.f;
        const int th = (wave & 3) >> 1, xh = wave & 1;
        const int t = 32 * th + l31;
        if (wave < 4) {
#pragma unroll
            for (int kk = 0; kk < 8; ++kk) { const bf16x8 av = *(const LAS bf16x8*)(KsB + 256 * (32 * xh + l31) + 16 * ((2 * kk + g) ^ KSWZ(l31))), bv = *(const LAS bf16x8*)(Qs + t * QP + kk * 16 + 8 * g);
                acc = __builtin_amdgcn_mfma_f32_32x32x16_bf16(av, bv, acc, 0, 0, 0); }
            const float ea = gb[t]; float rsum = 0.f;
#pragma unroll
            for (int i = 0; i < 4; ++i) { float wv[4];
#pragma unroll
                for (int e = 0; e < 4; ++e) { const int s = 32 * xh + 8 * i + 4 * g + e; wv[e] = (s <= t) ? acc[4 * i + e] * ea : 0.f; rsum += wv[e]; }
                v2u w2; w2.x = pk2(wv[0], wv[1]); w2.y = pk2(wv[2], wv[3]); *(LAS v2u*)(Ws + t * SP + 32 * xh + 8 * i + 4 * g) = w2; }
            rsum += __shfl_xor(rsum, 32);
            if (g == 0) RS[xh * 64 + t] = rsum;
        } else {
#pragma unroll
            for (int kk = 0; kk < 8; ++kk) { const bf16x8 av = *(const LAS bf16x8*)(CT + (32 * xh + l31) * QP + kk * 16 + 8 * g), bv = *(const LAS bf16x8*)(Qs + t * QP + kk * 16 + 8 * g);
                acc = __builtin_amdgcn_mfma_f32_32x32x16_bf16(av, bv, acc, 0, 0, 0); }
            const float ei = gb[64 + t];
#pragma unroll
            for (int r = 0; r < 16; ++r) acc[r] *= ei;
        }
        ML_BAR();
        if (wave >= 4) {
#pragma unroll
            for (int kk = 0; kk < 4; ++kk) { const bf16x8 av = TRF(VsB + vtrb + 2048 * kk + 512 * xh), bv = *(const LAS bf16x8*)(Ws + t * SP + kk * 16 + 8 * g);
                acc = __builtin_amdgcn_mfma_f32_32x32x16_bf16(av, bv, acc, 0, 0, 0); }
            const float den = gb[64 + t] * QN[t] + RS[t] + RS[64 + t];
            const float inv = 1.0f / fmaxf(fabsf(den), gb[128 + t]);
            bf16* hp = h_base + (size_t)(c * 64 + t) * 512 + 32 * xh + 4 * g;
#pragma unroll
            for (int i = 0; i < 4; ++i) { v2u o; o.x = pk2(acc[4 * i] * inv, acc[4 * i + 1] * inv); o.y = pk2(acc[4 * i + 2] * inv, acc[4 * i + 3] * inv); *(v2u*)(hp + 8 * i) = o; }
        }
        const float decay = gb[192], ff = gb[193];
        { f32x16 P;
#pragma unroll
          for (int r = 0; r < 16; ++r) P[r] = 0.f;
#pragma unroll
          for (int kk = 0; kk < 4; ++kk) { const bf16x8 av = tr_frag(KsB + kt0 + 4096 * kk, KsB + kt1 + 4096 * kk), bv = TRF(VsB + vtrb + 2048 * kk + 512 * eh2);
              P = __builtin_amdgcn_mfma_f32_32x32x16_bf16(av, bv, P, 0, 0, 0); }
#pragma unroll
          for (int r = 0; r < 16; ++r) C[r] = decay * C[r] + ff * P[r]; }
        float nnew = 0.f;
        if (tid < 128) nnew = decay * Nv[tid] + ff * RK[tid];
        ML_BAR();
#pragma unroll
        for (int i = 0; i < 4; ++i) { v2u o; o.x = pk2(C[4 * i], C[4 * i + 1]); o.y = pk2(C[4 * i + 2], C[4 * i + 3]); *(LAS v2u*)(CT + (32 * eh2 + l31) * QP + 32 * dq + 8 * i + 4 * g) = o; }
        if (tid < 128) Nv[tid] = nnew;
        if (c + 1 < 64) { if (c + 2 < 64) TILE_WAIT(6, pfB, rkB); else TILE_WAIT(0, pfB, rkB); TILE_WRITE(pfB, rkB); }
        if (c + 3 < 64) TILE_LOAD(c + 3, pfB, rkB);
        ML_BAR();
                }
        { const int c = c2 + 1; const int cur = c & 1; LAS float* gb = GB(cur);
        if (wave == 4 && c + 1 < 64) GATE_SCAN(c + 1, cur ^ 1);
        { const int t = tid >> 3, d0 = (tid & 7) * 16; float s = 0.f;
#pragma unroll
          for (int k = 0; k < 2; ++k) { const v4u q8 = *(const LAS v4u*)(Qs + t * QP + d0 + 8 * k); const f32x4 n0 = *(const LAS f32x4*)(Nv + d0 + 8 * k), n1 = *(const LAS f32x4*)(Nv + d0 + 8 * k + 4);
              s += bflo(q8.x) * n0[0] + bfhi(q8.x) * n0[1] + bflo(q8.y) * n0[2] + bfhi(q8.y) * n0[3] + bflo(q8.z) * n1[0] + bfhi(q8.z) * n1[1] + bflo(q8.w) * n1[2] + bfhi(q8.w) * n1[3]; }
          s += __shfl_xor(s, 1); s += __shfl_xor(s, 2); s += __shfl_xor(s, 4);
          if ((tid & 7) == 0) QN[t] = s; }
        f32x16 acc;
#pragma unroll
        for (int r = 0; r < 16; ++r) acc[r] = 0.f;
        const int th = (wave & 3) >> 1, xh = wave & 1;
        const int t = 32 * th + l31;
        if (wave < 4) {
#pragma unroll
            for (int kk = 0; kk < 8; ++kk) { const bf16x8 av = *(const LAS bf16x8*)(KsB + 256 * (32 * xh + l31) + 16 * ((2 * kk + g) ^ KSWZ(l31))), bv = *(const LAS bf16x8*)(Qs + t * QP + kk * 16 + 8 * g);
                acc = __builtin_amdgcn_mfma_f32_32x32x16_bf16(av, bv, acc, 0, 0, 0); }
            const float ea = gb[t]; float rsum = 0.f;
#pragma unroll
            for (int i = 0; i < 4; ++i) { float wv[4];
#pragma unroll
                for (int e = 0; e < 4; ++e) { const int s = 32 * xh + 8 * i + 4 * g + e; wv[e] = (s <= t) ? acc[4 * i + e] * ea : 0.f; rsum += wv[e]; }
                v2u w2; w2.x = pk2(wv[0], wv[1]); w2.y = pk2(wv[2], wv[3]); *(LAS v2u*)(Ws + t * SP + 32 * xh + 8 * i + 4 * g) = w2; }
            rsum += __shfl_xor(rsum, 32);
            if (g == 0) RS[xh * 64 + t] = rsum;
        } else {
#pragma unroll
            for (int kk = 0; kk < 8; ++kk) { const bf16x8 av = *(const LAS bf16x8*)(CT + (32 * xh + l31) * QP + kk * 16 + 8 * g), bv = *(const LAS bf16x8*)(Qs + t * QP + kk * 16 + 8 * g);
                acc = __builtin_amdgcn_mfma_f32_32x32x16_bf16(av, bv, acc, 0, 0, 0); }
            const float ei = gb[64 + t];
#pragma unroll
            for (int r = 0; r < 16; ++r) acc[r] *= ei;
        }
        ML_BAR();
        if (wave >= 4) {
#pragma unroll
            for (int kk = 0; kk < 4; ++kk) { const bf16x8 av = TRF(VsB + vtrb + 2048 * kk + 512 * xh), bv = *(const LAS bf16x8*)(Ws + t * SP + kk * 16 + 8 * g);
                acc = __builtin_amdgcn_mfma_f32_32x32x16_bf16(av, bv, acc, 0, 0, 0); }
            const float den = gb[64 + t] * QN[t] + RS[t] + RS[64 + t];
            const float inv = 1.0f / fmaxf(fabsf(den), gb[128 + t]);
            bf16* hp = h_base + (size_t)(c * 64 + t) * 512 + 32 * xh + 4 * g;
#pragma unroll
            for (int i = 0; i < 4; ++i) { v2u o; o.x = pk2(acc[4 * i] * inv, acc[4 * i + 1] * inv); o.y = pk2(acc[4 * i + 2] * inv, acc[4 * i + 3] * inv); *(v2u*)(hp + 8 * i) = o; }
        }
        const float decay = gb[192], ff = gb[193];
        { f32x16 P;
#pragma unroll
          for (int r = 0; r < 16; ++r) P[r] = 0.f;
#pragma unroll
          for (int kk = 0; kk < 4; ++kk) { const bf16x8 av = tr_frag(KsB + kt0 + 4096 * kk, KsB + kt1 + 4096 * kk), bv = TRF(VsB + vtrb + 2048 * kk + 512 * eh2);
              P = __builtin_amdgcn_mfma_f32_32x32x16_bf16(av, bv, P, 0, 0, 0); }
#pragma unroll
          for (int r = 0; r < 16; ++r) C[r] = decay * C[r] + ff * P[r]; }
        float nnew = 0.f;
        if (tid < 128) nnew = decay * Nv[tid] + ff * RK[tid];
        ML_BAR();
#pragma unroll
        for (int i = 0; i < 4; ++i) { v2u o; o.x = pk2(C[4 * i], C[4 * i + 1]); o.y = pk2(C[4 * i + 2], C[4 * i + 3]); *(LAS v2u*)(CT + (32 * eh2 + l31) * QP + 32 * dq + 8 * i + 4 * g) = o; }
        if (tid < 128) Nv[tid] = nnew;
        if (c + 1 < 64) { if (c + 2 < 64) TILE_WAIT(6, pfA, rkA); else TILE_WAIT(0, pfA, rkA); TILE_WRITE(pfA, rkA); }
        if (c + 3 < 64) TILE_LOAD(c + 3, pfA, rkA);
        ML_BAR();
                }
    }
    asm volatile("s_waitcnt vmcnt(0)" ::: "memory");
#undef GB
#undef ML_BAR
#undef TILE_LOAD
#undef TILE_WRITE
#undef TILE_WAIT
#undef KSWZ
#undef TRF
#undef ALOAD4
#undef ALOAD1
#undef GATE_SCAN
}

__device__ __forceinline__ unsigned xcc_id() { return (unsigned)__builtin_amdgcn_s_getreg((3 << 11) | 20) & 7u; }
__device__ __forceinline__ void mix_phase(const Args& a, unsigned char* lds_generic, LAS unsigned char* lds, int coff, bool do_ml, bool do_attn) {
    const int tid = __tid_l();
    unsigned* ctr = (unsigned*)(a.ws + WS_CTL) + coff * 64;
    volatile LAS int* MISC = (volatile LAS int*)(lds + MISC_OFF);
    const unsigned myx = xcc_id();
    const attn_body::bf16* Q = (const attn_body::bf16*)(a.ws + WS_Q); const attn_body::bf16* K = (const attn_body::bf16*)(a.ws + WS_K);
    const attn_body::bf16* V = (const attn_body::bf16*)(a.ws + WS_V); attn_body::bf16* AO = (attn_body::bf16*)(a.ws + WS_AO);
    if (do_ml) for (;;) {
        if (tid == 0) { int found = -1;
            const unsigned j0 = __hip_atomic_fetch_add(ctr + (8 + myx) * 64, 1u, __ATOMIC_RELAXED, __HIP_MEMORY_SCOPE_AGENT);
            if (j0 < 8u) found = (int)(myx * 8u + j0);
            else { unsigned cnt[7];
#pragma unroll
                for (unsigned dx = 1; dx < 8; ++dx) cnt[dx - 1] = __hip_atomic_load(ctr + (8 + ((myx + dx) & 7u)) * 64, __ATOMIC_RELAXED, __HIP_MEMORY_SCOPE_AGENT);
#pragma unroll
                for (unsigned dx = 1; dx < 8; ++dx) if (found < 0 && cnt[dx - 1] < 8u) { const unsigned x = (myx + dx) & 7u; const unsigned j = __hip_atomic_fetch_add(ctr + (8 + x) * 64, 1u, __ATOMIC_RELAXED, __HIP_MEMORY_SCOPE_AGENT);
                    if (j < 8u) found = (int)(x * 8u + j); } }
            MISC[0] = found; }
        __syncthreads();
        const int f = __builtin_amdgcn_readfirstlane(MISC[0]);
        __syncthreads();
        if (f < 0) break;
        mlstm_item(a, f, lds);
        __syncthreads();
    }
    if (do_attn) {
        if (tid == 0) { int found = -1;
            const unsigned j0 = __hip_atomic_fetch_add(ctr + myx * 64, 1u, __ATOMIC_RELAXED, __HIP_MEMORY_SCOPE_AGENT);
            if (j0 < 256u) found = (int)(myx * 256u + j0);
            else { unsigned cnt[7];
#pragma unroll
                for (unsigned dx = 1; dx < 8; ++dx) cnt[dx - 1] = __hip_atomic_load(ctr + ((myx + dx) & 7u) * 64, __ATOMIC_RELAXED, __HIP_MEMORY_SCOPE_AGENT);
#pragma unroll
                for (unsigned dx = 1; dx < 8; ++dx) if (found < 0 && cnt[dx - 1] < 256u) { const unsigned x = (myx + dx) & 7u; const unsigned j = __hip_atomic_fetch_add(ctr + x * 64, 1u, __ATOMIC_RELAXED, __HIP_MEMORY_SCOPE_AGENT);
                    if (j < 256u) found = (int)(x * 256u + j); } }
            MISC[0] = found; }
        __syncthreads();
        int f = __builtin_amdgcn_readfirstlane(MISC[0]);
        __syncthreads();
        while (f >= 0) {
            const int x = f >> 8, jj = f & 255, qb = 15 - ((jj & 63) >> 2), bh = x + 8 * ((jj >> 6) * 4 + (jj & 3)), b = bh >> 4, hp = bh & 15;
            unsigned nj = 0u;
            if (tid == 0) nj = __hip_atomic_fetch_add(ctr + x * 64, 1u, __ATOMIC_RELAXED, __HIP_MEMORY_SCOPE_AGENT);
            attn_body::attn_unit<8>(b, (hp >> 1) * 64, ((hp >> 2) * 2 + (hp & 1)) * 64, hp * 64, qb, Q, K, V, AO, (char*)lds_generic);
            if (tid == 0) { int found = -1;
                if (nj < 256u) found = x * 256 + (int)nj;
                else { unsigned cnt[7];
#pragma unroll
                    for (unsigned dx = 1; dx < 8; ++dx) cnt[dx - 1] = __hip_atomic_load(ctr + (((unsigned)x + dx) & 7u) * 64, __ATOMIC_RELAXED, __HIP_MEMORY_SCOPE_AGENT);
#pragma unroll
                    for (unsigned dx = 1; dx < 8; ++dx) if (found < 0 && cnt[dx - 1] < 256u) { const unsigned x2 = ((unsigned)x + dx) & 7u; const unsigned j = __hip_atomic_fetch_add(ctr + x2 * 64, 1u, __ATOMIC_RELAXED, __HIP_MEMORY_SCOPE_AGENT);
                        if (j < 256u) found = (int)(x2 * 256u + j); } }
                MISC[0] = found; }
            __syncthreads();
            f = __builtin_amdgcn_readfirstlane(MISC[0]);
            __syncthreads();
        }
    }
}

__device__ __forceinline__ void combine_phase(const Args& a) {
    const int tid = __tid_l(), lane = tid & 63, wave = __builtin_amdgcn_readfirstlane(tid >> 6), G = gridDim.x, bx = blockIdx.x;
    const bf16* AO = (const bf16*)(a.ws + WS_AO); const bf16* MLH = (const bf16*)(a.ws + WS_MLH); const bf16* MLO = (const bf16*)(a.ws + WS_MLO); bf16* Y = (bf16*)(a.ws + WS_HN);
    const float* lq = a.in[I_LAMQK];
    const float lam = __expf(wave_sum(lq[lane] * lq[64 + lane])) - __expf(wave_sum(lq[128 + lane] * lq[192 + lane])) + 0.2f;
    const int head = lane >> 4, vh = (lane >> 3) & 1, d = (lane & 7) * 8;
    float gda[8], gml[8];
#pragma unroll
    for (int i = 0; i < 8; ++i) { gda[i] = a.in[I_GDA][(lane & 15) * 8 + i] * 0.8f; gml[i] = a.in[I_GML][lane * 8 + i]; }
    const int gw = bx * 8 + wave, NGW = G * 8;
    for (int rb = gw; rb < TOK / 16; rb += NGW) {
#pragma unroll 2
        for (int r = 0; r < 16; ++r) {
            const size_t row = (size_t)rb * 16 + r;
            const v4u a0 = *(const v4u*)(AO + row * 1024 + ((head * 2 + 0) * 2 + vh) * 64 + d), a1 = *(const v4u*)(AO + row * 1024 + ((head * 2 + 1) * 2 + vh) * 64 + d);
            const v4u hh = *(const v4u*)(MLH + row * 512 + lane * 8), oo = *(const v4u*)(MLO + row * 512 + lane * 8);
            const unsigned a0w[4] = {a0.x, a0.y, a0.z, a0.w}, a1w[4] = {a1.x, a1.y, a1.z, a1.w}, hw[4] = {hh.x, hh.y, hh.z, hh.w}, ow[4] = {oo.x, oo.y, oo.z, oo.w};
            float o[8], hv[8], s1 = 0.f, s2 = 0.f;
#pragma unroll
            for (int i = 0; i < 4; ++i) { o[2 * i] = bflo(a0w[i]) - lam * bflo(a1w[i]); o[2 * i + 1] = bfhi(a0w[i]) - lam * bfhi(a1w[i]); hv[2 * i] = bflo(hw[i]); hv[2 * i + 1] = bfhi(hw[i]);
                s1 += o[2 * i] * o[2 * i] + o[2 * i + 1] * o[2 * i + 1]; s2 += hv[2 * i] * hv[2 * i] + hv[2 * i + 1] * hv[2 * i + 1]; }
#pragma unroll
            for (int m = 1; m < 16; m <<= 1) { s1 += __shfl_xor(s1, m); s2 += __shfl_xor(s2, m); }
            const float r1 = 1.0f / sqrtf(s1 * (1.0f / 128.0f) + 1e-6f), r2 = 1.0f / sqrtf(s2 * (1.0f / 128.0f) + 1e-6f);
            float y1[8], y2[8];
#pragma unroll
            for (int i = 0; i < 8; ++i) { const float op = (i & 1) ? bfhi(ow[i >> 1]) : bflo(ow[i >> 1]);
                y1[i] = o[i] * r1 * gda[i]; y2[i] = hv[i] * r2 * gml[i] / (1.0f + __expf(-op)); }
            v4u w1, w2; w1.x = pk2(y1[0], y1[1]); w1.y = pk2(y1[2], y1[3]); w1.z = pk2(y1[4], y1[5]); w1.w = pk2(y1[6], y1[7]);
            w2.x = pk2(y2[0], y2[1]); w2.y = pk2(y2[2], y2[3]); w2.z = pk2(y2[4], y2[5]); w2.w = pk2(y2[6], y2[7]);
            *(v4u*)(Y + row * 1024 + lane * 8) = w1; *(v4u*)(Y + row * 1024 + 512 + lane * 8) = w2;
        }
    }
}

constexpr int N_PHASES = 13;
#ifndef DUP_MASK
#define DUP_MASK 0
#endif
__global__ void __launch_bounds__(512, 2) mk_fwd(Args a) {
    extern __shared__ __attribute__((aligned(16))) unsigned char lds_raw[];
    LAS unsigned char* lds = (LAS unsigned char*)lds_raw;
    cg::grid_group grid = cg::this_grid();
    { volatile LAS unsigned* M_ = (volatile LAS unsigned*)(lds + MISC_OFF); if (threadIdx.x < 32) M_[threadIdx.x] = 0u; __syncthreads(); }
    XcdBarrier xbar = xcd_barrier_post((unsigned*)(a.ws + WS_CTL) + 4096, (volatile LAS unsigned*)(lds + MISC_OFF) + 8);
    if (a.ph_lo < 0) grid.sync();
    const int lo = a.ph_lo, hi = a.ph_hi, G = gridDim.x, bx = blockIdx.x;
    unsigned char* ws = a.ws;
    const float* mod = (const float*)(ws + WS_MOD);
    bf16* HN = (bf16*)(ws + WS_HN); bf16* HID = (bf16*)(ws + WS_HID);
    bf16* X1 = (bf16*)a.out;
    bf16* X2 = (bf16*)(ws + WS_MLV);
#define IN(k) (lo <= (k) && (k) < hi)
#define REP(k) for (int rep_ = 0; rep_ <= ((DUP_MASK >> (k)) & 1); ++rep_)
#define RSYNC() do { if (rep_) xcd_barrier(xbar); } while (0)
#define SEAM(k) do { if (IN(k) && IN((k) + 1)) xcd_barrier(xbar); } while (0)
    if (IN(0)) REP(0) { RSYNC(); p0_prologue(a, lds); } SEAM(0);
    if (DUP_MASK & 0x4000) { for (int i_ = 0; i_ < 10; ++i_) xcd_barrier(xbar); }
    if (IN(1)) REP(1) { RSYNC(); norm_phase<false, false>(a, a.in[I_X], 0, lds); } SEAM(1);
    if (IN(2)) REP(2) { RSYNC(); pg8::Gemm g{HN, (const bf16*)(ws + WS_W12A), TOK, 2 * FF, DM}; pg8::StaticOrder S; S.init(TOK, 2 * FF, G, bx);
        pg8::EpiSwiGLU E{HID, FF}; pg8::gemm_phase<pg8::EpiSwiGLU, pg8::StaticOrder, true, true>(lds, g, S, E); } SEAM(2);
    if (IN(3)) REP(3) { RSYNC(); pg8::Gemm g{HID, (const bf16*)(ws + WS_W3A), TOK, DM, FF}; pg8::StaticOrder S; S.init(TOK, DM, G, bx);
        pg8::EpiResid<0, 1> E{a.in[I_X], X1, mod + 2 * 1024, 0.5f}; pg8::gemm_phase<pg8::EpiResid<0, 1>, pg8::StaticOrder, true, true>(lds, g, S, E); } SEAM(3);
    if (IN(4)) REP(4) { RSYNC(); norm_phase<true, true>(a, X1, 1, lds); } SEAM(4);
    if (IN(5)) REP(5) { RSYNC(); pg8::Gemm g{HN, (const bf16*)(ws + WS_WIN), TOK, NINP, DM}; pg8::StaticOrder S; S.init(TOK, NINP, G, bx);
        pg8::EpiMix E{(bf16*)(ws + WS_Q), (bf16*)(ws + WS_K), (bf16*)(ws + WS_V), (bf16*)(ws + WS_MLQK), (bf16*)(ws + WS_MLV), (bf16*)(ws + WS_MLO), a.in[I_GQ], a.in[I_GK], (const float*)(ws + WS_ROPE), C2Q};
        pg8::gemm_phase<pg8::EpiMix, pg8::StaticOrder, true, true>(lds, g, S, E); } SEAM(5);
    if (IN(6)) REP(6) { RSYNC(); mlprep_phase(a, lds); } SEAM(6);
    if (IN(7)) { mix_phase(a, lds_raw, lds, 0, true, true); if (DUP_MASK & 0x80) { xcd_barrier(xbar); mix_phase(a, lds_raw, lds, 16, true, true); } if (DUP_MASK & 0x1000) { xcd_barrier(xbar); mix_phase(a, lds_raw, lds, 32, true, false); } if (DUP_MASK & 0x2000) { xcd_barrier(xbar); mix_phase(a, lds_raw, lds, 48, false, true); } } SEAM(7);
    if (IN(8)) REP(8) { RSYNC(); combine_phase(a); } SEAM(8);
    if (IN(9)) { pg8::Gemm g{HN, (const bf16*)(ws + WS_WOUT), TOK, DM, DM}; pg8::StaticOrder S; S.init(TOK, DM, G, bx);
        pg8::EpiResidXg E{X1, X2, mod + 5 * 1024, 1.0f, (bf16*)(ws + WS_XG3), a.in[I_GNORM] + 2048, mod + 7 * 1024, (float*)(ws + WS_RSS)}; pg8::gemm_phase<pg8::EpiResidXg, pg8::StaticOrder, true, true>(lds, g, S, E); } SEAM(9);
    if (IN(11)) REP(11) { RSYNC(); pg8::Gemm g{(const bf16*)(ws + WS_XG3), (const bf16*)(ws + WS_W12B), TOK, 2 * FF, DM}; pg8::StaticOrder S; S.init(TOK, 2 * FF, G, bx);
        pg8::EpiSwiGLUN E{HID, FF, (const float*)(ws + WS_RSS), (const float*)(ws + WS_SB3), 2 * FF}; pg8::gemm_phase<pg8::EpiSwiGLUN, pg8::StaticOrder, true, true>(lds, g, S, E); } SEAM(11);
    if (IN(12)) { pg8::Gemm g{HID, (const bf16*)(ws + WS_W3B), TOK, DM, FF}; pg8::StaticOrder S; S.init(TOK, DM, G, bx);
        pg8::EpiResid<1, 0> E{X2, a.out, mod + 8 * 1024, 0.5f}; pg8::gemm_phase<pg8::EpiResid<1, 0>, pg8::StaticOrder, true, true>(lds, g, S, E); }
#undef IN
#undef SEAM
}

#ifndef MK_MULTI
#define MK_MULTI 0
#endif
extern "C" void kernel_launch(void* const* d_in, const int* in_sizes, int n_in, void* d_out, int out_size, void* d_ws, size_t ws_size, hipStream_t stream) {
    static int grid = 0;
    if (grid == 0) {
        if (n_in != 20 || out_size != TOK * DM || ws_size < WS_END) { fprintf(stderr, "kernel_launch: unexpected shapes (n_in %d out %d ws %zu)\n", n_in, out_size, ws_size); grid = -1; return; }
        int dev = 0, cus = 0, per_cu = 0;
        hipGetDevice(&dev); hipDeviceGetAttribute(&cus, hipDeviceAttributeMultiprocessorCount, dev);
        if (hipFuncSetAttribute((const void*)mk_fwd, hipFuncAttributeMaxDynamicSharedMemorySize, LDS_BYTES) != hipSuccess) { fprintf(stderr, "kernel_launch: hipFuncSetAttribute failed\n"); grid = -1; return; }
        hipOccupancyMaxActiveBlocksPerMultiprocessor(&per_cu, (const void*)mk_fwd, 512, LDS_BYTES);
        (void)hipGetLastError();
        if (per_cu < 1) fprintf(stderr, "kernel_launch: occupancy query says %d blocks per CU\n", per_cu);
        grid = cus > 0 ? cus : 256;
    }
    if (grid < 0) return;
    if (hipMemsetAsync((char*)d_ws + WS_CTL, 0, 32768, stream) != hipSuccess) { fprintf(stderr, "kernel_launch: hipMemsetAsync failed\n"); return; }
    Args a{};
    for (int i = 0; i < 20; ++i) a.in[i] = (const float*)d_in[i];
    a.out = (float*)d_out; a.ws = (unsigned char*)d_ws;
#if MK_MULTI
    for (int p = 0; p < N_PHASES; ++p) { a.ph_lo = p; a.ph_hi = p + 1; hipLaunchKernelGGL(mk_fwd, dim3(grid), dim3(512), LDS_BYTES, stream, a); }
#else
    a.ph_lo = 0; a.ph_hi = N_PHASES;
    void* args[] = {&a};
    hipError_t e = hipLaunchCooperativeKernel((const void*)mk_fwd, dim3(grid), dim3(512), args, LDS_BYTES, stream);
    if (e != hipSuccess) fprintf(stderr, "kernel_launch: cooperative launch failed: %s (grid %d)\n", hipGetErrorString(e), grid);
#endif
}
```

```cpp
#include <hip/hip_runtime.h>
#include <hip/hip_cooperative_groups.h>
#include <cstdio>
#include <cstdint>
__device__ __forceinline__ int __tid_l() { int t = threadIdx.x; asm volatile("" : "+v"(t)); return t; }
namespace pg8 {
#define PG8_LAS __attribute__((address_space(3)))
typedef unsigned short bf16_t;
typedef short bf16x8 __attribute__((ext_vector_type(8)));
typedef float f32x4 __attribute__((ext_vector_type(4)));
typedef unsigned u32x4 __attribute__((ext_vector_type(4)));
constexpr int BM = 256, BK = 64, HALF = 128, HTB = HALF * BK * 2  , STAGE_BYTES = 8 * HTB, NXCD = 8, WGM = 8;

__host__ __device__ __forceinline__ int lds_byte(int r, int c) { const int st = (r >> 4) * 2 + (c >> 5), rr = r & 15, cc = c & 31, ob = rr * 64 + cc * 2; return st * 1024 + (ob ^ (((ob >> 9) & 1) << 5)); }
__host__ __device__ __forceinline__ void stage_rc(int b, int& R, int& C) { const int st = b / 1024, sb = b % 1024, swz = sb ^ (((sb >> 9) & 1) << 5); R = (st >> 1) * 16 + swz / 64; C = (st & 1) * 32 + (swz % 64) / 2; }
__host__ __device__ __forceinline__ int perm32(int rho) { const int n = rho >> 4, i = rho & 15; return 8 * (i >> 2) + 4 * n + (i & 3); }

struct Unit { int pm, pn; };
struct Gemm { const bf16_t* A; const bf16_t* Bt; int M, N, K; };

struct StaticOrder {
    int nM, nN, nwg, G, c;
    __host__ __device__ void init(int M, int N, int G_, int c_) { nM = M / BM; nN = N / BM; nwg = nM * nN; G = G_; c = c_; }
    __host__ __device__ bool next(int i, Unit& u) const {
        const long L = (long)i * G + c; if (L >= nwg) return false;
        int wgid = (int)L; { const int q = nwg / NXCD, r = nwg % NXCD, xcd = wgid % NXCD, off = wgid / NXCD; wgid = (xcd < r ? xcd * (q + 1) : r * (q + 1) + (xcd - r) * q) + off; }
        const int nig = WGM * nN, gid = wgid / nig, fm = gid * WGM, gsz = (nM - fm) < WGM ? (nM - fm) : WGM;
        u.pm = fm + ((wgid % nig) % gsz); u.pn = (wgid % nig) / gsz; return true;
    }
    __device__ __forceinline__ void a_ready(const Unit&) const {}
    __device__ __forceinline__ void done(const Unit&) const {}
};

__device__ __forceinline__ unsigned cvt_pk_bf16(float lo, float hi) { unsigned r; asm volatile("v_cvt_pk_bf16_f32 %0, %1, %2" : "=v"(r) : "v"(lo), "v"(hi)); return r; }
__device__ __forceinline__ f32x4 silu4(f32x4 x) {
    f32x4 r;
#pragma unroll
    for (int i = 0; i < 4; ++i) r[i] = x[i] * __builtin_amdgcn_rcpf(1.0f + __builtin_amdgcn_exp2f(-1.4426950408889634f * x[i]));
    return r;
}
struct EpiSwiGLU {
    static constexpr bool PERM = true, AFTER_DRAIN = false;
    bf16_t* O; int ldo;
    __device__ __forceinline__ void operator()(const f32x4 (&acc)[2][2][4][2], const Unit& u, int wr, int wc, int fr, int fq) const {
        const int row0 = u.pm * BM + wr * 64 + fr, col0 = u.pn * HALF + wc * 32 + 8 * fq;
#pragma unroll
        for (int ai = 0; ai < 2; ++ai)
#pragma unroll
            for (int m = 0; m < 4; ++m) {
                bf16_t* p = O + (size_t)(row0 + ai * HALF + m * 16) * ldo + col0;
                const f32x4 h0 = silu4(acc[ai][0][m][0]) * acc[ai][1][m][0], h1 = silu4(acc[ai][0][m][1]) * acc[ai][1][m][1];
                u32x4 w; w.x = cvt_pk_bf16(h0[0], h0[1]); w.y = cvt_pk_bf16(h0[2], h0[3]); w.z = cvt_pk_bf16(h1[0], h1[1]); w.w = cvt_pk_bf16(h1[2], h1[3]);
                *(u32x4*)p = w;
            }
    }
};
template <int BT, int OT>
struct EpiResid {
    static constexpr bool PERM = true, AFTER_DRAIN = false;
    const void* base; void* out; const float* gate; float gs;
    __device__ __forceinline__ void operator()(const f32x4 (&acc)[2][2][4][2], const Unit& u, int wr, int wc, int fr, int fq) const {
        const int row0 = u.pm * BM + wr * 64 + fr, col0 = u.pn * BM + wc * 32 + 8 * fq;
        const float* gp = gate + (size_t)(u.pm >> 4) * 9216 + col0;
        f32x4 gv[2][2];
#pragma unroll
        for (int bj = 0; bj < 2; ++bj)
#pragma unroll
            for (int n = 0; n < 2; ++n) gv[bj][n] = (*(const f32x4*)(gp + bj * HALF + 4 * n) + 1.0f) * gs;
#pragma unroll
        for (int ai = 0; ai < 2; ++ai) {
            f32x4 pre[4][2][2];
#pragma unroll
            for (int m = 0; m < 4; ++m) { const size_t off = (size_t)(row0 + ai * HALF + m * 16) * 1024 + col0;
#pragma unroll
                for (int bj = 0; bj < 2; ++bj) {
                    if (BT == 0) { pre[m][bj][0] = *(const f32x4*)((const float*)base + off + bj * HALF); pre[m][bj][1] = *(const f32x4*)((const float*)base + off + bj * HALF + 4); }
                    else { const u32x4 w = *(const u32x4*)((const bf16_t*)base + off + bj * HALF);
                        pre[m][bj][0] = (f32x4){__builtin_bit_cast(float, w.x << 16), __builtin_bit_cast(float, w.x & 0xffff0000u), __builtin_bit_cast(float, w.y << 16), __builtin_bit_cast(float, w.y & 0xffff0000u)};
                        pre[m][bj][1] = (f32x4){__builtin_bit_cast(float, w.z << 16), __builtin_bit_cast(float, w.z & 0xffff0000u), __builtin_bit_cast(float, w.w << 16), __builtin_bit_cast(float, w.w & 0xffff0000u)}; } } }
            asm volatile("" ::: "memory");
#pragma unroll
            for (int m = 0; m < 4; ++m) { const size_t off = (size_t)(row0 + ai * HALF + m * 16) * 1024 + col0;
#pragma unroll
                for (int bj = 0; bj < 2; ++bj) { const f32x4 o0 = pre[m][bj][0] + gv[bj][0] * acc[ai][bj][m][0], o1 = pre[m][bj][1] + gv[bj][1] * acc[ai][bj][m][1];
                    if (OT == 0) { *(f32x4*)((float*)out + off + bj * HALF) = o0; *(f32x4*)((float*)out + off + bj * HALF + 4) = o1; }
                    else { u32x4 w; w.x = cvt_pk_bf16(o0[0], o0[1]); w.y = cvt_pk_bf16(o0[2], o0[3]); w.z = cvt_pk_bf16(o1[0], o1[1]); w.w = cvt_pk_bf16(o1[2], o1[3]); *(u32x4*)((bf16_t*)out + off + bj * HALF) = w; } } }
            asm volatile("" ::: "memory");
        }
    }
};
struct EpiResidXg {
    static constexpr bool PERM = true, AFTER_DRAIN = false;
    const bf16_t* base; bf16_t* out; const float* gate; float gs; bf16_t* xg; const float* gn; const float* scn; float* rss;
    __device__ __forceinline__ void operator()(const f32x4 (&acc)[2][2][4][2], const Unit& u, int wr, int wc, int fr, int fq) const {
        const int row0 = u.pm * BM + wr * 64 + fr, col0 = u.pn * BM + wc * 32 + 8 * fq;
        const float* gp = gate + (size_t)(u.pm >> 4) * 9216 + col0; const float* sp = scn + (size_t)(u.pm >> 4) * 9216 + col0;
        f32x4 gv[2][2], gsn[2][2];
#pragma unroll
        for (int bj = 0; bj < 2; ++bj)
#pragma unroll
            for (int n = 0; n < 2; ++n) { gv[bj][n] = (*(const f32x4*)(gp + bj * HALF + 4 * n) + 1.0f) * gs; gsn[bj][n] = *(const f32x4*)(gn + col0 + bj * HALF + 4 * n) * (*(const f32x4*)(sp + bj * HALF + 4 * n) + 1.0f); }
#pragma unroll
        for (int ai = 0; ai < 2; ++ai)
#pragma unroll
        for (int mb = 0; mb < 4; mb += 2) {
            u32x4 prb[2][2];
#pragma unroll
            for (int mm = 0; mm < 2; ++mm) { const size_t off = (size_t)(row0 + ai * HALF + (mb + mm) * 16) * 1024 + col0;
#pragma unroll
                for (int bj = 0; bj < 2; ++bj) prb[mm][bj] = *(const u32x4*)(base + off + bj * HALF); }
            asm volatile("" ::: "memory");
#pragma unroll
            for (int mm = 0; mm < 2; ++mm) { const int m = mb + mm; const int row = row0 + ai * HALF + m * 16; const size_t off = (size_t)row * 1024 + col0; float ss = 0.f;
#pragma unroll
                for (int bj = 0; bj < 2; ++bj) { const u32x4 w = prb[mm][bj];
                    const f32x4 p0 = (f32x4){__builtin_bit_cast(float, w.x << 16), __builtin_bit_cast(float, w.x & 0xffff0000u), __builtin_bit_cast(float, w.y << 16), __builtin_bit_cast(float, w.y & 0xffff0000u)};
                    const f32x4 p1 = (f32x4){__builtin_bit_cast(float, w.z << 16), __builtin_bit_cast(float, w.z & 0xffff0000u), __builtin_bit_cast(float, w.w << 16), __builtin_bit_cast(float, w.w & 0xffff0000u)};
                    const f32x4 o0 = p0 + gv[bj][0] * acc[ai][bj][m][0], o1 = p1 + gv[bj][1] * acc[ai][bj][m][1];
                    u32x4 xo; xo.x = cvt_pk_bf16(o0[0], o0[1]); xo.y = cvt_pk_bf16(o0[2], o0[3]); xo.z = cvt_pk_bf16(o1[0], o1[1]); xo.w = cvt_pk_bf16(o1[2], o1[3]); *(u32x4*)(out + off + bj * HALF) = xo;
                    const f32x4 g0 = o0 * gsn[bj][0], g1 = o1 * gsn[bj][1];
                    u32x4 xw; xw.x = cvt_pk_bf16(g0[0], g0[1]); xw.y = cvt_pk_bf16(g0[2], g0[3]); xw.z = cvt_pk_bf16(g1[0], g1[1]); xw.w = cvt_pk_bf16(g1[2], g1[3]); *(u32x4*)(xg + off + bj * HALF) = xw;
                    ss += ((o0[0] * o0[0] + o0[1] * o0[1]) + (o0[2] * o0[2] + o0[3] * o0[3])) + ((o1[0] * o1[0] + o1[1] * o1[1]) + (o1[2] * o1[2] + o1[3] * o1[3])); }
                ss += __shfl_xor(ss, 16); ss += __shfl_xor(ss, 32);
                if (fq == 0) atomicAdd(rss + row, ss); }
            asm volatile("" ::: "memory");
        }
    }
};
struct EpiSwiGLUN {
    static constexpr bool PERM = true, AFTER_DRAIN = false;
    bf16_t* O; int ldo; const float* rss; const float* sb; int nphys;
    __device__ __forceinline__ void operator()(const f32x4 (&acc)[2][2][4][2], const Unit& u, int wr, int wc, int fr, int fq) const {
        const int row0 = u.pm * BM + wr * 64 + fr, col0 = u.pn * HALF + wc * 32 + 8 * fq;
        const float* sp = sb + (size_t)(u.pm >> 4) * nphys + u.pn * BM + wc * 32 + 8 * fq;
        f32x4 sv[2][2];
#pragma unroll
        for (int bj = 0; bj < 2; ++bj)
#pragma unroll
            for (int n = 0; n < 2; ++n) sv[bj][n] = *(const f32x4*)(sp + bj * HALF + 4 * n);
        float rinv[2][4];
#pragma unroll
        for (int ai = 0; ai < 2; ++ai)
#pragma unroll
            for (int m = 0; m < 4; ++m) rinv[ai][m] = __builtin_amdgcn_rsqf(rss[row0 + ai * HALF + m * 16] * (1.0f / 1024.0f) + 1e-6f);
#pragma unroll
        for (int ai = 0; ai < 2; ++ai)
#pragma unroll
            for (int m = 0; m < 4; ++m) {
                bf16_t* p = O + (size_t)(row0 + ai * HALF + m * 16) * ldo + col0; const float ri = rinv[ai][m];
                const f32x4 h0 = silu4(acc[ai][0][m][0] * ri + sv[0][0]) * (acc[ai][1][m][0] * ri + sv[1][0]), h1 = silu4(acc[ai][0][m][1] * ri + sv[0][1]) * (acc[ai][1][m][1] * ri + sv[1][1]);
                u32x4 w; w.x = cvt_pk_bf16(h0[0], h0[1]); w.y = cvt_pk_bf16(h0[2], h0[3]); w.z = cvt_pk_bf16(h1[0], h1[1]); w.w = cvt_pk_bf16(h1[2], h1[3]);
                *(u32x4*)p = w;
            }
    }
};
struct EpiMix {
    static constexpr bool PERM = true, AFTER_DRAIN = false;
    bf16_t *Q, *K, *V, *MLQK, *MLV, *MLO; const float *gq, *gk, *rope; float c2;
    __device__ __forceinline__ void operator()(const f32x4 (&acc)[2][2][4][2], const Unit& u, int wr, int wc, int fr, int fq) const {
        const int pn = u.pn, row0 = u.pm * BM + wr * 64 + fr;
        if (pn < 4) {
            const bool isq = pn < 2; const int grp = (pn & 1) * 4 + wc;
            bf16_t* dst = (isq ? Q : K) + grp * 64 + 8 * fq; const float* gvec = isq ? gq : gk; const float sc = isq ? c2 : 1.0f;
            f32x4 gv[2][2];
#pragma unroll
            for (int bj = 0; bj < 2; ++bj)
#pragma unroll
                for (int n = 0; n < 2; ++n) gv[bj][n] = *(const f32x4*)(gvec + 32 * bj + 8 * fq + 4 * n) * sc;
#pragma unroll
            for (int ai = 0; ai < 2; ++ai) {
                f32x4 cs[4][2][2];
#pragma unroll
                for (int m = 0; m < 4; ++m)
#pragma unroll
                    for (int n = 0; n < 2; ++n) { cs[m][n][0] = (f32x4){1.f, 0.f, 1.f, 0.f}; cs[m][n][1] = (f32x4){1.f, 0.f, 1.f, 0.f}; }
                if (fq < 2) {
#pragma unroll
                    for (int m = 0; m < 4; ++m) { const int pos = (row0 + ai * HALF + m * 16) & 4095;
#pragma unroll
                        for (int n = 0; n < 2; ++n) { cs[m][n][0] = *(const f32x4*)(rope + (size_t)pos * 16 + n * 8); cs[m][n][1] = *(const f32x4*)(rope + (size_t)pos * 16 + n * 8 + 4); } }
                }
#pragma unroll
                for (int m = 0; m < 4; ++m) {
                    const int row = row0 + ai * HALF + m * 16;
                    float ss = 0.f;
#pragma unroll
                    for (int bj = 0; bj < 2; ++bj)
#pragma unroll
                        for (int n = 0; n < 2; ++n) { const f32x4 x = acc[ai][bj][m][n]; ss += (x[0] * x[0] + x[1] * x[1]) + (x[2] * x[2] + x[3] * x[3]); }
                    ss += __shfl_xor(ss, 16); ss += __shfl_xor(ss, 32);
                    const float rinv = 1.0f / sqrtf(ss * (1.0f / 64.0f) + 1e-6f);
                    f32x4 v[2][2];
#pragma unroll
                    for (int bj = 0; bj < 2; ++bj)
#pragma unroll
                        for (int n = 0; n < 2; ++n) v[bj][n] = acc[ai][bj][m][n] * rinv * gv[bj][n];
                    const float sg = (fq == 0) ? -1.0f : 1.0f;
#pragma unroll
                    for (int n = 0; n < 2; ++n) {
                        const f32x4 x = v[0][n]; f32x4 pr;
#pragma unroll
                        for (int e = 0; e < 4; ++e) pr[e] = __shfl_xor(x[e], 16);
                        const f32x4 cs0 = cs[m][n][0], cs1 = cs[m][n][1];
                        f32x4 o;
                        o[0] = x[0] * cs0[0] + sg * pr[0] * cs0[1]; o[1] = x[1] * cs0[2] + sg * pr[1] * cs0[3];
                        o[2] = x[2] * cs1[0] + sg * pr[2] * cs1[1]; o[3] = x[3] * cs1[2] + sg * pr[3] * cs1[3];
                        v[0][n] = o;
                    }
#pragma unroll
                    for (int bj = 0; bj < 2; ++bj) {
                        u32x4 w; w.x = cvt_pk_bf16(v[bj][0][0], v[bj][0][1]); w.y = cvt_pk_bf16(v[bj][0][2], v[bj][0][3]); w.z = cvt_pk_bf16(v[bj][1][0], v[bj][1][1]); w.w = cvt_pk_bf16(v[bj][1][2], v[bj][1][3]);
                        *(u32x4*)(dst + (size_t)row * 512 + 32 * bj) = w;
                    }
                }
                asm volatile("" ::: "memory");
            }
        } else {
            bf16_t* dst; int ld; const int lc = 64 * wc + 8 * fq;
            if (pn < 6) { dst = V + (pn - 4) * 256 + lc; ld = 512; }
            else if (pn < 10) { dst = MLQK + (pn - 6) * 256 + lc; ld = 1024; }
            else if (pn < 12) { dst = MLV + (pn - 10) * 256 + lc; ld = 512; }
            else { dst = MLO + (pn - 12) * 256 + lc; ld = 512; }
#pragma unroll
            for (int ai = 0; ai < 2; ++ai)
#pragma unroll
                for (int m = 0; m < 4; ++m) {
                    bf16_t* p = dst + (size_t)(row0 + ai * HALF + m * 16) * ld;
#pragma unroll
                    for (int bj = 0; bj < 2; ++bj) {
                        const f32x4 a = acc[ai][bj][m][0], b = acc[ai][bj][m][1];
                        u32x4 w; w.x = cvt_pk_bf16(a[0], a[1]); w.y = cvt_pk_bf16(a[2], a[3]); w.z = cvt_pk_bf16(b[0], b[1]); w.w = cvt_pk_bf16(b[2], b[3]);
                        *(u32x4*)(p + 32 * bj) = w;
                    }
                }
        }
    }
};
template <class Epi, class Sched, bool ALIGN_EPI = false, bool SP2 = false>
__device__ __forceinline__ void gemm_phase(PG8_LAS unsigned char* lds, const Gemm g, const Sched& S, const Epi& E) {
    const int tid = __tid_l(), wid = __builtin_amdgcn_readfirstlane(tid >> 6), lane = tid & 63, wr = wid >> 2, wc = wid & 3, fr = lane & 15, fq = lane >> 4;
    const int K = g.K, nt = K / BK;
    unsigned voffA[2], voffB[2];
#pragma unroll
    for (int i = 0; i < 2; ++i) { int R, C; stage_rc(tid * 16 + i * 8192, R, C); const int Rb = Epi::PERM ? ((R & ~31) + perm32(R & 31)) : R;
        voffA[i] = (unsigned)(R * K + C) * 2u; voffB[i] = (unsigned)(Rb * K + C) * 2u; }
    const size_t kstep = (size_t)(BK * 2);
    const size_t hstep = (size_t)HALF * K * 2;
    const size_t tstep = 2 * hstep;
    const unsigned ldsw = (unsigned)wid * 1024u;
    const int aoff = lds_byte(wr * 64 + fr, fq * 8), boff = lds_byte(wc * 32 + fr, fq * 8);
#define PG8_SA(b, h) (((b) * 2 + (h)) * HTB)
#define PG8_SB(b, h) ((4 + (b) * 2 + (h)) * HTB)
#define PG8_STAGE(bufoff, gbase, voff) do { _Pragma("unroll") for (int _i = 0; _i < 2; ++_i) \
        __builtin_amdgcn_global_load_lds((const unsigned*)((const char*)(gbase) + (voff)[_i]), (PG8_LAS unsigned*)(lds + (bufoff) + ldsw + _i * 8192), 16, 0, 0); } while (0)
#define PG8_LDA(dst, b, h) do { _Pragma("unroll") for (int m = 0; m < 4; ++m) _Pragma("unroll") for (int k = 0; k < 2; ++k) dst[m][k] = *(const PG8_LAS bf16x8*)(lds + PG8_SA(b, h) + aoff + m * 2048 + k * 1024); } while (0)
#define PG8_LDB(dst, b, h) do { _Pragma("unroll") for (int n = 0; n < 2; ++n) _Pragma("unroll") for (int k = 0; k < 2; ++k) dst[n][k] = *(const PG8_LAS bf16x8*)(lds + PG8_SB(b, h) + boff + n * 2048 + k * 1024); } while (0)
#define PG8_MMA(ai, bj, At, Bt) do { __builtin_amdgcn_s_setprio(1); _Pragma("unroll") for (int m = 0; m < 4; ++m) _Pragma("unroll") for (int n = 0; n < 2; ++n) _Pragma("unroll") for (int k = 0; k < 2; ++k) \
        acc[ai][bj][m][n] = __builtin_amdgcn_mfma_f32_16x16x32_bf16(Bt[n][k], At[m][k], acc[ai][bj][m][n], 0, 0, 0); __builtin_amdgcn_s_setprio(0); } while (0)
#define PG8_WAIT_V(n) asm volatile("s_waitcnt vmcnt(" #n ")" ::: "memory")
#define PG8_WAIT_L(n) asm volatile("s_waitcnt lgkmcnt(" #n ")" ::: "memory")
#define PG8_BAR __builtin_amdgcn_s_barrier()
#define PG8_SCHED __builtin_amdgcn_sched_barrier(0)
    Unit cur, nxt; int ui = 0;
    if (!S.next(0, cur)) return;
    f32x4 acc[2][2][4][2];
#pragma unroll
    for (int a = 0; a < 2; ++a)
#pragma unroll
        for (int b = 0; b < 2; ++b)
#pragma unroll
            for (int m = 0; m < 4; ++m)
#pragma unroll
                for (int n = 0; n < 2; ++n) acc[a][b][m][n] = (f32x4){0.f, 0.f, 0.f, 0.f};
    bf16x8 At[4][2], B0[2][2], B1[2][2];
    const char* cA = (const char*)g.A + (size_t)cur.pm * tstep; const char* cB = (const char*)g.Bt + (size_t)cur.pn * tstep;
    S.a_ready(cur);
    if constexpr (SP2) {
        PG8_STAGE(PG8_SB(0, 0), cB, voffB); PG8_STAGE(PG8_SB(0, 1), cB + hstep, voffB); PG8_STAGE(PG8_SA(0, 0), cA, voffA); PG8_STAGE(PG8_SA(0, 1), cA + hstep, voffA);
        if (wr == 1) PG8_BAR;
        PG8_WAIT_V(2); PG8_BAR;
        PG8_STAGE(PG8_SB(1, 0), cB + kstep, voffB); PG8_STAGE(PG8_SA(1, 0), cA + kstep, voffA); PG8_STAGE(PG8_SB(1, 1), cB + hstep + kstep, voffB);
        PG8_WAIT_V(6); PG8_BAR;
    } else {
        PG8_STAGE(PG8_SB(0, 0), cB, voffB); PG8_STAGE(PG8_SA(0, 0), cA, voffA); PG8_STAGE(PG8_SB(0, 1), cB + hstep, voffB); PG8_STAGE(PG8_SA(0, 1), cA + hstep, voffA);
        if (wr == 1) PG8_BAR;
        PG8_WAIT_V(4); PG8_BAR;
        PG8_STAGE(PG8_SB(1, 0), cB + kstep, voffB); PG8_STAGE(PG8_SA(1, 0), cA + kstep, voffA); PG8_STAGE(PG8_SB(1, 1), cB + hstep + kstep, voffB);
        PG8_WAIT_V(6); PG8_BAR;
    }
    for (;;) {
        const bool has_next = S.next(ui + 1, nxt);
        const char* nA = has_next ? (const char*)g.A + (size_t)nxt.pm * tstep : cA; const char* nB = has_next ? (const char*)g.Bt + (size_t)nxt.pn * tstep : cB;
        for (int t = 0; t < nt; t += 2) {
            const bool last = (t == nt - 2);
            const char* a1 = cA + (size_t)(t + 1) * kstep;
            const char* a2 = last ? nA : cA + (size_t)(t + 2) * kstep; const char* b2 = last ? nB : cB + (size_t)(t + 2) * kstep;
            const char* a3 = a2 + kstep; const char* b3 = b2 + kstep;
            if (last && has_next) S.a_ready(nxt);
            if constexpr (SP2) {
            PG8_LDB(B0, 0, 0); PG8_LDB(B1, 0, 1); PG8_SCHED; PG8_LDA(At, 0, 0); PG8_STAGE(PG8_SA(1, 1), a1 + hstep, voffA);
            PG8_WAIT_V(8); PG8_WAIT_L(0); PG8_BAR; PG8_MMA(0, 0, At, B0); PG8_MMA(0, 1, At, B1); PG8_BAR; PG8_SCHED;
            PG8_LDA(At, 0, 1); PG8_STAGE(PG8_SB(0, 0), b2, voffB); PG8_STAGE(PG8_SB(0, 1), b2 + hstep, voffB); PG8_STAGE(PG8_SA(0, 0), a2, voffA);
            PG8_WAIT_V(8); PG8_WAIT_L(0); PG8_BAR; PG8_MMA(1, 0, At, B0); PG8_MMA(1, 1, At, B1); PG8_BAR; PG8_SCHED;
            PG8_LDB(B0, 1, 0); PG8_LDB(B1, 1, 1); PG8_SCHED; PG8_LDA(At, 1, 0); PG8_STAGE(PG8_SA(0, 1), a2 + hstep, voffA);
            PG8_WAIT_V(8); PG8_WAIT_L(0); PG8_BAR; PG8_MMA(0, 0, At, B0); PG8_MMA(0, 1, At, B1); PG8_BAR; PG8_SCHED;
            PG8_LDA(At, 1, 1); PG8_STAGE(PG8_SB(1, 0), b3, voffB); PG8_STAGE(PG8_SB(1, 1), b3 + hstep, voffB); PG8_STAGE(PG8_SA(1, 0), a3, voffA);
            PG8_WAIT_V(8); PG8_WAIT_L(0); PG8_BAR; PG8_MMA(1, 0, At, B0); PG8_MMA(1, 1, At, B1); PG8_BAR; PG8_SCHED;
            } else {
            PG8_LDB(B0, 0, 0); PG8_SCHED; PG8_LDA(At, 0, 0); PG8_STAGE(PG8_SA(1, 1), a1 + hstep, voffA);
            PG8_WAIT_L(8); PG8_BAR; PG8_WAIT_L(0); PG8_MMA(0, 0, At, B0); PG8_BAR; PG8_SCHED;
            PG8_LDB(B1, 0, 1); PG8_STAGE(PG8_SB(0, 0), b2, voffB);
            PG8_BAR; PG8_WAIT_L(0); PG8_MMA(0, 1, At, B1); PG8_BAR;
            PG8_LDA(At, 0, 1); PG8_STAGE(PG8_SA(0, 0), a2, voffA);
            PG8_BAR; PG8_WAIT_L(0); PG8_MMA(1, 0, At, B0); PG8_BAR; PG8_SCHED;
            PG8_STAGE(PG8_SB(0, 1), b2 + hstep, voffB);
            PG8_WAIT_V(6); PG8_BAR; PG8_MMA(1, 1, At, B1); PG8_BAR;
            PG8_LDB(B0, 1, 0); PG8_SCHED; PG8_LDA(At, 1, 0); PG8_STAGE(PG8_SA(0, 1), a2 + hstep, voffA);
            PG8_WAIT_L(8); PG8_BAR; PG8_WAIT_L(0); PG8_MMA(0, 0, At, B0); PG8_BAR; PG8_SCHED;
            PG8_LDB(B1, 1, 1); PG8_STAGE(PG8_SB(1, 0), b3, voffB);
            PG8_BAR; PG8_WAIT_L(0); PG8_MMA(0, 1, At, B1); PG8_BAR;
            PG8_LDA(At, 1, 1); PG8_STAGE(PG8_SA(1, 0), a3, voffA);
            PG8_BAR; PG8_WAIT_L(0); PG8_MMA(1, 0, At, B0); PG8_BAR; PG8_SCHED;
            PG8_STAGE(PG8_SB(1, 1), b3 + hstep, voffB);
            PG8_WAIT_V(6); PG8_BAR; PG8_MMA(1, 1, At, B1); PG8_BAR;
            }
        }
        if constexpr (ALIGN_EPI) { if (wr == 0) PG8_BAR; }
        if constexpr (!Epi::AFTER_DRAIN) { E(acc, cur, wr, wc, fr, fq); S.done(cur); }
        if (!has_next) break;
#pragma unroll
        for (int a = 0; a < 2; ++a)
#pragma unroll
            for (int b = 0; b < 2; ++b)
#pragma unroll
                for (int m = 0; m < 4; ++m)
#pragma unroll
                    for (int n = 0; n < 2; ++n) acc[a][b][m][n] = (f32x4){0.f, 0.f, 0.f, 0.f};
        cur = nxt; cA = nA; cB = nB; ++ui;
        if constexpr (ALIGN_EPI) { if (wr == 1) PG8_BAR; }
    }
    PG8_WAIT_V(0);
    if constexpr (!ALIGN_EPI) { if (wr == 0) PG8_BAR; }
    PG8_BAR;
    if constexpr (Epi::AFTER_DRAIN) { E.fused(acc, cur, wr, wc, fr, fq, lds, wid, lane); S.done(cur); }
#undef PG8_SA
#undef PG8_SB
#undef PG8_STAGE
#undef PG8_LDA
#undef PG8_LDB
#undef PG8_MMA
#undef PG8_WAIT_V
#undef PG8_WAIT_L
#undef PG8_BAR
#undef PG8_SCHED
}
}
#include <hip/hip_bf16.h>
#include <cmath>
namespace attn_body {
using bf16=__hip_bfloat16;
using bf16x8=__attribute__((ext_vector_type(8)))short;
using s16x4=__attribute__((ext_vector_type(4)))short;
using f32x16=__attribute__((ext_vector_type(16)))float;
using u32x4=__attribute__((ext_vector_type(4)))unsigned;
constexpr int BATCH=8,NHEAD=16,SEQ=4096,D=64,DM=NHEAD*D,QP=512,KP=512,VP=512,OP=1024;
constexpr int NW=8,QBLK=32,QB=QBLK*NW,KVBLK=64,NQB=SEQ/QB;
constexpr int ATTN_PITCH=DM, ATTN_UNIT_ROWS=QB;
__device__ __forceinline__ int crow(int r,int hi){return (r&3)+8*(r>>2)+4*hi;}
#define SBAR() __builtin_amdgcn_sched_barrier(0)
__device__ __forceinline__ void cmask(f32x16&p0,f32x16&p1,int jb,int qrel,int hi){
  const float NEG=-INFINITY; int kb=64*jb+4*hi;
  #pragma unroll
  for(int r=0;r<16;++r){int kv=kb+(r&3)+8*(r>>2); if(kv>qrel)p0[r]=NEG; if(kv+32>qrel)p1[r]=NEG;}
}

constexpr int NSLOT=3, SLOTB=8192;
constexpr int LDS_K=0, LDS_V=NSLOT*SLOTB, LDS_WS=2*NSLOT*SLOTB, LDS_OST=LDS_WS+NW*64*4, LDS_BYTES=LDS_OST+NW*4096;
constexpr float C2=0.125f*1.4426950408889634f;
__device__ __forceinline__ void glds16(const void*gsrc,unsigned lds_dst){unsigned keep;
  asm volatile("s_mov_b32 %0, m0\n\ts_mov_b32 m0, %2\n\ts_nop 0\n\tglobal_load_lds_dwordx4 %1, off\n\ts_mov_b32 m0, %0":"=&s"(keep):"v"(gsrc),"s"(lds_dst):"memory");}
__device__ __forceinline__ float max3f(float a,float b,float c){float r;asm("v_max3_f32 %0, %1, %2, %3":"=v"(r):"v"(a),"v"(b),"v"(c));return r;}
__device__ __forceinline__ float max2f(float a,float b){float r;asm("v_max_f32_e32 %0, %1, %2":"=v"(r):"v"(a),"v"(b));return r;}
__device__ __forceinline__ float fadd_s(float a,float b){float r;asm("v_add_f32_e32 %0, %1, %2":"=v"(r):"v"(a),"v"(b));return r;}
__device__ __forceinline__ float fsub_s(float a,float b){float r;asm("v_sub_f32_e32 %0, %1, %2":"=v"(r):"v"(a),"v"(b));return r;}
typedef float f32x2_t __attribute__((ext_vector_type(2))); typedef __bf16 bf16x2_t __attribute__((ext_vector_type(2)));
__device__ __forceinline__ unsigned cvtpk_s(float lo,float hi){f32x2_t v={lo,hi};bf16x2_t b=__builtin_convertvector(v,bf16x2_t);return __builtin_bit_cast(unsigned,b);}
#define WAIT_BAR(N) asm volatile("s_waitcnt vmcnt(" #N ") lgkmcnt(0)\n\ts_barrier":::"memory")

__device__ __forceinline__ void qkt(f32x16&p0,f32x16&p1,const char*Kslot,const bf16x8*qr,const f32x16&negm,int r32,int hi){
  const char*kb=Kslot+hi*1024+r32*16;
  #pragma unroll
  for(int d0=0;d0<4;++d0){
    const bf16x8 b0=*reinterpret_cast<const bf16x8*>(kb+d0*2048);
    const bf16x8 b1=*reinterpret_cast<const bf16x8*>(kb+d0*2048+512);
    if(d0==0){p0=__builtin_amdgcn_mfma_f32_32x32x16_bf16(b0,qr[0],negm,0,0,0);p1=__builtin_amdgcn_mfma_f32_32x32x16_bf16(b1,qr[0],negm,0,0,0);}
    else{p0=__builtin_amdgcn_mfma_f32_32x32x16_bf16(b0,qr[d0],p0,0,0,0);p1=__builtin_amdgcn_mfma_f32_32x32x16_bf16(b1,qr[d0],p1,0,0,0);}}
}
typedef __attribute__((address_space(3))) const char* lds_cptr;
typedef short v4i16_t __attribute__((ext_vector_type(4)));
__device__ __forceinline__ void kload8(bf16x8*kf,lds_cptr kp){
  kf[0]=*(const __attribute__((address_space(3))) bf16x8*)(kp);      kf[1]=*(const __attribute__((address_space(3))) bf16x8*)(kp+512);
  kf[2]=*(const __attribute__((address_space(3))) bf16x8*)(kp+2048); kf[3]=*(const __attribute__((address_space(3))) bf16x8*)(kp+2560);
  kf[4]=*(const __attribute__((address_space(3))) bf16x8*)(kp+4096); kf[5]=*(const __attribute__((address_space(3))) bf16x8*)(kp+4608);
  kf[6]=*(const __attribute__((address_space(3))) bf16x8*)(kp+6144); kf[7]=*(const __attribute__((address_space(3))) bf16x8*)(kp+6656);
}
__device__ __forceinline__ void kload2(bf16x8*kf,lds_cptr kp,int j){ kf[2*j]=*(const __attribute__((address_space(3))) bf16x8*)(kp+j*2048); kf[2*j+1]=*(const __attribute__((address_space(3))) bf16x8*)(kp+j*2048+512); }
__device__ __forceinline__ s16x4 vtr(lds_cptr p){ return __builtin_bit_cast(s16x4,__builtin_amdgcn_ds_read_tr16_b64_v4i16((__attribute__((address_space(3))) v4i16_t*)p)); }
__device__ __forceinline__ float rowmax(const f32x16&p0,const f32x16&p1){
  float a=max3f(p0[0],p0[1],p1[0]),b=max3f(p0[2],p0[3],p1[1]);a=max3f(a,p1[2],p1[3]);
  #pragma unroll
  for(int r=4;r<16;r+=4){a=max3f(a,p0[r],p0[r+1]);b=max3f(b,p0[r+2],p0[r+3]);a=max3f(a,p1[r],p1[r+1]);b=max3f(b,p1[r+2],p1[r+3]);}
  const float m=max2f(a,b);
  auto rr=__builtin_amdgcn_permlane32_swap(__float_as_uint(m),__float_as_uint(m),false,false);
  return max2f(__uint_as_float(rr[0]),__uint_as_float(rr[1]));
}
__device__ __forceinline__ void pv(f32x16*o,int vb,bf16x8 pa0,bf16x8 pa1,bf16x8 pa2,bf16x8 pa3){
  #pragma unroll
  for(int d0=0;d0<2;++d0){s16x4 lo[4],hi[4];
    #pragma unroll
    for(int ks=0;ks<4;++ks){
      asm volatile("ds_read_b64_tr_b16 %0,%1 offset:%c2":"=&v"(lo[ks]):"v"(vb),"i"(d0*4096+ks*1024):"memory");
      asm volatile("ds_read_b64_tr_b16 %0,%1 offset:%c2":"=&v"(hi[ks]):"v"(vb),"i"(d0*4096+ks*1024+512):"memory");}
    asm volatile("s_waitcnt lgkmcnt(0)":::"memory");SBAR();
    #define PK(k) (bf16x8){lo[k][0],lo[k][1],lo[k][2],lo[k][3],hi[k][0],hi[k][1],hi[k][2],hi[k][3]}
    o[d0]=__builtin_amdgcn_mfma_f32_32x32x16_bf16(pa0,PK(0),o[d0],0,0,0);
    o[d0]=__builtin_amdgcn_mfma_f32_32x32x16_bf16(pa1,PK(1),o[d0],0,0,0);
    o[d0]=__builtin_amdgcn_mfma_f32_32x32x16_bf16(pa2,PK(2),o[d0],0,0,0);
    o[d0]=__builtin_amdgcn_mfma_f32_32x32x16_bf16(pa3,PK(3),o[d0],0,0,0);
    #undef PK
  }
}

#ifndef ATTN_STORE16
#define ATTN_STORE16(p,v) (*(u32x4*)(p)=(v))
#endif
template<int THRL> __device__ __forceinline__ void attn_unit(int b,int qcol,int vcol,int ocol,int qb,const bf16*Q,const bf16*__restrict__ K,const bf16*__restrict__ V,bf16*O,char*shm){
  const int tid=__tid_l(),lane=tid&63,r32=lane&31,hi=lane>>5; const int wid=__builtin_amdgcn_readfirstlane(tid>>6);
  const long rowbase=(long)b*SEQ; const int q0=qb*QB;
  const bf16*Qw=Q+(rowbase+q0+wid*QBLK)*QP+qcol;
  const bf16*Kh=K+rowbase*KP+qcol,*Vh=V+rowbase*VP+vcol;
  const unsigned lds0=(unsigned)(uintptr_t)shm;
  float*wsf=(float*)(shm+LDS_WS)+wid*64;
  const bf16*ksrc=Kh+(long)lane*KP+wid*8;
  const bf16*vsrc=Vh+(long)(16*(wid&3)+(lane>>2))*VP+(wid>>2)*32+(lane&3)*8;
  const unsigned kdst=lds0+LDS_K+wid*1024, vdst=lds0+LDS_V+wid*1024;
  #define DMA_K(t,slot) glds16(ksrc+(long)(t)*KVBLK*KP,(unsigned)__builtin_amdgcn_readfirstlane(kdst+(slot)))
  #define DMA_V(t,slot) glds16(vsrc+(long)(t)*KVBLK*VP,(unsigned)__builtin_amdgcn_readfirstlane(vdst+(slot)))
  const int vb0=(int)(lds0+LDS_V)+((lane>>4)&1)*32+(lane&3)*8+(4*hi+((lane&15)>>2))*64;
  const char*Kbase=shm+LDS_K; bf16x8 kf[8];
  const lds_cptr shm3=(lds_cptr)shm; const lds_cptr kp0=shm3+LDS_K+hi*1024+r32*16; const lds_cptr vp0=shm3+LDS_V+((lane>>4)&1)*32+(lane&3)*8+(4*hi+((lane&15)>>2))*64;
  const int NT=(q0+QB)/KVBLK;
  DMA_K(0,0);DMA_V(0,0);DMA_K(1,SLOTB);
  bf16x8 qr[4];
  #pragma unroll
  for(int d0=0;d0<4;++d0)qr[d0]=*reinterpret_cast<const bf16x8*>(&Qw[(long)r32*QP+d0*16+hi*8]);
  float mhat=0.f,l_reg=0.f;f32x16 o[2];o[0]=f32x16{};o[1]=f32x16{};f32x16 negm=f32x16{};asm volatile("":"+v"(negm));
  const int qrel=wid*QBLK+r32;
  #define CMASK(P0,P1,t) do{int jb_=(t)-(NT-4); if(jb_>=0)cmask(P0,P1,jb_,qrel,hi);}while(0)
  bool resc=false;
  #define START(P0,P1) do{ const float rm=rowmax(P0,P1); resc=false; \
    { const float dl=rm; mhat=fadd_s(mhat,dl); \
      _Pragma("unroll") for(int r=0;r<16;++r){P0[r]=fsub_s(P0[r],dl);P1[r]=fsub_s(P1[r],dl);} \
      _Pragma("unroll") for(int r=0;r<16;++r)negm[r]=-mhat; asm volatile("":"+v"(negm)); } \
    _Pragma("unroll") for(int r=0;r<16;++r)P0[r]=__builtin_amdgcn_exp2f(P0[r]); }while(0)
  #define RESC() do{ if(resc){ asm volatile("s_waitcnt lgkmcnt(0)":::"memory"); \
      _Pragma("unroll") for(int d_=0;d_<2;++d_) _Pragma("unroll") for(int r=0;r<16;++r)o[d_][r]*=wsf[crow(r,hi)]; } }while(0)
  f32x16 pA0,pA1,pB0,pB1;
  int sl_prev=0,sl_cur=0,sl_next=SLOTB;
  #define ROT() do{sl_prev=sl_cur;sl_cur=sl_next;sl_next=(sl_next==(NSLOT-1)*SLOTB)?0:sl_next+SLOTB;}while(0)
  DMA_K(2,2*SLOTB);
  WAIT_BAR(3);
  qkt(pA0,pA1,Kbase,qr,negm,r32,hi);asm volatile("s_nop 15\n\ts_nop 7":"+v"(pA0),"+v"(pA1));CMASK(pA0,pA1,0);
  START(pA0,pA1);
  _Pragma("unroll") for(int r=0;r<16;++r)pA1[r]=__builtin_amdgcn_exp2f(pA1[r]);
  WAIT_BAR(0);
  DMA_K(3,0);DMA_V(1,SLOTB);
  ROT();
  kload8(kf,kp0+sl_cur);
  WAIT_BAR(2);
  s16x4 vlo[8],vhi[8]; u32x4 pw0,pw1,pw2,pw3;
  #define PKW(P,B) cvtpk_s(P[B],P[B+1])
  #define PAF(k) __builtin_bit_cast(bf16x8,pw##k)
  #define VFR(i) (bf16x8){vlo[i][0],vlo[i][1],vlo[i][2],vlo[i][3],vhi[i][0],vhi[i][1],vhi[i][2],vhi[i][3]}
  #define PIN(x) asm volatile("":"+v"(x))
  #define MX3(a,b,c) __builtin_fmaxf(__builtin_fmaxf((a),(b)),(c))
  #define GAPA(MF,A0,A1,A2,A3,W0,W1,PW) do{ MF; sacc+=A0; sacc+=A1; sacc+=A2; sacc+=A3; PIN(sacc); W0; W1; PIN(PW); SBAR(); }while(0)
  #define EX(v) __builtin_amdgcn_exp2f(v)
  #define GAPB(MF,X,B) do{ MF; X[B]=EX(X[B]); X[B+1]=EX(X[B+1]); X[B+2]=EX(X[B+2]); X[B+3]=EX(X[B+3]); PIN(X); SBAR(); }while(0)
  #define VRD(i) do{ vlo[i]=vtr(vp_+(((i)>>2)*4096+((i)&3)*1024)); vhi[i]=vtr(vp_+(((i)>>2)*4096+((i)&3)*1024+512)); }while(0)
  #define KRD(G,j) do{ if(G){ kload2(kf,kp0+sl_next,j); SBAR(); } }while(0)
  #define STEP(C0,C1,P0,P1,t,GK,GV,GL) do{ SBAR(); \
    const lds_cptr vp_=vp0+sl_prev; \
    VRD(0); SBAR(); float sacc=(P0[0]+P0[1]); \
    GAPA(C0=__builtin_amdgcn_mfma_f32_32x32x16_bf16(kf[0],qr[0],negm,0,0,0), P0[2],P0[3],P0[4],P0[5],     pw0[0]=PKW(P0,0), pw0[1]=PKW(P0,2), pw0); \
    VRD(4); SBAR(); GAPA(C1=__builtin_amdgcn_mfma_f32_32x32x16_bf16(kf[1],qr[0],negm,0,0,0), P0[6],P0[7],P0[8],P0[9],     pw0[2]=PKW(P0,4), pw0[3]=PKW(P0,6), pw0); \
    VRD(1); SBAR(); GAPA(C0=__builtin_amdgcn_mfma_f32_32x32x16_bf16(kf[2],qr[1],C0,0,0,0),   P0[10],P0[11],P0[12],P0[13], pw1[0]=PKW(P0,8), pw1[1]=PKW(P0,10), pw1); \
    VRD(5); SBAR(); GAPA(C1=__builtin_amdgcn_mfma_f32_32x32x16_bf16(kf[3],qr[1],C1,0,0,0),   P0[14],P0[15],P1[0],P1[1],   pw1[2]=PKW(P0,12),pw1[3]=PKW(P0,14), pw1); \
    VRD(2); SBAR(); GAPA(C0=__builtin_amdgcn_mfma_f32_32x32x16_bf16(kf[4],qr[2],C0,0,0,0),   P1[2],P1[3],P1[4],P1[5],     pw2[0]=PKW(P1,0), pw2[1]=PKW(P1,2), pw2); \
    VRD(6); SBAR(); GAPA(C1=__builtin_amdgcn_mfma_f32_32x32x16_bf16(kf[5],qr[2],C1,0,0,0),   P1[6],P1[7],P1[8],P1[9],     pw2[2]=PKW(P1,4), pw2[3]=PKW(P1,6), pw2); \
    VRD(3); SBAR(); GAPA(C0=__builtin_amdgcn_mfma_f32_32x32x16_bf16(kf[6],qr[3],C0,0,0,0),   P1[10],P1[11],P1[12],P1[13], pw3[0]=PKW(P1,8), pw3[1]=PKW(P1,10), pw3); \
    VRD(7); SBAR(); GAPA(C1=__builtin_amdgcn_mfma_f32_32x32x16_bf16(kf[7],qr[3],C1,0,0,0),   P1[14],P1[15],0.f,0.f,       pw3[2]=PKW(P1,12),pw3[3]=PKW(P1,14), pw3); \
    l_reg+=sacc; \
    if(GK){DMA_K((t)+3,sl_cur);} if(GV){DMA_V((t)+1,sl_next);} \
    CMASK(C0,C1,t); \
    { float a=MX3(C0[0],C0[1],C1[0]),b=MX3(C0[2],C0[3],C1[1]); a=MX3(a,C1[2],C1[3]); \
      _Pragma("unroll") for(int r=4;r<16;r+=4){a=MX3(a,C0[r],C0[r+1]);b=MX3(b,C0[r+2],C0[r+3]);a=MX3(a,C1[r],C1[r+1]);b=MX3(b,C1[r+2],C1[r+3]);} \
      float rm=__builtin_fmaxf(a,b); { auto rr=__builtin_amdgcn_permlane32_swap(__float_as_uint(rm),__float_as_uint(rm),false,false); rm=__builtin_fmaxf(__uint_as_float(rr[0]),__uint_as_float(rr[1])); } \
      resc=false; \
      if(__builtin_expect(__any(rm>(float)THRL),0)){ const float dl=__builtin_fmaxf(rm,0.f); mhat+=dl; \
        _Pragma("unroll") for(int r=0;r<16;++r){C0[r]-=dl;C1[r]-=dl;} \
        _Pragma("unroll") for(int r=0;r<16;++r)negm[r]=-mhat; asm volatile("":"+v"(negm)); \
        const float f=__builtin_amdgcn_exp2f(-dl); l_reg*=f; if(hi==0)wsf[r32]=f; resc=true; } } \
    SBAR(); \
    GAPB(o[0]=__builtin_amdgcn_mfma_f32_32x32x16_bf16(PAF(0),VFR(0),o[0],0,0,0), C0,0); \
    GAPB(o[1]=__builtin_amdgcn_mfma_f32_32x32x16_bf16(PAF(0),VFR(4),o[1],0,0,0), C0,4); \
    KRD(GL,0); GAPB(o[0]=__builtin_amdgcn_mfma_f32_32x32x16_bf16(PAF(1),VFR(1),o[0],0,0,0), C0,8); \
    KRD(GL,1); GAPB(o[1]=__builtin_amdgcn_mfma_f32_32x32x16_bf16(PAF(1),VFR(5),o[1],0,0,0), C0,12); \
    KRD(GL,2); GAPB(o[0]=__builtin_amdgcn_mfma_f32_32x32x16_bf16(PAF(2),VFR(2),o[0],0,0,0), C1,0); \
    KRD(GL,3); GAPB(o[1]=__builtin_amdgcn_mfma_f32_32x32x16_bf16(PAF(2),VFR(6),o[1],0,0,0), C1,4); \
    GAPB(o[0]=__builtin_amdgcn_mfma_f32_32x32x16_bf16(PAF(3),VFR(3),o[0],0,0,0), C1,8); \
    GAPB(o[1]=__builtin_amdgcn_mfma_f32_32x32x16_bf16(PAF(3),VFR(7),o[1],0,0,0), C1,12); \
    }while(0)
  int t=1;
  #undef CMASK
  #define CMASK(P0,P1,t) do{}while(0)
  for(;t+5<NT;t+=2){
    STEP(pB0,pB1,pA0,pA1,t,true,true,true);     WAIT_BAR(2); RESC(); ROT();
    STEP(pA0,pA1,pB0,pB1,t+1,true,true,true);   WAIT_BAR(2); RESC(); ROT();
  }
  #undef CMASK
  #define CMASK(P0,P1,t) do{int jb_=(t)-(NT-4); if(jb_>=0)cmask(P0,P1,jb_,qrel,hi);}while(0)
  #define ENDW(tt) do{ if((tt)+3<NT){WAIT_BAR(2);} else if((tt)+2<NT){WAIT_BAR(1);} else {WAIT_BAR(0);} }while(0)
  for(;t+1<NT;t+=2){
    STEP(pB0,pB1,pA0,pA1,t,(t+3<NT),(t+1<NT),(t+1<NT));       ENDW(t);   RESC(); ROT();
    STEP(pA0,pA1,pB0,pB1,t+1,(t+4<NT),(t+2<NT),(t+2<NT));     ENDW(t+1); RESC(); ROT();
  }
  STEP(pB0,pB1,pA0,pA1,NT-1,false,false,false); RESC();
  { float sacc=pB0[0]+pB0[1]; _Pragma("unroll") for(int r=2;r<16;++r)sacc+=pB0[r]; _Pragma("unroll") for(int r=0;r<16;++r)sacc+=pB1[r]; l_reg+=sacc;
    pw0=(u32x4){PKW(pB0,0),PKW(pB0,2),PKW(pB0,4),PKW(pB0,6)};pw1=(u32x4){PKW(pB0,8),PKW(pB0,10),PKW(pB0,12),PKW(pB0,14)};pw2=(u32x4){PKW(pB1,0),PKW(pB1,2),PKW(pB1,4),PKW(pB1,6)};pw3=(u32x4){PKW(pB1,8),PKW(pB1,10),PKW(pB1,12),PKW(pB1,14)};
    SBAR(); pv(o,vb0+sl_cur,PAF(0),PAF(1),PAF(2),PAF(3)); }
  #undef PKW
  #undef PAF
  #undef VFR
  #undef PIN
  #undef MX3
  #undef GAPA
  #undef GAPB
  #undef EX
  #undef VRD
  #undef KRD
  #undef STEP
  #undef ENDW
  {auto rr=__builtin_amdgcn_permlane32_swap(__float_as_uint(l_reg),__float_as_uint(l_reg),false,false);l_reg=__uint_as_float(rr[0])+__uint_as_float(rr[1]);}
  if(hi==0)wsf[32+r32]=l_reg;asm volatile("s_waitcnt lgkmcnt(0)":::"memory");
  float rli[16];
  #pragma unroll
  for(int r=0;r<16;++r)rli[r]=__builtin_amdgcn_rcpf(wsf[32+crow(r,hi)]);
  bf16*Ow=O+(rowbase+q0+wid*QBLK)*OP+ocol;
  { bf16*stg=(bf16*)(shm+LDS_OST)+wid*2048;
    #pragma unroll
    for(int r=0;r<16;++r){const int orow=crow(r,hi);
      #pragma unroll
      for(int d0=0;d0<2;++d0)stg[orow*64+d0*32+r32]=__float2bfloat16(o[d0][r]*rli[r]);}
    asm volatile("s_waitcnt lgkmcnt(0)":::"memory");
    #pragma unroll
    for(int i=0;i<4;++i){const int row=i*8+(lane>>3),ch=lane&7; const u32x4 v=*(const u32x4*)(stg+row*64+ch*8); ATTN_STORE16(Ow+(long)row*OP+ch*8,v);} }
  asm volatile("s_waitcnt lgkmcnt(0)\n\ts_barrier":::"memory");
  #undef DMA_K
  #undef DMA_V
  #undef CMASK
  #undef START
  #undef RESC
  #undef ROT
}
#undef SBAR
#undef WAIT_BAR
}
namespace cg = cooperative_groups;
#define LAS __attribute__((address_space(3)))
typedef unsigned short bf16;
typedef unsigned v4u __attribute__((ext_vector_type(4)));
typedef unsigned v2u __attribute__((ext_vector_type(2)));
typedef float f32x4 __attribute__((ext_vector_type(4)));
typedef float f32x16 __attribute__((ext_vector_type(16)));
typedef short bf16x8 __attribute__((ext_vector_type(8)));

constexpr int NB = 8, SEQ = 4096, DM = 1024, TOK = NB * SEQ, FF = 2816, NIN = 3592, NINP = 3584, NMOD = 9216;
constexpr size_t MiB = 1u << 20;
constexpr size_t WS_CTL = 0, WS_MOD = 64 * 1024, WS_ROPE = 512 * 1024, WS_GATES = 1 * MiB;
constexpr size_t WS_W12A = 2 * MiB, WS_W3A = 13 * MiB, WS_W12B = 19 * MiB, WS_W3B = 30 * MiB, WS_WIN = 36 * MiB, WS_WOUT = 43 * MiB;
constexpr size_t WS_HN = 48 * MiB, WS_HID = 112 * MiB;
constexpr size_t WS_Q = WS_HID, WS_K = WS_HID + 32 * MiB, WS_V = WS_HID + 64 * MiB, WS_MLQK = WS_HID + 96 * MiB;
constexpr size_t WS_MLV = 288 * MiB, WS_MLO = 320 * MiB, WS_AO = 352 * MiB, WS_MLH = 416 * MiB, WS_IMGB = 448 * MiB, WS_END = 512 * MiB;
constexpr size_t WS_RSS = 47 * MiB, WS_SB3 = 47 * MiB + 256 * 1024, WS_XG3 = WS_AO;
constexpr size_t WS_BP = 45 * MiB, WS_RK = 46 * MiB, WS_IMGA = WS_HN;
constexpr int LDS_BYTES = 147456, MISC_OFF = 131072 + 320;
constexpr float C2Q = 0.125f * 1.4426950408889634f;

__device__ __forceinline__ unsigned f2bf(float f) { unsigned u = __builtin_bit_cast(unsigned, f); return (u + 0x7fffu + ((u >> 16) & 1u)) >> 16; }
__device__ __forceinline__ unsigned pk2(float lo, float hi) { return pg8::cvt_pk_bf16(lo, hi); }
__device__ __forceinline__ float bflo(unsigned u) { return __builtin_bit_cast(float, u << 16); }
__device__ __forceinline__ float bfhi(unsigned u) { return __builtin_bit_cast(float, u & 0xffff0000u); }
__device__ __forceinline__ float wave_sum(float v) {
#pragma unroll
    for (int o = 1; o < 64; o <<= 1) v += __shfl_xor(v, o);
    return v;
}
#define LDS_WAIT() asm volatile("s_waitcnt lgkmcnt(0)" ::: "memory")

#define XB_TMO      128
#define XB_XCNT(j)  (256  + 64 * (j))
#define XB_XSUB(j)  (1280 + 64 * (j))
#define XB_XGEN(j)  (2304 + 64 * (j))
#define XB_TOP      3328
#define XB_TOPGEN   3392
#define XCD_BAR_WORDS 3456
#define XB_SPIN_CAP (1u << 18)

__device__ __forceinline__ unsigned xb_ld(unsigned* p)              { return __hip_atomic_load(p, __ATOMIC_RELAXED, __HIP_MEMORY_SCOPE_AGENT); }
__device__ __forceinline__ unsigned xb_add(unsigned* p, unsigned v) { return __hip_atomic_fetch_add(p, v, __ATOMIC_RELAXED, __HIP_MEMORY_SCOPE_AGENT); }
__device__ __forceinline__ unsigned xb_xcc_id() { return (unsigned)__builtin_amdgcn_s_getreg((3 << 11) | 20) & 0xFu; }
#define XB_SPIN(cond, bar) do { unsigned _sp = 0; while (cond) { __builtin_amdgcn_s_sleep(1); \
    if ((++_sp & 255u) == 0u) { if (xb_ld(&(bar)[XB_TMO])) break; if (_sp > XB_SPIN_CAP) { atomicAdd(&(bar)[XB_TMO], 1u); break; } } } } while (0)

struct XcdBarrier {
    unsigned* bar; unsigned x;
    volatile LAS unsigned* st;
};

__device__ __forceinline__ XcdBarrier xcd_barrier_post(unsigned* bar, volatile LAS unsigned* st) {
    XcdBarrier b; b.bar = bar; b.x = xb_xcc_id(); b.st = st;
    if (threadIdx.x == 0) (void)xb_add(&bar[XB_XCNT(b.x)], 1u);
    return b;
}
__device__ __forceinline__ void xcd_barrier_complete(unsigned* bar, unsigned x, unsigned& nloc, unsigned& nx) {
    const unsigned G = gridDim.x * gridDim.y * gridDim.z;
    unsigned sum, cnt, mine, sp = 0u;
    for (;;) {
        sum = 0u; cnt = 0u; mine = 0u;
#pragma unroll
        for (unsigned j = 0; j < 16; ++j) { const unsigned c = xb_ld(&bar[XB_XCNT(j)]); sum += c; cnt += (c > 0u) ? 1u : 0u; mine = (j == x) ? c : mine; }
        if (sum == G) break;
        __builtin_amdgcn_s_sleep(1);
        if ((++sp & 255u) == 0u) { if (xb_ld(&bar[XB_TMO])) break; if (sp > XB_SPIN_CAP) { atomicAdd(&bar[XB_TMO], 1u); break; } }
    }
    nloc = mine > 0u ? mine : 1u; nx = cnt > 0u ? cnt : 1u;
}

__device__ __forceinline__ void xcd_barrier(const XcdBarrier& b) {
    asm volatile("s_waitcnt vmcnt(0)" ::: "memory");
    __syncthreads();
    if (threadIdx.x == 0) {
        unsigned* bar = b.bar;
        __builtin_amdgcn_s_waitcnt(0);
        unsigned nloc = b.st[0], nx = b.st[1];
        if (nloc == 0u) { xcd_barrier_complete(bar, b.x, nloc, nx); b.st[0] = nloc; b.st[1] = nx; }
        const unsigned old = xb_add(&bar[XB_XSUB(b.x)], 1u);
        const unsigned gen = old / nloc;
        if (old + 1u == (gen + 1u) * nloc) {
            __builtin_amdgcn_fence(__ATOMIC_RELEASE, "agent");
            asm volatile("s_waitcnt vmcnt(0)" ::: "memory");
            const unsigned og = xb_add(&bar[XB_TOP], 1u);
            const unsigned tg = og / nx;
            if (og + 1u == (tg + 1u) * nx) xb_add(&bar[XB_TOPGEN], 1u);
            else XB_SPIN(xb_ld(&bar[XB_TOPGEN]) == tg, bar);
            __builtin_amdgcn_fence(__ATOMIC_ACQUIRE, "agent");
            xb_add(&bar[XB_XGEN(b.x)], 1u);
            asm volatile("s_waitcnt vmcnt(0)" ::: "memory");
        } else {
            XB_SPIN(xb_ld(&bar[XB_XGEN(b.x)]) == gen, bar);
            __builtin_amdgcn_fence(__ATOMIC_ACQUIRE, "agent");
            asm volatile("s_waitcnt vmcnt(0)" ::: "memory");
        }
    }
    __syncthreads();
}


struct Args { const float* in[20]; float* out; unsigned char* ws; int ph_lo, ph_hi; };
enum { I_X = 0, I_C, I_WADA, I_BADA, I_GNORM, I_F1W12, I_F1W3, I_WIN, I_CONVW, I_CONVB, I_BIG, I_BFG, I_GQ, I_GK, I_LAMQK, I_GDA, I_GML, I_WOUT, I_F2W12, I_F2W3 };

__device__ __forceinline__ void transpose_item(const float* W, int K, int ldw, int nsrc0, bf16* WT, int ndst0, LAS float* scr, int k0, int lane) {
#pragma unroll 8
    for (int i = 0; i < 32; ++i) { const int kk = 2 * i + (lane >> 5); scr[kk * 33 + (lane & 31)] = W[(size_t)(k0 + kk) * ldw + nsrc0 + (lane & 31)]; }
    LDS_WAIT();
    const int c = lane & 7;
#pragma unroll
    for (int j = 0; j < 4; ++j) { const int n = (lane >> 3) + 8 * j; const LAS float* s = scr + (8 * c) * 33 + n;
        v4u o; o.x = pk2(s[0 * 33], s[1 * 33]); o.y = pk2(s[2 * 33], s[3 * 33]); o.z = pk2(s[4 * 33], s[5 * 33]); o.w = pk2(s[6 * 33], s[7 * 33]);
        *(v4u*)(WT + (size_t)(ndst0 + n) * K + k0 + 8 * c) = o; }
    LDS_WAIT();
}
__device__ __forceinline__ void p0_prologue(const Args& a, LAS unsigned char* lds) {
    const int tid = __tid_l(), lane = tid & 63, wave = __builtin_amdgcn_readfirstlane(tid >> 6), G = gridDim.x, bx = blockIdx.x;
    unsigned char* ws = a.ws;
    if (bx == 0 && tid < 64) ((unsigned*)(ws + WS_CTL))[tid * 64] = 0u;
    for (int i = bx * 512 + tid; i < TOK; i += G * 512) ((float*)(ws + WS_RSS))[i] = 0.f;
    {
        LAS float* sc = (LAS float*)lds;
        LAS float* red = (LAS float*)(lds + 32768);
        const float* c = a.in[I_C];
        for (int i = tid; i < 8192; i += 512) { const int b = i >> 10, k = i & 1023; const float v = c[i]; sc[k * 8 + b] = v / (1.0f + __expf(-v)); }
        __syncthreads();
        const float* wada = a.in[I_WADA]; const float* bada = a.in[I_BADA]; float* mod = (float*)(ws + WS_MOD);
        for (int jb = bx; jb < 256; jb += G) {
            const int j0 = jb * 36; float acc[8];
#pragma unroll
            for (int b = 0; b < 8; ++b) acc[b] = 0.f;
            if (lane < 36) {
                const float* wp = wada + (size_t)(wave * 128) * NMOD + j0 + lane;
#pragma unroll 32
                for (int k = 0; k < 128; ++k) {
                    const float wv = wp[(size_t)k * NMOD];
                    const f32x4 s0 = *(const LAS f32x4*)(sc + (wave * 128 + k) * 8), s1 = *(const LAS f32x4*)(sc + (wave * 128 + k) * 8 + 4);
                    acc[0] += wv * s0[0]; acc[1] += wv * s0[1]; acc[2] += wv * s0[2]; acc[3] += wv * s0[3];
                    acc[4] += wv * s1[0]; acc[5] += wv * s1[1]; acc[6] += wv * s1[2]; acc[7] += wv * s1[3];
                }
#pragma unroll
                for (int b = 0; b < 8; ++b) red[(wave * 8 + b) * 36 + lane] = acc[b];
            }
            __syncthreads();
            if (tid < 288) { const int b = tid / 36, j = tid % 36; float s = bada[j0 + j];
#pragma unroll
                for (int w = 0; w < 8; ++w) s += red[(w * 8 + b) * 36 + j];
                mod[(size_t)b * NMOD + j0 + j] = s; }
            __syncthreads();
        }
    }
    {
        float* rope = (float*)(ws + WS_ROPE);
        for (int e = bx * 512 + tid; e < SEQ * 8; e += G * 512) {
            const int pos = e >> 3, i = e & 7;
            const float invf = powf(500000.0f, -(float)i * 0.125f);
            const float ang = (float)pos * invf;
            const double k = rint((double)ang * 0.15915494309189535);
            const float r = (float)((double)ang - k * 6.283185307179586);
            rope[2 * e] = cosf(r); rope[2 * e + 1] = sinf(r);
        }
    }
    {
        LAS float* scr = (LAS float*)(lds + wave * 16384);
        const int gw = bx * 8 + wave, NGW = G * 8;
        constexpr int I_12 = 16 * 176, I_3 = 44 * 32, I_IN = 16 * 112, I_O = 16 * 32, NITEMS = 2 * I_12 + 2 * I_3 + I_IN + I_O;
        for (int it = gw; it < NITEMS; it += NGW) {
            int r = it;
            if (r < 2 * I_12) {
                const int which = r >= I_12; r -= which * I_12; const int kb = r / 176, nb = r % 176, n0 = nb * 32;
                const int src = ((n0 >> 7) & 1) * FF + (n0 >> 8) * 128 + (n0 & 127);
                transpose_item(a.in[which ? I_F2W12 : I_F1W12], 1024, 2 * FF, src, (bf16*)(ws + (which ? WS_W12B : WS_W12A)), n0, scr, kb * 64, lane); continue; }
            r -= 2 * I_12;
            if (r < 2 * I_3) { const int which = r >= I_3; r -= which * I_3; const int kb = r / 32, nb = r % 32;
                transpose_item(a.in[which ? I_F2W3 : I_F1W3], FF, 1024, nb * 32, (bf16*)(ws + (which ? WS_W3B : WS_W3A)), nb * 32, scr, kb * 64, lane); continue; }
            r -= 2 * I_3;
            if (r < I_IN) { const int kb = r / 112, nb = r % 112, n0 = nb * 32;
                const int src = (n0 & ~255) + ((n0 >> 5) & 3) * 64 + ((n0 >> 7) & 1) * 32;
                transpose_item(a.in[I_WIN], 1024, NIN, src, (bf16*)(ws + WS_WIN), n0, scr, kb * 64, lane); continue; }
            r -= I_IN;
            { const int kb = r / 32, nb = r % 32; transpose_item(a.in[I_WOUT], 1024, 1024, nb * 32, (bf16*)(ws + WS_WOUT), nb * 32, scr, kb * 64, lane); }
        }
    }
}

template <bool GATES, bool XBF>
__device__ __forceinline__ void norm_phase(const Args& a, const void* xin_, int sub, LAS unsigned char* lds) {
    const int tid = __tid_l(), lane = tid & 63, wave = __builtin_amdgcn_readfirstlane(tid >> 6), G = gridDim.x, bx = blockIdx.x;
    bf16* hn = (bf16*)(a.ws + WS_HN); const float* mod = (const float*)(a.ws + WS_MOD); float* gates = (float*)(a.ws + WS_GATES);
    const float* gn = a.in[I_GNORM] + sub * 1024;
    f32x4 wlo[GATES ? 16 : 1], whi[GATES ? 16 : 1];
    if (GATES) {
        const float* win = a.in[I_WIN];
#pragma unroll
        for (int j = 0; j < 4; ++j)
#pragma unroll
            for (int e = 0; e < 4; ++e) { const float* wp = win + (size_t)(256 * j + 4 * lane + e) * NIN + NINP; wlo[4 * j + e] = *(const f32x4*)wp; whi[4 * j + e] = *(const f32x4*)(wp + 4); }
    }
    const int gw = bx * 8 + wave, NGW = G * 8;
    if (!GATES && !XBF) {
        const bf16* Wt = (const bf16*)(a.ws + WS_W12B); float* sb = (float*)(a.ws + WS_SB3);
        for (int n = gw; n < 2 * FF; n += NGW) {
            float wv[16];
#pragma unroll
            for (int j = 0; j < 4; ++j) { const v2u w = *(const v2u*)(Wt + (size_t)n * 1024 + 256 * j + 4 * lane); wv[4 * j] = bflo(w.x); wv[4 * j + 1] = bfhi(w.x); wv[4 * j + 2] = bflo(w.y); wv[4 * j + 3] = bfhi(w.y); }
#pragma unroll
            for (int b = 0; b < 8; ++b) { const float* sh = mod + (size_t)b * NMOD + 6 * 1024 + 4 * lane; float s = 0.f;
#pragma unroll
                for (int j = 0; j < 4; ++j) { const f32x4 sv = *(const f32x4*)(sh + 256 * j); s += (wv[4 * j] * sv[0] + wv[4 * j + 1] * sv[1]) + (wv[4 * j + 2] * sv[2] + wv[4 * j + 3] * sv[3]); }
                s = wave_sum(s);
                if (lane == 0) sb[(size_t)b * (2 * FF) + n] = s; }
        }
    }
    for (int rb = gw; rb < TOK / 16; rb += NGW) {
        const int row0 = rb * 16, b = row0 >> 12;
        const float* mb = mod + (size_t)b * NMOD + sub * 3072;
        f32x4 gs[4], sh[4];
#pragma unroll
        for (int j = 0; j < 4; ++j) { const int col = 256 * j + 4 * lane; gs[j] = *(const f32x4*)(gn + col) * (*(const f32x4*)(mb + 1024 + col) + 1.0f); sh[j] = *(const f32x4*)(mb + col); }
#pragma unroll 2
        for (int r = 0; r < 16; ++r) {
            f32x4 v[4]; float ss = 0.f;
#pragma unroll
            for (int j = 0; j < 4; ++j) {
                if (XBF) { const v2u w = *(const v2u*)((const bf16*)xin_ + (size_t)(row0 + r) * 1024 + 4 * lane + 256 * j); v[j] = (f32x4){bflo(w.x), bfhi(w.x), bflo(w.y), bfhi(w.y)}; }
                else v[j] = *(const f32x4*)((const float*)xin_ + (size_t)(row0 + r) * 1024 + 4 * lane + 256 * j);
                ss += (v[j][0] * v[j][0] + v[j][1] * v[j][1]) + (v[j][2] * v[j][2] + v[j][3] * v[j][3]); }
            const float rinv = 1.0f / sqrtf(wave_sum(ss) * (1.0f / 1024.0f) + 1e-6f);
            bf16* orow = hn + (size_t)(row0 + r) * 1024 + 4 * lane;
#pragma unroll
            for (int j = 0; j < 4; ++j) { v[j] = v[j] * rinv * gs[j] + sh[j]; v2u o; o.x = pk2(v[j][0], v[j][1]); o.y = pk2(v[j][2], v[j][3]); *(v2u*)(orow + 256 * j) = o; }
            if (GATES) {
                f32x4 glo = (f32x4){0.f, 0.f, 0.f, 0.f}, ghi = (f32x4){0.f, 0.f, 0.f, 0.f};
#pragma unroll
                for (int j = 0; j < 4; ++j)
#pragma unroll
                    for (int e = 0; e < 4; ++e) { glo += wlo[4 * j + e] * v[j][e]; ghi += whi[4 * j + e] * v[j][e]; }
                const bool u32_ = (lane & 32) != 0, u16_ = (lane & 16) != 0, u8_ = (lane & 8) != 0;
                f32x4 keep = u32_ ? ghi : glo; const f32x4 send = u32_ ? glo : ghi;
#pragma unroll
                for (int e = 0; e < 4; ++e) keep[e] += __shfl_xor(send[e], 32);
                float k20 = u16_ ? keep[2] : keep[0], k21 = u16_ ? keep[3] : keep[1]; const float s20 = u16_ ? keep[0] : keep[2], s21 = u16_ ? keep[1] : keep[3];
                k20 += __shfl_xor(s20, 16); k21 += __shfl_xor(s21, 16);
                float k1 = u8_ ? k21 : k20; const float s1 = u8_ ? k20 : k21;
                k1 += __shfl_xor(s1, 8);
                k1 += __shfl_xor(k1, 4); k1 += __shfl_xor(k1, 2); k1 += __shfl_xor(k1, 1);
                if ((lane & 7) == 0) gates[(size_t)(row0 + r) * 8 + (lane >> 3)] = k1;
            }
        }
    }
}

namespace ml {
constexpr int QP = 136, SP = 72;
constexpr int L_QS = 0, L_KS = 17408, LP_EP = 71680;
constexpr int L_VS = 33792, L_WS = 41984, L_CT = 51200, L_N = 68608, L_QN = 69120, L_RS = 69376, L_RK = 69888, L_G = 70400, GSTRIDE = 1024, L_BPL = 72448;
typedef short v4i16_t __attribute__((ext_vector_type(4)));
__device__ __forceinline__ bf16x8 tr_frag(const LAS unsigned char* p0, const LAS unsigned char* p1) {
    const v4i16_t lo = __builtin_amdgcn_ds_read_tr16_b64_v4i16((LAS v4i16_t*)p0), hi = __builtin_amdgcn_ds_read_tr16_b64_v4i16((LAS v4i16_t*)p1);
    return (bf16x8){lo[0], lo[1], lo[2], lo[3], hi[0], hi[1], hi[2], hi[3]};
}
__device__ __forceinline__ float scan_add(float v, int lane) {
#pragma unroll
    for (int o = 1; o < 64; o <<= 1) { const float t = __shfl_up(v, o); if (lane >= o) v += t; }
    return v;
}
__device__ __forceinline__ float scan_max(float v, int lane) {
#pragma unroll
    for (int o = 1; o < 64; o <<= 1) { const float t = __shfl_up(v, o); if (lane >= o) v = fmaxf(v, t); }
    return v;
}
}

__device__ __forceinline__ void mlprep_phase(const Args& a, LAS unsigned char* lds) {
    using namespace ml;
    const int tid = __tid_l(), lane = tid & 63, wave = __builtin_amdgcn_readfirstlane(tid >> 6), G = gridDim.x, bx = blockIdx.x;
    const bf16* MLQK = (const bf16*)(a.ws + WS_MLQK);
    LAS bf16* Qs = (LAS bf16*)(lds + L_QS); LAS bf16* Ks = (LAS bf16*)(lds + L_KS); LAS float* EP = (LAS float*)(lds + LP_EP);
    const int cg_ = tid & 31, rg = tid >> 5; const bool isq = cg_ < 16;
    for (int it = bx; it < 2048; it += G) {
        const int bh = it >> 6, c = it & 63, b = bh >> 2, h = bh & 3;
        const int colq = isq ? (h * 128 + cg_ * 8) : (512 + h * 128 + (cg_ - 16) * 8);
        const bf16* qk_base = MLQK + (size_t)b * SEQ * 1024 + colq;
        v4u uq[7];
        { const int t0 = c * 64 + rg * 4 - 3;
#pragma unroll
          for (int i = 0; i < 7; ++i) { const int t = t0 + i; uq[i] = *(const v4u*)(qk_base + (size_t)(t < 0 ? 0 : t) * 1024); if (t < 0) uq[i] = (v4u){0u, 0u, 0u, 0u}; }
 }
        float cw[4][8], cb[8];
#pragma unroll
        for (int j = 0; j < 4; ++j) { const f32x4 w0 = *(const f32x4*)(a.in[I_CONVW] + j * 1024 + colq), w1 = *(const f32x4*)(a.in[I_CONVW] + j * 1024 + colq + 4);
            cw[j][0] = w0[0]; cw[j][1] = w0[1]; cw[j][2] = w0[2]; cw[j][3] = w0[3]; cw[j][4] = w1[0]; cw[j][5] = w1[1]; cw[j][6] = w1[2]; cw[j][7] = w1[3]; }
        { const f32x4 w0 = *(const f32x4*)(a.in[I_CONVB] + colq), w1 = *(const f32x4*)(a.in[I_CONVB] + colq + 4);
          cb[0] = w0[0]; cb[1] = w0[1]; cb[2] = w0[2]; cb[3] = w0[3]; cb[4] = w1[0]; cb[5] = w1[1]; cb[6] = w1[2]; cb[7] = w1[3]; }
        if (wave == 0) {
            const float* gp = (const float*)(a.ws + WS_GATES) + ((size_t)b * SEQ + c * 64 + lane) * 8;
            const float ig = gp[h] + a.in[I_BIG][h], fg = gp[4 + h] + a.in[I_BFG][h];
            const float fl = fminf(fg, 0.f) - log1pf(__expf(-fabsf(fg)));
            const float bb = scan_add(fl, lane), p = ig - bb;
            EP[lane] = __expf(p);
            float* bpo = (float*)(a.ws + WS_BP) + ((size_t)bh * SEQ + c * 64 + lane) * 2; bpo[0] = bb; bpo[1] = p;
        }
        __syncthreads();
        {
#pragma unroll
          for (int r = 0; r < 4; ++r) { float o[8];
#pragma unroll
              for (int i = 0; i < 8; ++i) o[i] = cb[i];
#pragma unroll
              for (int j = 0; j < 4; ++j) { const v4u u_ = uq[r + j];
                  o[0] += cw[j][0] * bflo(u_.x); o[1] += cw[j][1] * bfhi(u_.x); o[2] += cw[j][2] * bflo(u_.y); o[3] += cw[j][3] * bfhi(u_.y);
                  o[4] += cw[j][4] * bflo(u_.z); o[5] += cw[j][5] * bfhi(u_.z); o[6] += cw[j][6] * bflo(u_.w); o[7] += cw[j][7] * bfhi(u_.w); }
              const int t_ = rg * 4 + r;
              const float qs_ = isq ? 0.08838834764831845f : EP[t_];
#pragma unroll
              for (int i = 0; i < 8; ++i) o[i] = o[i] * __builtin_amdgcn_rcpf(1.0f + __builtin_amdgcn_exp2f(-1.4426950408889634f * o[i])) * qs_;
              v4u w_; w_.x = pk2(o[0], o[1]); w_.y = pk2(o[2], o[3]); w_.z = pk2(o[4], o[5]); w_.w = pk2(o[6], o[7]);
              if (isq) *(LAS v4u*)(Qs + t_ * QP + cg_ * 8) = w_; else *(LAS v4u*)(Ks + t_ * QP + (cg_ - 16) * 8) = w_;
          }
        }
        __syncthreads();
        { bf16* ga = (bf16*)(a.ws + WS_IMGA) + (size_t)it * 16384;
#pragma unroll
          for (int k = 0; k < 2; ++k) { const int idx = tid + 512 * k, row = idx >> 4, ch = idx & 15;
              *(v4u*)(ga + idx * 8) = *(const LAS v4u*)(Qs + row * QP + ch * 8); *(v4u*)(ga + 8192 + idx * 8) = *(const LAS v4u*)(Ks + row * QP + ch * 8); }
          { const int d = tid & 127, sq = tid >> 7; float s = 0.f;
#pragma unroll
            for (int k = 0; k < 16; ++k) s += __builtin_bit_cast(float, (unsigned)Ks[(sq * 16 + k) * QP + d] << 16);
            ((LAS float*)(lds + LP_EP + 1024))[sq * 128 + d] = s; }
        }
        __syncthreads();
        if (tid < 128) { LAS float* rp = (LAS float*)(lds + LP_EP + 1024); ((float*)(a.ws + WS_RK))[(size_t)it * 128 + tid] = (rp[tid] + rp[128 + tid]) + (rp[256 + tid] + rp[384 + tid]); }
        __syncthreads();
    }
}

__device__ __forceinline__ void mlstm_item(const Args& a, int item, LAS unsigned char* lds) {
    using namespace ml;
    const int tid = __tid_l(), lane = tid & 63, wave = __builtin_amdgcn_readfirstlane(tid >> 6), l31 = lane & 31, g = lane >> 5;
    const int b = item >> 3, h = (item >> 1) & 3, half = item & 1, bh = b * 4 + h;
    const bf16* imgA = (const bf16*)(a.ws + WS_IMGA) + (size_t)bh * 64 * 16384 + tid * 8;
    const bf16* vsrc = (const bf16*)(a.ws + WS_MLV) + ((size_t)b * SEQ + (tid >> 3)) * 512 + h * 128 + half * 64 + (tid & 7) * 8;
    const float* bp = (const float*)(a.ws + WS_BP) + (size_t)bh * SEQ * 2;
    const float* rkg = (const float*)(a.ws + WS_RK) + (size_t)bh * 64 * 128;
    bf16* h_base = (bf16*)(a.ws + WS_MLH) + (size_t)b * SEQ * 512 + h * 128 + half * 64;

    LAS bf16* Qs = (LAS bf16*)(lds + L_QS); LAS bf16* Ws = (LAS bf16*)(lds + L_WS); LAS bf16* CT = (LAS bf16*)(lds + L_CT);
    LAS unsigned char* KsB = lds + L_KS; LAS unsigned char* VsB = lds + L_VS;
    const int li_ = lane & 15, tq_ = li_ >> 2, tp_ = li_ & 3, tc16_ = (lane >> 4) & 1;
    const int vtrb = 1024 * g + 64 * tq_ + 16 * (2 * tc16_ + (tp_ >> 1)) + 8 * (tp_ & 1);
    LAS float* Nv = (LAS float*)(lds + L_N); LAS float* QN = (LAS float*)(lds + L_QN); LAS float* RS = (LAS float*)(lds + L_RS); LAS float* RK = (LAS float*)(lds + L_RK);
#define GB(buf) ((LAS float*)(lds + L_G + (buf) * GSTRIDE))
#define ML_BAR() asm volatile("s_waitcnt lgkmcnt(0)\n\ts_barrier" ::: "memory")
    v4u pfA[5], pfB[5]; unsigned rkA = 0u, rkB = 0u;
    const int crow_ = tid >> 4, cch = tid & 15, crow8 = tid >> 3, cch8 = tid & 7;
    const float* rkl = rkg + (tid & 127);
#define ALOAD4(r, p) asm volatile("global_load_dwordx4 %0, %1, off" : "=&v"(r) : "v"(p) : "memory")
#define ALOAD1(r, p) asm volatile("global_load_dword %0, %1, off" : "=&v"(r) : "v"(p) : "memory")
#define TILE_LOAD(c, pf, rk) do { const bf16* ga_ = imgA + (size_t)(c) * 16384; \
        ALOAD4(pf[0], ga_); ALOAD4(pf[1], ga_ + 4096); ALOAD4(pf[2], ga_ + 8192); ALOAD4(pf[3], ga_ + 12288); \
        ALOAD4(pf[4], vsrc + (size_t)(c) * 64 * 512); ALOAD1(rk, rkl + (c) * 128); } while (0)
#define TILE_WAIT(N, pf, rk) asm volatile("s_waitcnt vmcnt(" #N ")" : "+v"(pf[0]), "+v"(pf[1]), "+v"(pf[2]), "+v"(pf[3]), "+v"(pf[4]), "+v"(rk) : : "memory")
#define KSWZ(row) ((((row) & 3) << 2) | (((row) >> 2) & 3))
#define TILE_WRITE(pf, rk) do { \
        *(LAS v4u*)(Qs + crow_ * QP + cch * 8) = pf[0]; *(LAS v4u*)(Qs + (crow_ + 32) * QP + cch * 8) = pf[1]; \
        *(LAS v4u*)(KsB + 256 * crow_ + 16 * (cch ^ KSWZ(crow_))) = pf[2]; *(LAS v4u*)(KsB + 256 * (crow_ + 32) + 16 * (cch ^ KSWZ(crow_))) = pf[3];     \
        *(LAS v4u*)(VsB + 1024 * (crow8 >> 3) + 512 * (cch8 >> 2) + 64 * (crow8 & 7) + 16 * (cch8 & 3)) = pf[4]; \
        if (tid < 128) RK[tid] = __builtin_bit_cast(float, rk); } while (0)
#define TRF(p0_) tr_frag((p0_), (p0_) + 256)
    float Mc = 0.f;
    LAS float* BPL = (LAS float*)(lds + L_BPL);
#define GATE_SCAN(c, buf) do { LAS float* o_ = GB(buf); const float gb_b = BPL[((c) * 64 + lane) * 2], gb_p = BPL[((c) * 64 + lane) * 2 + 1]; \
        const float P_ = scan_max(gb_p, lane); const float gg_ = __shfl(gb_b, 63), Pm_ = __shfl(P_, 63); \
        const float mt_ = gb_b + fmaxf(Mc, P_); const float al_ = gb_b - mt_; const float Mn_ = gg_ + fmaxf(Mc, Pm_); \
        o_[lane] = __expf(al_); o_[64 + lane] = __expf(al_ + Mc); o_[128 + lane] = __expf(-mt_); \
        if (lane == 0) { o_[192] = __expf(gg_ + Mc - Mn_); o_[193] = __expf(gg_ - Mn_); } Mc = Mn_; } while (0)

    f32x16 C;
#pragma unroll
    for (int r = 0; r < 16; ++r) C[r] = 0.f;
    const int dq = wave & 3, eh2 = wave >> 2;
    const int kch_ = 4 * dq + 2 * tc16_ + (tp_ >> 1);
    const int kt0 = 256 * (8 * g + tq_) + 16 * (kch_ ^ ((tq_ << 2) | (2 * g))) + 8 * (tp_ & 1), kt1 = 256 * (8 * g + 4 + tq_) + 16 * (kch_ ^ ((tq_ << 2) | (2 * g + 1))) + 8 * (tp_ & 1);
    for (int i = tid; i < 64 * QP / 2; i += 512) ((LAS unsigned*)CT)[i] = 0u;
    if (tid < 128) Nv[tid] = 0.f;
#pragma unroll
    for (int k = 0; k < 4; ++k) *(LAS f32x4*)(BPL + (tid + 512 * k) * 4) = *(const f32x4*)(bp + (tid + 512 * k) * 4);
    asm volatile("s_waitcnt vmcnt(0)" ::: "memory");
    TILE_LOAD(0, pfA, rkA); TILE_WAIT(0, pfA, rkA); TILE_WRITE(pfA, rkA);
    TILE_LOAD(1, pfB, rkB); TILE_LOAD(2, pfA, rkA);
    __syncthreads();
    if (wave == 4) GATE_SCAN(0, 0);
    __syncthreads();

    for (int c2 = 0; c2 < 64; c2 += 2) {
        { const int c = c2; const int cur = c & 1; LAS float* gb = GB(cur);
        if (wave == 4 && c + 1 < 64) GATE_SCAN(c + 1, cur ^ 1);
        { const int t = tid >> 3, d0 = (tid & 7) * 16; float s = 0.f;
#pragma unroll
          for (int k = 0; k < 2; ++k) { const v4u q8 = *(const LAS v4u*)(Qs + t * QP + d0 + 8 * k); const f32x4 n0 = *(const LAS f32x4*)(Nv + d0 + 8 * k), n1 = *(const LAS f32x4*)(Nv + d0 + 8 * k + 4);
              s += bflo(q8.x) * n0[0] + bfhi(q8.x) * n0[1] + bflo(q8.y) * n0[2] + bfhi(q8.y) * n0[3] + bflo(q8.z) * n1[0] + bfhi(q8.z) * n1[1] + bflo(q8.w) * n1[2] + bfhi(q8.w) * n1[3]; }
          s += __shfl_xor(s, 1); s += __shfl_xor(s, 2); s += __shfl_xor(s, 4);
          if ((tid & 7) == 0) QN[t] = s; }
        f32x16 acc;
#pragma unroll
        for (int r = 0; r < 16; ++r) acc[r] = 0.f;
        const int th = (wave & 3) >> 1, xh = wave & 1;
        const int t = 32 * th + l31;
        if (wave < 4) {
#pragma unroll
            for (int kk = 0; kk < 8; ++kk) { const bf16x8 av = *(const LAS bf16x8*)(KsB + 256 * (32 * xh + l31) + 16 * ((2 * kk + g) ^ KSWZ(l31))), bv = *(const LAS bf16x8*)(Qs + t * QP + kk * 16 + 8 * g);
                acc = __builtin_amdgcn_mfma_f32_32x32x16_bf16(av, bv, acc, 0, 0, 0); }
            const float ea = gb[t]; float rsum = 0.f;
#pragma unroll
            for (int i = 0; i < 4; ++i) { float wv[4];
#pragma unroll
                for (int e = 0; e < 4; ++e) { const int s = 32 * xh + 8 * i + 4 * g + e; wv[e] = (s <= t) ? acc[4 * i + e] * ea : 0.f; rsum += wv[e]; }
                v2u w2; w2.x = pk2(wv[0], wv[1]); w2.y = pk2(wv[2], wv[3]); *(LAS v2u*)(Ws + t * SP + 32 * xh + 8 * i + 4 * g) = w2; }
            rsum += __shfl_xor(rsum, 32);
            if (g == 0) RS[xh * 64 + t] = rsum;
        } else {
#pragma unroll
            for (int kk = 0; kk < 8; ++kk) { const bf16x8 av = *(const LAS bf16x8*)(CT + (32 * xh + l31) * QP + kk * 16 + 8 * g), bv = *(const LAS bf16x8*)(Qs + t * QP + kk * 16 + 8 * g);
                acc = __builtin_amdgcn_mfma_f32_32x32x16_bf16(av, bv, acc, 0, 0, 0); }
            const float ei = gb[64 + t];
#pragma unroll
            for (int r = 0; r < 16; ++r) acc[r] *= ei;
        }
        ML_BAR();
        if (wave >= 4) {
#pragma unroll
            for (int kk = 0; kk < 4; ++kk) { const bf16x8 av = TRF(VsB + vtrb + 2048 * kk + 512 * xh), bv = *(const LAS bf16x8*)(Ws + t * SP + kk * 16 + 8 * g);
                acc = __builtin_amdgcn_mfma_f32_32x32x16_bf16(av, bv, acc, 0, 0, 0); }
            const float den = gb[64 + t] * QN[t] + RS[t] + RS[64 + t];
            const float inv = 1.0f / fmaxf(fabsf(den), gb[128 + t]);
            bf16* hp = h_base + (size_t)(c * 64 + t) * 512 + 32 * xh + 4 * g;
#pragma unroll
            for (int i = 0; i < 4; ++i) { v2u o; o.x = pk2(acc[4 * i] * inv, acc[4 * i + 1] * inv); o.y = pk2(acc[4 * i + 2] * inv, acc[4 * i + 3] * inv); *(v2u*)(hp + 8 * i) = o; }
        }
        const float decay = gb[192], ff = gb[193];
        { f32x16 P;
#pragma unroll
          for (int r = 0; r < 16; ++r) P[r] = 0.f;
#pragma unroll
          for (int kk = 0; kk < 4; ++kk) { const bf16x8 av = tr_frag(KsB + kt0 + 4096 * kk, KsB + kt1 + 4096 * kk), bv = TRF(VsB + vtrb + 2048 * kk + 512 * eh2);
              P = __builtin_amdgcn_mfma_f32_32x32x16_bf16(av, bv, P, 0, 0, 0); }
#pragma unroll
          for (int r = 0; r < 16; ++r) C[r] = decay * C[r] + ff * P[r]; }
        float nnew = 0.f;
        if (tid < 128) nnew = decay * Nv[tid] + ff * RK[tid];
        ML_BAR();
#pragma unroll
        for (int i = 0; i < 4; ++i) { v2u o; o.x = pk2(C[4 * i], C[4 * i + 1]); o.y = pk2(C[4 * i + 2], C[4 * i + 3]); *(LAS v2u*)(CT + (32 * eh2 + l31) * QP + 32 * dq + 8 * i + 4 * g) = o; }
        if (tid < 128) Nv[tid] = nnew;
        if (c + 1 < 64) { if (c + 2 < 64) TILE_WAIT(6, pfB, rkB); else TILE_WAIT(0, pfB, rkB); TILE_WRITE(pfB, rkB); }
        if (c + 3 < 64) TILE_LOAD(c + 3, pfB, rkB);
        ML_BAR();
                }
        { const int c = c2 + 1; const int cur = c & 1; LAS float* gb = GB(cur);
        if (wave == 4 && c + 1 < 64) GATE_SCAN(c + 1, cur ^ 1);
        { const int t = tid >> 3, d0 = (tid & 7) * 16; float s = 0.f;
#pragma unroll
          for (int k = 0; k < 2; ++k) { const v4u q8 = *(const LAS v4u*)(Qs + t * QP + d0 + 8 * k); const f32x4 n0 = *(const LAS f32x4*)(Nv + d0 + 8 * k), n1 = *(const LAS f32x4*)(Nv + d0 + 8 * k + 4);
              s += bflo(q8.x) * n0[0] + bfhi(q8.x) * n0[1] + bflo(q8.y) * n0[2] + bfhi(q8.y) * n0[3] + bflo(q8.z) * n1[0] + bfhi(q8.z) * n1[1] + bflo(q8.w) * n1[2] + bfhi(q8.w) * n1[3]; }
          s += __shfl_xor(s, 1); s += __shfl_xor(s, 2); s += __shfl_xor(s, 4);
          if ((tid & 7) == 0) QN[t] = s; }
        f32x16 acc;
#pragma unroll
        for (int r = 0; r < 16; ++r) acc[r] = 0.f;
        const int th = (wave & 3) >> 1, xh = wave & 1;
        const int t = 32 * th + l31;
        if (wave < 4) {
#pragma unroll
            for (int kk = 0; kk < 8; ++kk) { const bf16x8 av = *(const LAS bf16x8*)(KsB + 256 * (32 * xh + l31) + 16 * ((2 * kk + g) ^ KSWZ(l31))), bv = *(const LAS bf16x8*)(Qs + t * QP + kk * 16 + 8 * g);
                acc = __builtin_amdgcn_mfma_f32_32x32x16_bf16(av, bv, acc, 0, 0, 0); }
            const float ea = gb[t]; float rsum = 0.f;
#pragma unroll
            for (int i = 0; i < 4; ++i) { float wv[4];
#pragma unroll
                for (int e = 0; e < 4; ++e) { const int s = 32 * xh + 8 * i + 4 * g + e; wv[e] = (s <= t) ? acc[4 * i + e] * ea : 0.f; rsum += wv[e]; }
                v2u w2; w2.x = pk2(wv[0], wv[1]); w2.y = pk2(wv[2], wv[3]); *(LAS v2u*)(Ws + t * SP + 32 * xh + 8 * i + 4 * g) = w2; }
            rsum += __shfl_xor(rsum, 32);
            if (g == 0) RS[xh * 64 + t] = rsum;
        } else {
#pragma unroll
            for (int kk = 0; kk < 8; ++kk) { const bf16x8 av = *(const LAS bf16x8*)(CT + (32 * xh + l31) * QP + kk * 16 + 8 * g), bv = *(const LAS bf16x8*)(Qs + t * QP + kk * 16 + 8 * g);
                acc = __builtin_amdgcn_mfma_f32_32x32x16_bf16(av, bv, acc, 0, 0, 0); }
            const float ei = gb[64 + t];
#pragma unroll
            for (int r = 0; r < 16; ++r) acc[r] *= ei;
        }
        ML_BAR();
        if (wave >= 4) {
#pragma unroll
            for (int kk = 0; kk < 4; ++kk) { const bf16x8 av = TRF(VsB + vtrb + 2048 * kk + 512 * xh), bv = *(const LAS bf16x8*)(Ws + t * SP + kk * 16 + 8 * g);
                acc = __builtin_amdgcn_mfma_f32_32x32x16_bf16(av, bv, acc, 0, 0, 0); }
            const float den = gb[64 + t] * QN[t] + RS[t] + RS[64 + t];
            const float inv = 1.0f / fmaxf(fabsf(den), gb[128 + t]);
            bf16* hp = h_base + (size_t)(c * 64 + t) * 512 + 32 * xh + 4 * g;
#pragma unroll
            for (int i = 0; i < 4; ++i) { v2u o; o.x = pk2(acc[4 * i] * inv, acc[4 * i + 1] * inv); o.y = pk2(acc[4 * i + 2] * inv, acc[4 * i + 3] * inv); *(v2u*)(hp + 8 * i) = o; }
        }
        const float decay = gb[192], ff = gb[193];
        { f32x16 P;
#pragma unroll
          for (int r = 0; r < 16; ++r) P[r] = 0.f;
#pragma unroll
          for (int kk = 0; kk < 4; ++kk) { const bf16x8 av = tr_frag(KsB + kt0 + 4096 * kk, KsB + kt1 + 4096 * kk), bv = TRF(VsB + vtrb + 2048 * kk + 512 * eh2);
              P = __builtin_amdgcn_mfma_f32_32x32x16_bf16(av, bv, P, 0, 0, 0); }
#pragma unroll
          for (int r = 0; r < 16; ++r) C[r] = decay * C[r] + ff * P[r]; }
        float nnew = 0.f;
        if (tid < 128) nnew = decay * Nv[tid] + ff * RK[tid];
        ML_BAR();
#pragma unroll
        for (int i = 0; i < 4; ++i) { v2u o; o.x = pk2(C[4 * i], C[4 * i + 1]); o.y = pk2(C[4 * i + 2], C[4 * i + 3]); *(LAS v2u*)(CT + (32 * eh2 + l31) * QP + 32 * dq + 8 * i + 4 * g) = o; }
        if (tid < 128) Nv[tid] = nnew;
        if (c + 1 < 64) { if (c + 2 < 64) TILE_WAIT(6, pfA, rkA); else TILE_WAIT(0, pfA, rkA); TILE_WRITE(pfA, rkA); }
        if (c + 3 < 64) TILE_LOAD(c + 3, pfA, rkA);
        ML_BAR();
                }
    }
    asm volatile("s_waitcnt vmcnt(0)" ::: "memory");
#undef GB
#undef ML_BAR
#undef TILE_LOAD
#undef TILE_WRITE
#undef TILE_WAIT
#undef KSWZ
#undef TRF
#undef ALOAD4
#undef ALOAD1
#undef GATE_SCAN
}

__device__ __forceinline__ unsigned xcc_id() { return (unsigned)__builtin_amdgcn_s_getreg((3 << 11) | 20) & 7u; }
__device__ __forceinline__ void mix_phase(const Args& a, unsigned char* lds_generic, LAS unsigned char* lds, int coff, bool do_ml, bool do_attn) {
    const int tid = __tid_l();
    unsigned* ctr = (unsigned*)(a.ws + WS_CTL) + coff * 64;
    volatile LAS int* MISC = (volatile LAS int*)(lds + MISC_OFF);
    const unsigned myx = xcc_id();
    const attn_body::bf16* Q = (const attn_body::bf16*)(a.ws + WS_Q); const attn_body::bf16* K = (const attn_body::bf16*)(a.ws + WS_K);
    const attn_body::bf16* V = (const attn_body::bf16*)(a.ws + WS_V); attn_body::bf16* AO = (attn_body::bf16*)(a.ws + WS_AO);
    if (do_ml) for (;;) {
        if (tid == 0) { int found = -1;
            const unsigned j0 = __hip_atomic_fetch_add(ctr + (8 + myx) * 64, 1u, __ATOMIC_RELAXED, __HIP_MEMORY_SCOPE_AGENT);
            if (j0 < 8u) found = (int)(myx * 8u + j0);
            else { unsigned cnt[7];
#pragma unroll
                for (unsigned dx = 1; dx < 8; ++dx) cnt[dx - 1] = __hip_atomic_load(ctr + (8 + ((myx + dx) & 7u)) * 64, __ATOMIC_RELAXED, __HIP_MEMORY_SCOPE_AGENT);
#pragma unroll
                for (unsigned dx = 1; dx < 8; ++dx) if (found < 0 && cnt[dx - 1] < 8u) { const unsigned x = (myx + dx) & 7u; const unsigned j = __hip_atomic_fetch_add(ctr + (8 + x) * 64, 1u, __ATOMIC_RELAXED, __HIP_MEMORY_SCOPE_AGENT);
                    if (j < 8u) found = (int)(x * 8u + j); } }
            MISC[0] = found; }
        __syncthreads();
        const int f = __builtin_amdgcn_readfirstlane(MISC[0]);
        __syncthreads();
        if (f < 0) break;
        mlstm_item(a, f, lds);
        __syncthreads();
    }
    if (do_attn) {
        if (tid == 0) { int found = -1;
            const unsigned j0 = __hip_atomic_fetch_add(ctr + myx * 64, 1u, __ATOMIC_RELAXED, __HIP_MEMORY_SCOPE_AGENT);
            if (j0 < 256u) found = (int)(myx * 256u + j0);
            else { unsigned cnt[7];
#pragma unroll
                for (unsigned dx = 1; dx < 8; ++dx) cnt[dx - 1] = __hip_atomic_load(ctr + ((myx + dx) & 7u) * 64, __ATOMIC_RELAXED, __HIP_MEMORY_SCOPE_AGENT);
#pragma unroll
                for (unsigned dx = 1; dx < 8; ++dx) if (found < 0 && cnt[dx - 1] < 256u) { const unsigned x = (myx + dx) & 7u; const unsigned j = __hip_atomic_fetch_add(ctr + x * 64, 1u, __ATOMIC_RELAXED, __HIP_MEMORY_SCOPE_AGENT);
                    if (j < 256u) found = (int)(x * 256u + j); } }
            MISC[0] = found; }
        __syncthreads();
        int f = __builtin_amdgcn_readfirstlane(MISC[0]);
        __syncthreads();
        while (f >= 0) {
            const int x = f >> 8, jj = f & 255, qb = 15 - ((jj & 63) >> 2), bh = x + 8 * ((jj >> 6) * 4 + (jj & 3)), b = bh >> 4, hp = bh & 15;
            unsigned nj = 0u;
            if (tid == 0) nj = __hip_atomic_fetch_add(ctr + x * 64, 1u, __ATOMIC_RELAXED, __HIP_MEMORY_SCOPE_AGENT);
            attn_body::attn_unit<8>(b, (hp >> 1) * 64, ((hp >> 2) * 2 + (hp & 1)) * 64, hp * 64, qb, Q, K, V, AO, (char*)lds_generic);
            if (tid == 0) { int found = -1;
                if (nj < 256u) found = x * 256 + (int)nj;
                else { unsigned cnt[7];
#pragma unroll
                    for (unsigned dx = 1; dx < 8; ++dx) cnt[dx - 1] = __hip_atomic_load(ctr + (((unsigned)x + dx) & 7u) * 64, __ATOMIC_RELAXED, __HIP_MEMORY_SCOPE_AGENT);
#pragma unroll
                    for (unsigned dx = 1; dx < 8; ++dx) if (found < 0 && cnt[dx - 1] < 256u) { const unsigned x2 = ((unsigned)x + dx) & 7u; const unsigned j = __hip_atomic_fetch_add(ctr + x2 * 64, 1u, __ATOMIC_RELAXED, __HIP_MEMORY_SCOPE_AGENT);
                        if (j < 256u) found = (int)(x2 * 256u + j); } }
                MISC[0] = found; }
            __syncthreads();
            f = __builtin_amdgcn_readfirstlane(MISC[0]);
            __syncthreads();
        }
    }
}

__device__ __forceinline__ void combine_phase(const Args& a) {
    const int tid = __tid_l(), lane = tid & 63, wave = __builtin_amdgcn_readfirstlane(tid >> 6), G = gridDim.x, bx = blockIdx.x;
    const bf16* AO = (const bf16*)(a.ws + WS_AO); const bf16* MLH = (const bf16*)(a.ws + WS_MLH); const bf16* MLO = (const bf16*)(a.ws + WS_MLO); bf16* Y = (bf16*)(a.ws + WS_HN);
    const float* lq = a.in[I_LAMQK];
    const float lam = __expf(wave_sum(lq[lane] * lq[64 + lane])) - __expf(wave_sum(lq[128 + lane] * lq[192 + lane])) + 0.2f;
    const int head = lane >> 4, vh = (lane >> 3) & 1, d = (lane & 7) * 8;
    float gda[8], gml[8];
#pragma unroll
    for (int i = 0; i < 8; ++i) { gda[i] = a.in[I_GDA][(lane & 15) * 8 + i] * 0.8f; gml[i] = a.in[I_GML][lane * 8 + i]; }
    const int gw = bx * 8 + wave, NGW = G * 8;
    for (int rb = gw; rb < TOK / 16; rb += NGW) {
#pragma unroll 2
        for (int r = 0; r < 16; ++r) {
            const size_t row = (size_t)rb * 16 + r;
            const v4u a0 = *(const v4u*)(AO + row * 1024 + ((head * 2 + 0) * 2 + vh) * 64 + d), a1 = *(const v4u*)(AO + row * 1024 + ((head * 2 + 1) * 2 + vh) * 64 + d);
            const v4u hh = *(const v4u*)(MLH + row * 512 + lane * 8), oo = *(const v4u*)(MLO + row * 512 + lane * 8);
            const unsigned a0w[4] = {a0.x, a0.y, a0.z, a0.w}, a1w[4] = {a1.x, a1.y, a1.z, a1.w}, hw[4] = {hh.x, hh.y, hh.z, hh.w}, ow[4] = {oo.x, oo.y, oo.z, oo.w};
            float o[8], hv[8], s1 = 0.f, s2 = 0.f;
#pragma unroll
            for (int i = 0; i < 4; ++i) { o[2 * i] = bflo(a0w[i]) - lam * bflo(a1w[i]); o[2 * i + 1] = bfhi(a0w[i]) - lam * bfhi(a1w[i]); hv[2 * i] = bflo(hw[i]); hv[2 * i + 1] = bfhi(hw[i]);
                s1 += o[2 * i] * o[2 * i] + o[2 * i + 1] * o[2 * i + 1]; s2 += hv[2 * i] * hv[2 * i] + hv[2 * i + 1] * hv[2 * i + 1]; }
#pragma unroll
            for (int m = 1; m < 16; m <<= 1) { s1 += __shfl_xor(s1, m); s2 += __shfl_xor(s2, m); }
            const float r1 = 1.0f / sqrtf(s1 * (1.0f / 128.0f) + 1e-6f), r2 = 1.0f / sqrtf(s2 * (1.0f / 128.0f) + 1e-6f);
            float y1[8], y2[8];
#pragma unroll
            for (int i = 0; i < 8; ++i) { const float op = (i & 1) ? bfhi(ow[i >> 1]) : bflo(ow[i >> 1]);
                y1[i] = o[i] * r1 * gda[i]; y2[i] = hv[i] * r2 * gml[i] / (1.0f + __expf(-op)); }
            v4u w1, w2; w1.x = pk2(y1[0], y1[1]); w1.y = pk2(y1[2], y1[3]); w1.z = pk2(y1[4], y1[5]); w1.w = pk2(y1[6], y1[7]);
            w2.x = pk2(y2[0], y2[1]); w2.y = pk2(y2[2], y2[3]); w2.z = pk2(y2[4], y2[5]); w2.w = pk2(y2[6], y2[7]);
            *(v4u*)(Y + row * 1024 + lane * 8) = w1; *(v4u*)(Y + row * 1024 + 512 + lane * 8) = w2;
        }
    }
}

constexpr int N_PHASES = 13;
#ifndef DUP_MASK
#define DUP_MASK 0
#endif
__global__ void __launch_bounds__(512, 2) mk_fwd(Args a) {
    extern __shared__ __attribute__((aligned(16))) unsigned char lds_raw[];
    LAS unsigned char* lds = (LAS unsigned char*)lds_raw;
    cg::grid_group grid = cg::this_grid();
    { volatile LAS unsigned* M_ = (volatile LAS unsigned*)(lds + MISC_OFF); if (threadIdx.x < 32) M_[threadIdx.x] = 0u; __syncthreads(); }
    XcdBarrier xbar = xcd_barrier_post((unsigned*)(a.ws + WS_CTL) + 4096, (volatile LAS unsigned*)(lds + MISC_OFF) + 8);
    if (a.ph_lo < 0) grid.sync();
    const int lo = a.ph_lo, hi = a.ph_hi, G = gridDim.x, bx = blockIdx.x;
    unsigned char* ws = a.ws;
    const float* mod = (const float*)(ws + WS_MOD);
    bf16* HN = (bf16*)(ws + WS_HN); bf16* HID = (bf16*)(ws + WS_HID);
    bf16* X1 = (bf16*)a.out;
    bf16* X2 = (bf16*)(ws + WS_MLV);
#define IN(k) (lo <= (k) && (k) < hi)
#define REP(k) for (int rep_ = 0; rep_ <= ((DUP_MASK >> (k)) & 1); ++rep_)
#define RSYNC() do { if (rep_) xcd_barrier(xbar); } while (0)
#define SEAM(k) do { if (IN(k) && IN((k) + 1)) xcd_barrier(xbar); } while (0)
    if (IN(0)) REP(0) { RSYNC(); p0_prologue(a, lds); } SEAM(0);
    if (DUP_MASK & 0x4000) { for (int i_ = 0; i_ < 10; ++i_) xcd_barrier(xbar); }
    if (IN(1)) REP(1) { RSYNC(); norm_phase<false, false>(a, a.in[I_X], 0, lds); } SEAM(1);
    if (IN(2)) REP(2) { RSYNC(); pg8::Gemm g{HN, (const bf16*)(ws + WS_W12A), TOK, 2 * FF, DM}; pg8::StaticOrder S; S.init(TOK, 2 * FF, G, bx);
        pg8::EpiSwiGLU E{HID, FF}; pg8::gemm_phase<pg8::EpiSwiGLU, pg8::StaticOrder, true, true>(lds, g, S, E); } SEAM(2);
    if (IN(3)) REP(3) { RSYNC(); pg8::Gemm g{HID, (const bf16*)(ws + WS_W3A), TOK, DM, FF}; pg8::StaticOrder S; S.init(TOK, DM, G, bx);
        pg8::EpiResid<0, 1> E{a.in[I_X], X1, mod + 2 * 1024, 0.5f}; pg8::gemm_phase<pg8::EpiResid<0, 1>, pg8::StaticOrder, true, true>(lds, g, S, E); } SEAM(3);
    if (IN(4)) REP(4) { RSYNC(); norm_phase<true, true>(a, X1, 1, lds); } SEAM(4);
    if (IN(5)) REP(5) { RSYNC(); pg8::Gemm g{HN, (const bf16*)(ws + WS_WIN), TOK, NINP, DM}; pg8::StaticOrder S; S.init(TOK, NINP, G, bx);
        pg8::EpiMix E{(bf16*)(ws + WS_Q), (bf16*)(ws + WS_K), (bf16*)(ws + WS_V), (bf16*)(ws + WS_MLQK), (bf16*)(ws + WS_MLV), (bf16*)(ws + WS_MLO), a.in[I_GQ], a.in[I_GK], (const float*)(ws + WS_ROPE), C2Q};
        pg8::gemm_phase<pg8::EpiMix, pg8::StaticOrder, true, true>(lds, g, S, E); } SEAM(5);
    if (IN(6)) REP(6) { RSYNC(); mlprep_phase(a, lds); } SEAM(6);
    if (IN(7)) { mix_phase(a, lds_raw, lds, 0, true, true); if (DUP_MASK & 0x80) { xcd_barrier(xbar); mix_phase(a, lds_raw, lds, 16, true, true); } if (DUP_MASK & 0x1000) { xcd_barrier(xbar); mix_phase(a, lds_raw, lds, 32, true, false); } if (DUP_MASK & 0x2000) { xcd_barrier(xbar); mix_phase(a, lds_raw, lds, 48, false, true); } } SEAM(7);
    if (IN(8)) REP(8) { RSYNC(); combine_phase(a); } SEAM(8);
    if (IN(9)) { pg8::Gemm g{HN, (const bf16*)(ws + WS_WOUT), TOK, DM, DM}; pg8::StaticOrder S; S.init(TOK, DM, G, bx);
        pg8::EpiResidXg E{X1, X2, mod + 5 * 1024, 1.0f, (bf16*)(ws + WS_XG3), a.in[I_GNORM] + 2048, mod + 7 * 1024, (float*)(ws + WS_RSS)}; pg8::gemm_phase<pg8::EpiResidXg, pg8::StaticOrder, true, true>(lds, g, S, E); } SEAM(9);
    if (IN(11)) REP(11) { RSYNC(); pg8::Gemm g{(const bf16*)(ws + WS_XG3), (const bf16*)(ws + WS_W12B), TOK, 2 * FF, DM}; pg8::StaticOrder S; S.init(TOK, 2 * FF, G, bx);
        pg8::EpiSwiGLUN E{HID, FF, (const float*)(ws + WS_RSS), (const float*)(ws + WS_SB3), 2 * FF}; pg8::gemm_phase<pg8::EpiSwiGLUN, pg8::StaticOrder, true, true>(lds, g, S, E); } SEAM(11);
    if (IN(12)) { pg8::Gemm g{HID, (const bf16*)(ws + WS_W3B), TOK, DM, FF}; pg8::StaticOrder S; S.init(TOK, DM, G, bx);
        pg8::EpiResid<1, 0> E{X2, a.out, mod + 8 * 1024, 0.5f}; pg8::gemm_phase<pg8::EpiResid<1, 0>, pg8::StaticOrder, true, true>(lds, g, S, E); }
#undef IN
#undef SEAM
}

#ifndef MK_MULTI
#define MK_MULTI 0
#endif
extern "C" void kernel_launch(void* const* d_in, const int* in_sizes, int n_in, void* d_out, int out_size, void* d_ws, size_t ws_size, hipStream_t stream) {
    static int grid = 0;
    if (grid == 0) {
        if (n_in != 20 || out_size != TOK * DM || ws_size < WS_END) { fprintf(stderr, "kernel_launch: unexpected shapes (n_in %d out %d ws %zu)\n", n_in, out_size, ws_size); grid = -1; return; }
        int dev = 0, cus = 0, per_cu = 0;
        hipGetDevice(&dev); hipDeviceGetAttribute(&cus, hipDeviceAttributeMultiprocessorCount, dev);
        if (hipFuncSetAttribute((const void*)mk_fwd, hipFuncAttributeMaxDynamicSharedMemorySize, LDS_BYTES) != hipSuccess) { fprintf(stderr, "kernel_launch: hipFuncSetAttribute failed\n"); grid = -1; return; }
        hipOccupancyMaxActiveBlocksPerMultiprocessor(&per_cu, (const void*)mk_fwd, 512, LDS_BYTES);
        (void)hipGetLastError();
        if (per_cu < 1) fprintf(stderr, "kernel_launch: occupancy query says %d blocks per CU\n", per_cu);
        grid = cus > 0 ? cus : 256;
    }
    if (grid < 0) return;
    if (hipMemsetAsync((char*)d_ws + WS_CTL, 0, 32768, stream) != hipSuccess) { fprintf(stderr, "kernel_launch: hipMemsetAsync failed\n"); return; }
    Args a{};
    for (int i = 0; i < 20; ++i) a.in[i] = (const float*)d_in[i];
    a.out = (float*)d_out; a.ws = (unsigned char*)d_ws;
#if MK_MULTI
    for (int p = 0; p < N_PHASES; ++p) { a.ph_lo = p; a.ph_hi = p + 1; hipLaunchKernelGGL(mk_fwd, dim3(grid), dim3(512), LDS_BYTES, stream, a); }
#else
    a.ph_lo = 0; a.ph_hi = N_PHASES;
    void* args[] = {&a};
    hipError_t e = hipLaunchCooperativeKernel((const void*)mk_fwd, dim3(grid), dim3(512), args, LDS_BYTES, stream);
    if (e != hipSuccess) fprintf(stderr, "kernel_launch: cooperative launch failed: %s (grid %d)\n", hipGetErrorString(e), grid);
#endif
}
```

```cpp
#include <hip/hip_runtime.h>
#include <hip/hip_cooperative_groups.h>
#include <cstdio>
#include <cstdint>
__device__ __forceinline__ int __tid_l() { int t = threadIdx.x; asm volatile("" : "+v"(t)); return t; }
namespace pg8 {
#define PG8_LAS __attribute__((address_space(3)))
typedef unsigned short bf16_t;
typedef short bf16x8 __attribute__((ext_vector_type(8)));
typedef float f32x4 __attribute__((ext_vector_type(4)));
typedef unsigned u32x4 __attribute__((ext_vector_type(4)));
constexpr int BM = 256, BK = 64, HALF = 128, HTB = HALF * BK * 2  , STAGE_BYTES = 8 * HTB, NXCD = 8, WGM = 8;

__host__ __device__ __forceinline__ int lds_byte(int r, int c) { const int st = (r >> 4) * 2 + (c >> 5), rr = r & 15, cc = c & 31, ob = rr * 64 + cc * 2; return st * 1024 + (ob ^ (((ob >> 9) & 1) << 5)); }
__host__ __device__ __forceinline__ void stage_rc(int b, int& R, int& C) { const int st = b / 1024, sb = b % 1024, swz = sb ^ (((sb >> 9) & 1) << 5); R = (st >> 1) * 16 + swz / 64; C = (st & 1) * 32 + (swz % 64) / 2; }
__host__ __device__ __forceinline__ int perm32(int rho) { const int n = rho >> 4, i = rho & 15; return 8 * (i >> 2) + 4 * n + (i & 3); }

struct Unit { int pm, pn; };
struct Gemm { const bf16_t* A; const bf16_t* Bt; int M, N, K; };

struct StaticOrder {
    int nM, nN, nwg, G, c;
    __host__ __device__ void init(int M, int N, int G_, int c_) { nM = M / BM; nN = N / BM; nwg = nM * nN; G = G_; c = c_; }
    __host__ __device__ bool next(int i, Unit& u) const {
        const long L = (long)i * G + c; if (L >= nwg) return false;
        int wgid = (int)L; { const int q = nwg / NXCD, r = nwg % NXCD, xcd = wgid % NXCD, off = wgid / NXCD; wgid = (xcd < r ? xcd * (q + 1) : r * (q + 1) + (xcd - r) * q) + off; }
        const int nig = WGM * nN, gid = wgid / nig, fm = gid * WGM, gsz = (nM - fm) < WGM ? (nM - fm) : WGM;
        u.pm = fm + ((wgid % nig) % gsz); u.pn = (wgid % nig) / gsz; return true;
    }
    __device__ __forceinline__ void a_ready(const Unit&) const {}
    __device__ __forceinline__ void done(const Unit&) const {}
};

__device__ __forceinline__ unsigned cvt_pk_bf16(float lo, float hi) { unsigned r; asm volatile("v_cvt_pk_bf16_f32 %0, %1, %2" : "=v"(r) : "v"(lo), "v"(hi)); return r; }
__device__ __forceinline__ f32x4 silu4(f32x4 x) {
    f32x4 r;
#pragma unroll
    for (int i = 0; i < 4; ++i) r[i] = x[i] * __builtin_amdgcn_rcpf(1.0f + __builtin_amdgcn_exp2f(-1.4426950408889634f * x[i]));
    return r;
}
struct EpiSwiGLU {
    static constexpr bool PERM = true, AFTER_DRAIN = false;
    bf16_t* O; int ldo;
    __device__ __forceinline__ void operator()(const f32x4 (&acc)[2][2][4][2], const Unit& u, int wr, int wc, int fr, int fq) const {
        const int row0 = u.pm * BM + wr * 64 + fr, col0 = u.pn * HALF + wc * 32 + 8 * fq;
#pragma unroll
        for (int ai = 0; ai < 2; ++ai)
#pragma unroll
            for (int m = 0; m < 4; ++m) {
                bf16_t* p = O + (size_t)(row0 + ai * HALF + m * 16) * ldo + col0;
                const f32x4 h0 = silu4(acc[ai][0][m][0]) * acc[ai][1][m][0], h1 = silu4(acc[ai][0][m][1]) * acc[ai][1][m][1];
                u32x4 w; w.x = cvt_pk_bf16(h0[0], h0[1]); w.y = cvt_pk_bf16(h0[2], h0[3]); w.z = cvt_pk_bf16(h1[0], h1[1]); w.w = cvt_pk_bf16(h1[2], h1[3]);
                *(u32x4*)p = w;
            }
    }
};
template <int BT, int OT>
struct EpiResid {
    static constexpr bool PERM = true, AFTER_DRAIN = false;
    const void* base; void* out; const float* gate; float gs;
    __device__ __forceinline__ void operator()(const f32x4 (&acc)[2][2][4][2], const Unit& u, int wr, int wc, int fr, int fq) const {
        const int row0 = u.pm * BM + wr * 64 + fr, col0 = u.pn * BM + wc * 32 + 8 * fq;
        const float* gp = gate + (size_t)(u.pm >> 4) * 9216 + col0;
        f32x4 gv[2][2];
#pragma unroll
        for (int bj = 0; bj < 2; ++bj)
#pragma unroll
            for (int n = 0; n < 2; ++n) gv[bj][n] = (*(const f32x4*)(gp + bj * HALF + 4 * n) + 1.0f) * gs;
#pragma unroll
        for (int ai = 0; ai < 2; ++ai) {
            f32x4 pre[4][2][2];
#pragma unroll
            for (int m = 0; m < 4; ++m) { const size_t off = (size_t)(row0 + ai * HALF + m * 16) * 1024 + col0;
#pragma unroll
                for (int bj = 0; bj < 2; ++bj) {
                    if (BT == 0) { pre[m][bj][0] = *(const f32x4*)((const float*)base + off + bj * HALF); pre[m][bj][1] = *(const f32x4*)((const float*)base + off + bj * HALF + 4); }
                    else { const u32x4 w = *(const u32x4*)((const bf16_t*)base + off + bj * HALF);
                        pre[m][bj][0] = (f32x4){__builtin_bit_cast(float, w.x << 16), __builtin_bit_cast(float, w.x & 0xffff0000u), __builtin_bit_cast(float, w.y << 16), __builtin_bit_cast(float, w.y & 0xffff0000u)};
                        pre[m][bj][1] = (f32x4){__builtin_bit_cast(float, w.z << 16), __builtin_bit_cast(float, w.z & 0xffff0000u), __builtin_bit_cast(float, w.w << 16), __builtin_bit_cast(float, w.w & 0xffff0000u)}; } } }
            asm volatile("" ::: "memory");
#pragma unroll
            for (int m = 0; m < 4; ++m) { const size_t off = (size_t)(row0 + ai * HALF + m * 16) * 1024 + col0;
#pragma unroll
                for (int bj = 0; bj < 2; ++bj) { const f32x4 o0 = pre[m][bj][0] + gv[bj][0] * acc[ai][bj][m][0], o1 = pre[m][bj][1] + gv[bj][1] * acc[ai][bj][m][1];
                    if (OT == 0) { *(f32x4*)((float*)out + off + bj * HALF) = o0; *(f32x4*)((float*)out + off + bj * HALF + 4) = o1; }
                    else { u32x4 w; w.x = cvt_pk_bf16(o0[0], o0[1]); w.y = cvt_pk_bf16(o0[2], o0[3]); w.z = cvt_pk_bf16(o1[0], o1[1]); w.w = cvt_pk_bf16(o1[2], o1[3]); *(u32x4*)((bf16_t*)out + off + bj * HALF) = w; } } }
            asm volatile("" ::: "memory");
        }
    }
};
struct EpiResidXg {
    static constexpr bool PERM = true, AFTER_DRAIN = false;
    const bf16_t* base; bf16_t* out; const float* gate; float gs; bf16_t* xg; const float* gn; const float* scn; float* rss;
    __device__ __forceinline__ void operator()(const f32x4 (&acc)[2][2][4][2], const Unit& u, int wr, int wc, int fr, int fq) const {
        const int row0 = u.pm * BM + wr * 64 + fr, col0 = u.pn * BM + wc * 32 + 8 * fq;
        const float* gp = gate + (size_t)(u.pm >> 4) * 9216 + col0; const float* sp = scn + (size_t)(u.pm >> 4) * 9216 + col0;
        f32x4 gv[2][2], gsn[2][2];
#pragma unroll
        for (int bj = 0; bj < 2; ++bj)
#pragma unroll
            for (int n = 0; n < 2; ++n) { gv[bj][n] = (*(const f32x4*)(gp + bj * HALF + 4 * n) + 1.0f) * gs; gsn[bj][n] = *(const f32x4*)(gn + col0 + bj * HALF + 4 * n) * (*(const f32x4*)(sp + bj * HALF + 4 * n) + 1.0f); }
#pragma unroll
        for (int ai = 0; ai < 2; ++ai)
#pragma unroll
        for (int mb = 0; mb < 4; mb += 2) {
            u32x4 prb[2][2];
#pragma unroll
            for (int mm = 0; mm < 2; ++mm) { const size_t off = (size_t)(row0 + ai * HALF + (mb + mm) * 16) * 1024 + col0;
#pragma unroll
                for (int bj = 0; bj < 2; ++bj) prb[mm][bj] = *(const u32x4*)(base + off + bj * HALF); }
            asm volatile("" ::: "memory");
#pragma unroll
            for (int mm = 0; mm < 2; ++mm) { const int m = mb + mm; const int row = row0 + ai * HALF + m * 16; const size_t off = (size_t)row * 1024 + col0; float ss = 0.f;
#pragma unroll
                for (int bj = 0; bj < 2; ++bj) { const u32x4 w = prb[mm][bj];
                    const f32x4 p0 = (f32x4){__builtin_bit_cast(float, w.x << 16), __builtin_bit_cast(float, w.x & 0xffff0000u), __builtin_bit_cast(float, w.y << 16), __builtin_bit_cast(float, w.y & 0xffff0000u)};
                    const f32x4 p1 = (f32x4){__builtin_bit_cast(float, w.z << 16), __builtin_bit_cast(float, w.z & 0xffff0000u), __builtin_bit_cast(float, w.w << 16), __builtin_bit_cast(float, w.w & 0xffff0000u)};
                    const f32x4 o0 = p0 + gv[bj][0] * acc[ai][bj][m][0], o1 = p1 + gv[bj][1] * acc[ai][bj][m][1];
                    u32x4 xo; xo.x = cvt_pk_bf16(o0[0], o0[1]); xo.y = cvt_pk_bf16(o0[2], o0[3]); xo.z = cvt_pk_bf16(o1[0], o1[1]); xo.w = cvt_pk_bf16(o1[2], o1[3]); *(u32x4*)(out + off + bj * HALF) = xo;
                    const f32x4 g0 = o0 * gsn[bj][0], g1 = o1 * gsn[bj][1];
                    u32x4 xw; xw.x = cvt_pk_bf16(g0[0], g0[1]); xw.y = cvt_pk_bf16(g0[2], g0[3]); xw.z = cvt_pk_bf16(g1[0], g1[1]); xw.w = cvt_pk_bf16(g1[2], g1[3]); *(u32x4*)(xg + off + bj * HALF) = xw;
                    ss += ((o0[0] * o0[0] + o0[1] * o0[1]) + (o0[2] * o0[2] + o0[3] * o0[3])) + ((o1[0] * o1[0] + o1[1] * o1[1]) + (o1[2] * o1[2] + o1[3] * o1[3])); }
                ss += __shfl_xor(ss, 16); ss += __shfl_xor(ss, 32);
                if (fq == 0) atomicAdd(rss + row, ss); }
            asm volatile("" ::: "memory");
        }
    }
};
struct EpiSwiGLUN {
    static constexpr bool PERM = true, AFTER_DRAIN = false;
    bf16_t* O; int ldo; const float* rss; const float* sb; int nphys;
    __device__ __forceinline__ void operator()(const f32x4 (&acc)[2][2][4][2], const Unit& u, int wr, int wc, int fr, int fq) const {
        const int row0 = u.pm * BM + wr * 64 + fr, col0 = u.pn * HALF + wc * 32 + 8 * fq;
        const float* sp = sb + (size_t)(u.pm >> 4) * nphys + u.pn * BM + wc * 32 + 8 * fq;
        f32x4 sv[2][2];
#pragma unroll
        for (int bj = 0; bj < 2; ++bj)
#pragma unroll
            for (int n = 0; n < 2; ++n) sv[bj][n] = *(const f32x4*)(sp + bj * HALF + 4 * n);
        float rinv[2][4];
#pragma unroll
        for (int ai = 0; ai < 2; ++ai)
#pragma unroll
            for (int m = 0; m < 4; ++m) rinv[ai][m] = __builtin_amdgcn_rsqf(rss[row0 + ai * HALF + m * 16] * (1.0f / 1024.0f) + 1e-6f);
#pragma unroll
        for (int ai = 0; ai < 2; ++ai)
#pragma unroll
            for (int m = 0; m < 4; ++m) {
                bf16_t* p = O + (size_t)(row0 + ai * HALF + m * 16) * ldo + col0; const float ri = rinv[ai][m];
                const f32x4 h0 = silu4(acc[ai][0][m][0] * ri + sv[0][0]) * (acc[ai][1][m][0] * ri + sv[1][0]), h1 = silu4(acc[ai][0][m][1] * ri + sv[0][1]) * (acc[ai][1][m][1] * ri + sv[1][1]);
                u32x4 w; w.x = cvt_pk_bf16(h0[0], h0[1]); w.y = cvt_pk_bf16(h0[2], h0[3]); w.z = cvt_pk_bf16(h1[0], h1[1]); w.w = cvt_pk_bf16(h1[2], h1[3]);
                *(u32x4*)p = w;
            }
    }
};
struct EpiMix {
    static constexpr bool PERM = true, AFTER_DRAIN = false;
    bf16_t *Q, *K, *V, *MLQK, *MLV, *MLO; const float *gq, *gk, *rope; float c2;
    __device__ __forceinline__ void operator()(const f32x4 (&acc)[2][2][4][2], const Unit& u, int wr, int wc, int fr, int fq) const {
        const int pn = u.pn, row0 = u.pm * BM + wr * 64 + fr;
        if (pn < 4) {
            const bool isq = pn < 2; const int grp = (pn & 1) * 4 + wc;
            bf16_t* dst = (isq ? Q : K) + grp * 64 + 8 * fq; const float* gvec = isq ? gq : gk; const float sc = isq ? c2 : 1.0f;
            f32x4 gv[2][2];
#pragma unroll
            for (int bj = 0; bj < 2; ++bj)
#pragma unroll
                for (int n = 0; n < 2; ++n) gv[bj][n] = *(const f32x4*)(gvec + 32 * bj + 8 * fq + 4 * n) * sc;
#pragma unroll
            for (int ai = 0; ai < 2; ++ai) {
                f32x4 cs[4][2][2];
#pragma unroll
                for (int m = 0; m < 4; ++m)
#pragma unroll
                    for (int n = 0; n < 2; ++n) { cs[m][n][0] = (f32x4){1.f, 0.f, 1.f, 0.f}; cs[m][n][1] = (f32x4){1.f, 0.f, 1.f, 0.f}; }
                if (fq < 2) {
#pragma unroll
                    for (int m = 0; m < 4; ++m) { const int pos = (row0 + ai * HALF + m * 16) & 4095;
#pragma unroll
                        for (int n = 0; n < 2; ++n) { cs[m][n][0] = *(const f32x4*)(rope + (size_t)pos * 16 + n * 8); cs[m][n][1] = *(const f32x4*)(rope + (size_t)pos * 16 + n * 8 + 4); } }
                }
#pragma unroll
                for (int m = 0; m < 4; ++m) {
                    const int row = row0 + ai * HALF + m * 16;
                    float ss = 0.f;
#pragma unroll
                    for (int bj = 0; bj < 2; ++bj)
#pragma unroll
                        for (int n = 0; n < 2; ++n) { const f32x4 x = acc[ai][bj][m][n]; ss += (x[0] * x[0] + x[1] * x[1]) + (x[2] * x[2] + x[3] * x[3]); }
                    ss += __shfl_xor(ss, 16); ss += __shfl_xor(ss, 32);
                    const float rinv = 1.0f / sqrtf(ss * (1.0f / 64.0f) + 1e-6f);
                    f32x4 v[2][2];
#pragma unroll
                    for (int bj = 0; bj < 2; ++bj)
#pragma unroll
                        for (int n = 0; n < 2; ++n) v[bj][n] = acc[ai][bj][m][n] * rinv * gv[bj][n];
                    const float sg = (fq == 0) ? -1.0f : 1.0f;
#pragma unroll
                    for (int n = 0; n < 2; ++n) {
                        const f32x4 x = v[0][n]; f32x4 pr;
#pragma unroll
                        for (int e = 0; e < 4; ++e) pr[e] = __shfl_xor(x[e], 16);
                        const f32x4 cs0 = cs[m][n][0], cs1 = cs[m][n][1];
                        f32x4 o;
                        o[0] = x[0] * cs0[0] + sg * pr[0] * cs0[1]; o[1] = x[1] * cs0[2] + sg * pr[1] * cs0[3];
                        o[2] = x[2] * cs1[0] + sg * pr[2] * cs1[1]; o[3] = x[3] * cs1[2] + sg * pr[3] * cs1[3];
                        v[0][n] = o;
                    }
#pragma unroll
                    for (int bj = 0; bj < 2; ++bj) {
                        u32x4 w; w.x = cvt_pk_bf16(v[bj][0][0], v[bj][0][1]); w.y = cvt_pk_bf16(v[bj][0][2], v[bj][0][3]); w.z = cvt_pk_bf16(v[bj][1][0], v[bj][1][1]); w.w = cvt_pk_bf16(v[bj][1][2], v[bj][1][3]);
                        *(u32x4*)(dst + (size_t)row * 512 + 32 * bj) = w;
                    }
                }
                asm volatile("" ::: "memory");
            }
        } else {
            bf16_t* dst; int ld; const int lc = 64 * wc + 8 * fq;
            if (pn < 6) { dst = V + (pn - 4) * 256 + lc; ld = 512; }
            else if (pn < 10) { dst = MLQK + (pn - 6) * 256 + lc; ld = 1024; }
            else if (pn < 12) { dst = MLV + (pn - 10) * 256 + lc; ld = 512; }
            else { dst = MLO + (pn - 12) * 256 + lc; ld = 512; }
#pragma unroll
            for (int ai = 0; ai < 2; ++ai)
#pragma unroll
                for (int m = 0; m < 4; ++m) {
                    bf16_t* p = dst + (size_t)(row0 + ai * HALF + m * 16) * ld;
#pragma unroll
                    for (int bj = 0; bj < 2; ++bj) {
                        const f32x4 a = acc[ai][bj][m][0], b = acc[ai][bj][m][1];
                        u32x4 w; w.x = cvt_pk_bf16(a[0], a[1]); w.y = cvt_pk_bf16(a[2], a[3]); w.z = cvt_pk_bf16(b[0], b[1]); w.w = cvt_pk_bf16(b[2], b[3]);
                        *(u32x4*)(p + 32 * bj) = w;
                    }
                }
        }
    }
};
template <class Epi, class Sched, bool ALIGN_EPI = false, bool SP2 = false>
__device__ __forceinline__ void gemm_phase(PG8_LAS unsigned char* lds, const Gemm g, const Sched& S, const Epi& E) {
    const int tid = __tid_l(), wid = __builtin_amdgcn_readfirstlane(tid >> 6), lane = tid & 63, wr = wid >> 2, wc = wid & 3, fr = lane & 15, fq = lane >> 4;
    const int K = g.K, nt = K / BK;
    unsigned voffA[2], voffB[2];
#pragma unroll
    for (int i = 0; i < 2; ++i) { int R, C; stage_rc(tid * 16 + i * 8192, R, C); const int Rb = Epi::PERM ? ((R & ~31) + perm32(R & 31)) : R;
        voffA[i] = (unsigned)(R * K + C) * 2u; voffB[i] = (unsigned)(Rb * K + C) * 2u; }
    const size_t kstep = (size_t)(BK * 2);
    const size_t hstep = (size_t)HALF * K * 2;
    const size_t tstep = 2 * hstep;
    const unsigned ldsw = (unsigned)wid * 1024u;
    const int aoff = lds_byte(wr * 64 + fr, fq * 8), boff = lds_byte(wc * 32 + fr, fq * 8);
#define PG8_SA(b, h) (((b) * 2 + (h)) * HTB)
#define PG8_SB(b, h) ((4 + (b) * 2 + (h)) * HTB)
#define PG8_STAGE(bufoff, gbase, voff) do { _Pragma("unroll") for (int _i = 0; _i < 2; ++_i) \
        __builtin_amdgcn_global_load_lds((const unsigned*)((const char*)(gbase) + (voff)[_i]), (PG8_LAS unsigned*)(lds + (bufoff) + ldsw + _i * 8192), 16, 0, 0); } while (0)
#define PG8_LDA(dst, b, h) do { _Pragma("unroll") for (int m = 0; m < 4; ++m) _Pragma("unroll") for (int k = 0; k < 2; ++k) dst[m][k] = *(const PG8_LAS bf16x8*)(lds + PG8_SA(b, h) + aoff + m * 2048 + k * 1024); } while (0)
#define PG8_LDB(dst, b, h) do { _Pragma("unroll") for (int n = 0; n < 2; ++n) _Pragma("unroll") for (int k = 0; k < 2; ++k) dst[n][k] = *(const PG8_LAS bf16x8*)(lds + PG8_SB(b, h) + boff + n * 2048 + k * 1024); } while (0)
#define PG8_MMA(ai, bj, At, Bt) do { __builtin_amdgcn_s_setprio(1); _Pragma("unroll") for (int m = 0; m < 4; ++m) _Pragma("unroll") for (int n = 0; n < 2; ++n) _Pragma("unroll") for (int k = 0; k < 2; ++k) \
        acc[ai][bj][m][n] = __builtin_amdgcn_mfma_f32_16x16x32_bf16(Bt[n][k], At[m][k], acc[ai][bj][m][n], 0, 0, 0); __builtin_amdgcn_s_setprio(0); } while (0)
#define PG8_WAIT_V(n) asm volatile("s_waitcnt vmcnt(" #n ")" ::: "memory")
#define PG8_WAIT_L(n) asm volatile("s_waitcnt lgkmcnt(" #n ")" ::: "memory")
#define PG8_BAR __builtin_amdgcn_s_barrier()
#define PG8_SCHED __builtin_amdgcn_sched_barrier(0)
    Unit cur, nxt; int ui = 0;
    if (!S.next(0, cur)) return;
    f32x4 acc[2][2][4][2];
#pragma unroll
    for (int a = 0; a < 2; ++a)
#pragma unroll
        for (int b = 0; b < 2; ++b)
#pragma unroll
            for (int m = 0; m < 4; ++m)
#pragma unroll
                for (int n = 0; n < 2; ++n) acc[a][b][m][n] = (f32x4){0.f, 0.f, 0.f, 0.f};
    bf16x8 At[4][2], B0[2][2], B1[2][2];
    const char* cA = (const char*)g.A + (size_t)cur.pm * tstep; const char* cB = (const char*)g.Bt + (size_t)cur.pn * tstep;
    S.a_ready(cur);
    if constexpr (SP2) {
        PG8_STAGE(PG8_SB(0, 0), cB, voffB); PG8_STAGE(PG8_SB(0, 1), cB + hstep, voffB); PG8_STAGE(PG8_SA(0, 0), cA, voffA); PG8_STAGE(PG8_SA(0, 1), cA + hstep, voffA);
        if (wr == 1) PG8_BAR;
        PG8_WAIT_V(2); PG8_BAR;
        PG8_STAGE(PG8_SB(1, 0), cB + kstep, voffB); PG8_STAGE(PG8_SA(1, 0), cA + kstep, voffA); PG8_STAGE(PG8_SB(1, 1), cB + hstep + kstep, voffB);
        PG8_WAIT_V(6); PG8_BAR;
    } else {
        PG8_STAGE(PG8_SB(0, 0), cB, voffB); PG8_STAGE(PG8_SA(0, 0), cA, voffA); PG8_STAGE(PG8_SB(0, 1), cB + hstep, voffB); PG8_STAGE(PG8_SA(0, 1), cA + hstep, voffA);
        if (wr == 1) PG8_BAR;
        PG8_WAIT_V(4); PG8_BAR;
        PG8_STAGE(PG8_SB(1, 0), cB + kstep, voffB); PG8_STAGE(PG8_SA(1, 0), cA + kstep, voffA); PG8_STAGE(PG8_SB(1, 1), cB + hstep + kstep, voffB);
        PG8_WAIT_V(6); PG8_BAR;
    }
    for (;;) {
        const bool has_next = S.next(ui + 1, nxt);
        const char* nA = has_next ? (const char*)g.A + (size_t)nxt.pm * tstep : cA; const char* nB = has_next ? (const char*)g.Bt + (size_t)nxt.pn * tstep : cB;
        for (int t = 0; t < nt; t += 2) {
            const bool last = (t == nt - 2);
            const char* a1 = cA + (size_t)(t + 1) * kstep;
            const char* a2 = last ? nA : cA + (size_t)(t + 2) * kstep; const char* b2 = last ? nB : cB + (size_t)(t + 2) * kstep;
            const char* a3 = a2 + kstep; const char* b3 = b2 + kstep;
            if (last && has_next) S.a_ready(nxt);
            if constexpr (SP2) {
            PG8_LDB(B0, 0, 0); PG8_LDB(B1, 0, 1); PG8_SCHED; PG8_LDA(At, 0, 0); PG8_STAGE(PG8_SA(1, 1), a1 + hstep, voffA);
            PG8_WAIT_V(8); PG8_WAIT_L(0); PG8_BAR; PG8_MMA(0, 0, At, B0); PG8_MMA(0, 1, At, B1); PG8_BAR; PG8_SCHED;
            PG8_LDA(At, 0, 1); PG8_STAGE(PG8_SB(0, 0), b2, voffB); PG8_STAGE(PG8_SB(0, 1), b2 + hstep, voffB); PG8_STAGE(PG8_SA(0, 0), a2, voffA);
            PG8_WAIT_V(8); PG8_WAIT_L(0); PG8_BAR; PG8_MMA(1, 0, At, B0); PG8_MMA(1, 1, At, B1); PG8_BAR; PG8_SCHED;
            PG8_LDB(B0, 1, 0); PG8_LDB(B1, 1, 1); PG8_SCHED; PG8_LDA(At, 1, 0); PG8_STAGE(PG8_SA(0, 1), a2 + hstep, voffA);
            PG8_WAIT_V(8); PG8_WAIT_L(0); PG8_BAR; PG8_MMA(0, 0, At, B0); PG8_MMA(0, 1, At, B1); PG8_BAR; PG8_SCHED;
            PG8_LDA(At, 1, 1); PG8_STAGE(PG8_SB(1, 0), b3, voffB); PG8_STAGE(PG8_SB(1, 1), b3 + hstep, voffB); PG8_STAGE(PG8_SA(1, 0), a3, voffA);
            PG8_WAIT_V(8); PG8_WAIT_L(0); PG8_BAR; PG8_MMA(1, 0, At, B0); PG8_MMA(1, 1, At, B1); PG8_BAR; PG8_SCHED;
            } else {
            PG8_LDB(B0, 0, 0); PG8_SCHED; PG8_LDA(At, 0, 0); PG8_STAGE(PG8_SA(1, 1), a1 + hstep, voffA);
            PG8_WAIT_L(8); PG8_BAR; PG8_WAIT_L(0); PG8_MMA(0, 0, At, B0); PG8_BAR; PG8_SCHED;
            PG8_LDB(B1, 0, 1); PG8_STAGE(PG8_SB(0, 0), b2, voffB);
            PG8_BAR; PG8_WAIT_L(0); PG8_MMA(0, 1, At, B1); PG8_BAR;
            PG8_LDA(At, 0, 1); PG8_STAGE(PG8_SA(0, 0), a2, voffA);
            PG8_BAR; PG8_WAIT_L(0); PG8_MMA(1, 0, At, B0); PG8_BAR; PG8_SCHED;
            PG8_STAGE(PG8_SB(0, 1), b2 + hstep, voffB);
            PG8_WAIT_V(6); PG8_BAR; PG8_MMA(1, 1, At, B1); PG8_BAR;
            PG8_LDB(B0, 1, 0); PG8_SCHED; PG8_LDA(At, 1, 0); PG8_STAGE(PG8_SA(0, 1), a2 + hstep, voffA);
            PG8_WAIT_L(8); PG8_BAR; PG8_WAIT_L(0); PG8_MMA(0, 0, At, B0); PG8_BAR; PG8_SCHED;
            PG8_LDB(B1, 1, 1); PG8_STAGE(PG8_SB(1, 0), b3, voffB);
            PG8_BAR; PG8_WAIT_L(0); PG8_MMA(0, 1, At, B1); PG8_BAR;
            PG8_LDA(At, 1, 1); PG8_STAGE(PG8_SA(1, 0), a3, voffA);
            PG8_BAR; PG8_WAIT_L(0); PG8_MMA(1, 0, At, B0); PG8_BAR; PG8_SCHED;
            PG8_STAGE(PG8_SB(1, 1), b3 + hstep, voffB);
            PG8_WAIT_V(6); PG8_BAR; PG8_MMA(1, 1, At, B1); PG8_BAR;
            }
        }
        if constexpr (ALIGN_EPI) { if (wr == 0) PG8_BAR; }
        if constexpr (!Epi::AFTER_DRAIN) { E(acc, cur, wr, wc, fr, fq); S.done(cur); }
        if (!has_next) break;
#pragma unroll
        for (int a = 0; a < 2; ++a)
#pragma unroll
            for (int b = 0; b < 2; ++b)
#pragma unroll
                for (int m = 0; m < 4; ++m)
#pragma unroll
                    for (int n = 0; n < 2; ++n) acc[a][b][m][n] = (f32x4){0.f, 0.f, 0.f, 0.f};
        cur = nxt; cA = nA; cB = nB; ++ui;
        if constexpr (ALIGN_EPI) { if (wr == 1) PG8_BAR; }
    }
    PG8_WAIT_V(0);
    if constexpr (!ALIGN_EPI) { if (wr == 0) PG8_BAR; }
    PG8_BAR;
    if constexpr (Epi::AFTER_DRAIN) { E.fused(acc, cur, wr, wc, fr, fq, lds, wid, lane); S.done(cur); }
#undef PG8_SA
#undef PG8_SB
#undef PG8_STAGE
#undef PG8_LDA
#undef PG8_LDB
#undef PG8_MMA
#undef PG8_WAIT_V
#undef PG8_WAIT_L
#undef PG8_BAR
#undef PG8_SCHED
}
}
#include <hip/hip_bf16.h>
#include <cmath>
namespace attn_body {
using bf16=__hip_bfloat16;
using bf16x8=__attribute__((ext_vector_type(8)))short;
using s16x4=__attribute__((ext_vector_type(4)))short;
using f32x16=__attribute__((ext_vector_type(16)))float;
using u32x4=__attribute__((ext_vector_type(4)))unsigned;
constexpr int BATCH=8,NHEAD=16,SEQ=4096,D=64,DM=NHEAD*D,QP=512,KP=512,VP=512,OP=1024;
constexpr int NW=8,QBLK=32,QB=QBLK*NW,KVBLK=64,NQB=SEQ/QB;
constexpr int ATTN_PITCH=DM, ATTN_UNIT_ROWS=QB;
__device__ __forceinline__ int crow(int r,int hi){return (r&3)+8*(r>>2)+4*hi;}
#define SBAR() __builtin_amdgcn_sched_barrier(0)
__device__ __forceinline__ void cmask(f32x16&p0,f32x16&p1,int jb,int qrel,int hi){
  const float NEG=-INFINITY; int kb=64*jb+4*hi;
  #pragma unroll
  for(int r=0;r<16;++r){int kv=kb+(r&3)+8*(r>>2); if(kv>qrel)p0[r]=NEG; if(kv+32>qrel)p1[r]=NEG;}
}

constexpr int NSLOT=3, SLOTB=8192;
constexpr int LDS_K=0, LDS_V=NSLOT*SLOTB, LDS_WS=2*NSLOT*SLOTB, LDS_OST=LDS_WS+NW*64*4, LDS_BYTES=LDS_OST+NW*4096;
constexpr float C2=0.125f*1.4426950408889634f;
__device__ __forceinline__ void glds16(const void*gsrc,unsigned lds_dst){unsigned keep;
  asm volatile("s_mov_b32 %0, m0\n\ts_mov_b32 m0, %2\n\ts_nop 0\n\tglobal_load_lds_dwordx4 %1, off\n\ts_mov_b32 m0, %0":"=&s"(keep):"v"(gsrc),"s"(lds_dst):"memory");}
__device__ __forceinline__ float max3f(float a,float b,float c){float r;asm("v_max3_f32 %0, %1, %2, %3":"=v"(r):"v"(a),"v"(b),"v"(c));return r;}
__device__ __forceinline__ float max2f(float a,float b){float r;asm("v_max_f32_e32 %0, %1, %2":"=v"(r):"v"(a),"v"(b));return r;}
__device__ __forceinline__ float fadd_s(float a,float b){float r;asm("v_add_f32_e32 %0, %1, %2":"=v"(r):"v"(a),"v"(b));return r;}
__device__ __forceinline__ float fsub_s(float a,float b){float r;asm("v_sub_f32_e32 %0, %1, %2":"=v"(r):"v"(a),"v"(b));return r;}
typedef float f32x2_t __attribute__((ext_vector_type(2))); typedef __bf16 bf16x2_t __attribute__((ext_vector_type(2)));
__device__ __forceinline__ unsigned cvtpk_s(float lo,float hi){f32x2_t v={lo,hi};bf16x2_t b=__builtin_convertvector(v,bf16x2_t);return __builtin_bit_cast(unsigned,b);}
#define WAIT_BAR(N) asm volatile("s_waitcnt vmcnt(" #N ") lgkmcnt(0)\n\ts_barrier":::"memory")

__device__ __forceinline__ void qkt(f32x16&p0,f32x16&p1,const char*Kslot,const bf16x8*qr,const f32x16&negm,int r32,int hi){
  const char*kb=Kslot+hi*1024+r32*16;
  #pragma unroll
  for(int d0=0;d0<4;++d0){
    const bf16x8 b0=*reinterpret_cast<const bf16x8*>(kb+d0*2048);
    const bf16x8 b1=*reinterpret_cast<const bf16x8*>(kb+d0*2048+512);
    if(d0==0){p0=__builtin_amdgcn_mfma_f32_32x32x16_bf16(b0,qr[0],negm,0,0,0);p1=__builtin_amdgcn_mfma_f32_32x32x16_bf16(b1,qr[0],negm,0,0,0);}
    else{p0=__builtin_amdgcn_mfma_f32_32x32x16_bf16(b0,qr[d0],p0,0,0,0);p1=__builtin_amdgcn_mfma_f32_32x32x16_bf16(b1,qr[d0],p1,0,0,0);}}
}
typedef __attribute__((address_space(3))) const char* lds_cptr;
typedef short v4i16_t __attribute__((ext_vector_type(4)));
__device__ __forceinline__ void kload8(bf16x8*kf,lds_cptr kp){
  kf[0]=*(const __attribute__((address_space(3))) bf16x8*)(kp);      kf[1]=*(const __attribute__((address_space(3))) bf16x8*)(kp+512);
  kf[2]=*(const __attribute__((address_space(3))) bf16x8*)(kp+2048); kf[3]=*(const __attribute__((address_space(3))) bf16x8*)(kp+2560);
  kf[4]=*(const __attribute__((address_space(3))) bf16x8*)(kp+4096); kf[5]=*(const __attribute__((address_space(3))) bf16x8*)(kp+4608);
  kf[6]=*(const __attribute__((address_space(3))) bf16x8*)(kp+6144); kf[7]=*(const __attribute__((address_space(3))) bf16x8*)(kp+6656);
}
__device__ __forceinline__ void kload2(bf16x8*kf,lds_cptr kp,int j){ kf[2*j]=*(const __attribute__((address_space(3))) bf16x8*)(kp+j*2048); kf[2*j+1]=*(const __attribute__((address_space(3))) bf16x8*)(kp+j*2048+512); }
__device__ __forceinline__ s16x4 vtr(lds_cptr p){ return __builtin_bit_cast(s16x4,__builtin_amdgcn_ds_read_tr16_b64_v4i16((__attribute__((address_space(3))) v4i16_t*)p)); }
__device__ __forceinline__ float rowmax(const f32x16&p0,const f32x16&p1){
  float a=max3f(p0[0],p0[1],p1[0]),b=max3f(p0[2],p0[3],p1[1]);a=max3f(a,p1[2],p1[3]);
  #pragma unroll
  for(int r=4;r<16;r+=4){a=max3f(a,p0[r],p0[r+1]);b=max3f(b,p0[r+2],p0[r+3]);a=max3f(a,p1[r],p1[r+1]);b=max3f(b,p1[r+2],p1[r+3]);}
  const float m=max2f(a,b);
  auto rr=__builtin_amdgcn_permlane32_swap(__float_as_uint(m),__float_as_uint(m),false,false);
  return max2f(__uint_as_float(rr[0]),__uint_as_float(rr[1]));
}
__device__ __forceinline__ void pv(f32x16*o,int vb,bf16x8 pa0,bf16x8 pa1,bf16x8 pa2,bf16x8 pa3){
  #pragma unroll
  for(int d0=0;d0<2;++d0){s16x4 lo[4],hi[4];
    #pragma unroll
    for(int ks=0;ks<4;++ks){
      asm volatile("ds_read_b64_tr_b16 %0,%1 offset:%c2":"=&v"(lo[ks]):"v"(vb),"i"(d0*4096+ks*1024):"memory");
      asm volatile("ds_read_b64_tr_b16 %0,%1 offset:%c2":"=&v"(hi[ks]):"v"(vb),"i"(d0*4096+ks*1024+512):"memory");}
    asm volatile("s_waitcnt lgkmcnt(0)":::"memory");SBAR();
    #define PK(k) (bf16x8){lo[k][0],lo[k][1],lo[k][2],lo[k][3],hi[k][0],hi[k][1],hi[k][2],hi[k][3]}
    o[d0]=__builtin_amdgcn_mfma_f32_32x32x16_bf16(pa0,PK(0),o[d0],0,0,0);
    o[d0]=__builtin_amdgcn_mfma_f32_32x32x16_bf16(pa1,PK(1),o[d0],0,0,0);
    o[d0]=__builtin_amdgcn_mfma_f32_32x32x16_bf16(pa2,PK(2),o[d0],0,0,0);
    o[d0]=__builtin_amdgcn_mfma_f32_32x32x16_bf16(pa3,PK(3),o[d0],0,0,0);
    #undef PK
  }
}

#ifndef ATTN_STORE16
#define ATTN_STORE16(p,v) (*(u32x4*)(p)=(v))
#endif
template<int THRL> __device__ __forceinline__ void attn_unit(int b,int qcol,int vcol,int ocol,int qb,const bf16*Q,const bf16*__restrict__ K,const bf16*__restrict__ V,bf16*O,char*shm){
  const int tid=__tid_l(),lane=tid&63,r32=lane&31,hi=lane>>5; const int wid=__builtin_amdgcn_readfirstlane(tid>>6);
  const long rowbase=(long)b*SEQ; const int q0=qb*QB;
  const bf16*Qw=Q+(rowbase+q0+wid*QBLK)*QP+qcol;
  const bf16*Kh=K+rowbase*KP+qcol,*Vh=V+rowbase*VP+vcol;
  const unsigned lds0=(unsigned)(uintptr_t)shm;
  float*wsf=(float*)(shm+LDS_WS)+wid*64;
  const bf16*ksrc=Kh+(long)lane*KP+wid*8;
  const bf16*vsrc=Vh+(long)(16*(wid&3)+(lane>>2))*VP+(wid>>2)*32+(lane&3)*8;
  const unsigned kdst=lds0+LDS_K+wid*1024, vdst=lds0+LDS_V+wid*1024;
  #define DMA_K(t,slot) glds16(ksrc+(long)(t)*KVBLK*KP,(unsigned)__builtin_amdgcn_readfirstlane(kdst+(slot)))
  #define DMA_V(t,slot) glds16(vsrc+(long)(t)*KVBLK*VP,(unsigned)__builtin_amdgcn_readfirstlane(vdst+(slot)))
  const int vb0=(int)(lds0+LDS_V)+((lane>>4)&1)*32+(lane&3)*8+(4*hi+((lane&15)>>2))*64;
  const char*Kbase=shm+LDS_K; bf16x8 kf[8];
  const lds_cptr shm3=(lds_cptr)shm; const lds_cptr kp0=shm3+LDS_K+hi*1024+r32*16; const lds_cptr vp0=shm3+LDS_V+((lane>>4)&1)*32+(lane&3)*8+(4*hi+((lane&15)>>2))*64;
  const int NT=(q0+QB)/KVBLK;
  DMA_K(0,0);DMA_V(0,0);DMA_K(1,SLOTB);
  bf16x8 qr[4];
  #pragma unroll
  for(int d0=0;d0<4;++d0)qr[d0]=*reinterpret_cast<const bf16x8*>(&Qw[(long)r32*QP+d0*16+hi*8]);
  float mhat=0.f,l_reg=0.f;f32x16 o[2];o[0]=f32x16{};o[1]=f32x16{};f32x16 negm=f32x16{};asm volatile("":"+v"(negm));
  const int qrel=wid*QBLK+r32;
  #define CMASK(P0,P1,t) do{int jb_=(t)-(NT-4); if(jb_>=0)cmask(P0,P1,jb_,qrel,hi);}while(0)
  bool resc=false;
  #define START(P0,P1) do{ const float rm=rowmax(P0,P1); resc=false; \
    { const float dl=rm; mhat=fadd_s(mhat,dl); \
      _Pragma("unroll") for(int r=0;r<16;++r){P0[r]=fsub_s(P0[r],dl);P1[r]=fsub_s(P1[r],dl);} \
      _Pragma("unroll") for(int r=0;r<16;++r)negm[r]=-mhat; asm volatile("":"+v"(negm)); } \
    _Pragma("unroll") for(int r=0;r<16;++r)P0[r]=__builtin_amdgcn_exp2f(P0[r]); }while(0)
  #define RESC() do{ if(resc){ asm volatile("s_waitcnt lgkmcnt(0)":::"memory"); \
      _Pragma("unroll") for(int d_=0;d_<2;++d_) _Pragma("unroll") for(int r=0;r<16;++r)o[d_][r]*=wsf[crow(r,hi)]; } }while(0)
  f32x16 pA0,pA1,pB0,pB1;
  int sl_prev=0,sl_cur=0,sl_next=SLOTB;
  #define ROT() do{sl_prev=sl_cur;sl_cur=sl_next;sl_next=(sl_next==(NSLOT-1)*SLOTB)?0:sl_next+SLOTB;}while(0)
  DMA_K(2,2*SLOTB);
  WAIT_BAR(3);
  qkt(pA0,pA1,Kbase,qr,negm,r32,hi);asm volatile("s_nop 15\n\ts_nop 7":"+v"(pA0),"+v"(pA1));CMASK(pA0,pA1,0);
  START(pA0,pA1);
  _Pragma("unroll") for(int r=0;r<16;++r)pA1[r]=__builtin_amdgcn_exp2f(pA1[r]);
  WAIT_BAR(0);
  DMA_K(3,0);DMA_V(1,SLOTB);
  ROT();
  kload8(kf,kp0+sl_cur);
  WAIT_BAR(2);
  s16x4 vlo[8],vhi[8]; u32x4 pw0,pw1,pw2,pw3;
  #define PKW(P,B) cvtpk_s(P[B],P[B+1])
  #define PAF(k) __builtin_bit_cast(bf16x8,pw##k)
  #define VFR(i) (bf16x8){vlo[i][0],vlo[i][1],vlo[i][2],vlo[i][3],vhi[i][0],vhi[i][1],vhi[i][2],vhi[i][3]}
  #define PIN(x) asm volatile("":"+v"(x))
  #define MX3(a,b,c) __builtin_fmaxf(__builtin_fmaxf((a),(b)),(c))
  #define GAPA(MF,A0,A1,A2,A3,W0,W1,PW) do{ MF; sacc+=A0; sacc+=A1; sacc+=A2; sacc+=A3; PIN(sacc); W0; W1; PIN(PW); SBAR(); }while(0)
  #define EX(v) __builtin_amdgcn_exp2f(v)
  #define GAPB(MF,X,B) do{ MF; X[B]=EX(X[B]); X[B+1]=EX(X[B+1]); X[B+2]=EX(X[B+2]); X[B+3]=EX(X[B+3]); PIN(X); SBAR(); }while(0)
  #define VRD(i) do{ vlo[i]=vtr(vp_+(((i)>>2)*4096+((i)&3)*1024)); vhi[i]=vtr(vp_+(((i)>>2)*4096+((i)&3)*1024+512)); }while(0)
  #define KRD(G,j) do{ if(G){ kload2(kf,kp0+sl_next,j); SBAR(); } }while(0)
  #define STEP(C0,C1,P0,P1,t,GK,GV,GL) do{ SBAR(); \
    const lds_cptr vp_=vp0+sl_prev; \
    VRD(0); SBAR(); float sacc=(P0[0]+P0[1]); \
    GAPA(C0=__builtin_amdgcn_mfma_f32_32x32x16_bf16(kf[0],qr[0],negm,0,0,0), P0[2],P0[3],P0[4],P0[5],     pw0[0]=PKW(P0,0), pw0[1]=PKW(P0,2), pw0); \
    VRD(4); SBAR(); GAPA(C1=__builtin_amdgcn_mfma_f32_32x32x16_bf16(kf[1],qr[0],negm,0,0,0), P0[6],P0[7],P0[8],P0[9],     pw0[2]=PKW(P0,4), pw0[3]=PKW(P0,6), pw0); \
    VRD(1); SBAR(); GAPA(C0=__builtin_amdgcn_mfma_f32_32x32x16_bf16(kf[2],qr[1],C0,0,0,0),   P0[10],P0[11],P0[12],P0[13], pw1[0]=PKW(P0,8), pw1[1]=PKW(P0,10), pw1); \
    VRD(5); SBAR(); GAPA(C1=__builtin_amdgcn_mfma_f32_32x32x16_bf16(kf[3],qr[1],C1,0,0,0),   P0[14],P0[15],P1[0],P1[1],   pw1[2]=PKW(P0,12),pw1[3]=PKW(P0,14), pw1); \
    VRD(2); SBAR(); GAPA(C0=__builtin_amdgcn_mfma_f32_32x32x16_bf16(kf[4],qr[2],C0,0,0,0),   P1[2],P1[3],P1[4],P1[5],     pw2[0]=PKW(P1,0), pw2[1]=PKW(P1,2), pw2); \
    VRD(6); SBAR(); GAPA(C1=__builtin_amdgcn_mfma_f32_32x32x16_bf16(kf[5],qr[2],C1,0,0,0),   P1[6],P1[7],P1[8],P1[9],     pw2[2]=PKW(P1,4), pw2[3]=PKW(P1,6), pw2); \
    VRD(3); SBAR(); GAPA(C0=__builtin_amdgcn_mfma_f32_32x32x16_bf16(kf[6],qr[3],C0,0,0,0),   P1[10],P1[11],P1[12],P1[13], pw3[0]=PKW(P1,8), pw3[1]=PKW(P1,10), pw3); \
    VRD(7); SBAR(); GAPA(C1=__builtin_amdgcn_mfma_f32_32x32x16_bf16(kf[7],qr[3],C1,0,0,0),   P1[14],P1[15],0.f,0.f,       pw3[2]=PKW(P1,12),pw3[3]=PKW(P1,14), pw3); \
    l_reg+=sacc; \
    if(GK){DMA_K((t)+3,sl_cur);} if(GV){DMA_V((t)+1,sl_next);} \
    CMASK(C0,C1,t); \
    { float a=MX3(C0[0],C0[1],C1[0]),b=MX3(C0[2],C0[3],C1[1]); a=MX3(a,C1[2],C1[3]); \
      _Pragma("unroll") for(int r=4;r<16;r+=4){a=MX3(a,C0[r],C0[r+1]);b=MX3(b,C0[r+2],C0[r+3]);a=MX3(a,C1[r],C1[r+1]);b=MX3(b,C1[r+2],C1[r+3]);} \
      float rm=__builtin_fmaxf(a,b); { auto rr=__builtin_amdgcn_permlane32_swap(__float_as_uint(rm),__float_as_uint(rm),false,false); rm=__builtin_fmaxf(__uint_as_float(rr[0]),__uint_as_float(rr[1])); } \
      resc=false; \
      if(__builtin_expect(__any(rm>(float)THRL),0)){ const float dl=__builtin_fmaxf(rm,0.f); mhat+=dl; \
        _Pragma("unroll") for(int r=0;r<16;++r){C0[r]-=dl;C1[r]-=dl;} \
        _Pragma("unroll") for(int r=0;r<16;++r)negm[r]=-mhat; asm volatile("":"+v"(negm)); \
        const float f=__builtin_amdgcn_exp2f(-dl); l_reg*=f; if(hi==0)wsf[r32]=f; resc=true; } } \
    SBAR(); \
    GAPB(o[0]=__builtin_amdgcn_mfma_f32_32x32x16_bf16(PAF(0),VFR(0),o[0],0,0,0), C0,0); \
    GAPB(o[1]=__builtin_amdgcn_mfma_f32_32x32x16_bf16(PAF(0),VFR(4),o[1],0,0,0), C0,4); \
    KRD(GL,0); GAPB(o[0]=__builtin_amdgcn_mfma_f32_32x32x16_bf16(PAF(1),VFR(1),o[0],0,0,0), C0,8); \
    KRD(GL,1); GAPB(o[1]=__builtin_amdgcn_mfma_f32_32x32x16_bf16(PAF(1),VFR(5),o[1],0,0,0), C0,12); \
    KRD(GL,2); GAPB(o[0]=__builtin_amdgcn_mfma_f32_32x32x16_bf16(PAF(2),VFR(2),o[0],0,0,0), C1,0); \
    KRD(GL,3); GAPB(o[1]=__builtin_amdgcn_mfma_f32_32x32x16_bf16(PAF(2),VFR(6),o[1],0,0,0), C1,4); \
    GAPB(o[0]=__builtin_amdgcn_mfma_f32_32x32x16_bf16(PAF(3),VFR(3),o[0],0,0,0), C1,8); \
    GAPB(o[1]=__builtin_amdgcn_mfma_f32_32x32x16_bf16(PAF(3),VFR(7),o[1],0,0,0), C1,12); \
    }while(0)
  int t=1;
  #undef CMASK
  #define CMASK(P0,P1,t) do{}while(0)
  for(;t+5<NT;t+=2){
    STEP(pB0,pB1,pA0,pA1,t,true,true,true);     WAIT_BAR(2); RESC(); ROT();
    STEP(pA0,pA1,pB0,pB1,t+1,true,true,true);   WAIT_BAR(2); RESC(); ROT();
  }
  #undef CMASK
  #define CMASK(P0,P1,t) do{int jb_=(t)-(NT-4); if(jb_>=0)cmask(P0,P1,jb_,qrel,hi);}while(0)
  #define ENDW(tt) do{ if((tt)+3<NT){WAIT_BAR(2);} else if((tt)+2<NT){WAIT_BAR(1);} else {WAIT_BAR(0);} }while(0)
  for(;t+1<NT;t+=2){
    STEP(pB0,pB1,pA0,pA1,t,(t+3<NT),(t+1<NT),(t+1<NT));       ENDW(t);   RESC(); ROT();
    STEP(pA0,pA1,pB0,pB1,t+1,(t+4<NT),(t+2<NT),(t+2<NT));     ENDW(t+1); RESC(); ROT();
  }
  STEP(pB0,pB1,pA0,pA1,NT-1,false,false,false); RESC();
  { float sacc=pB0[0]+pB0[1]; _Pragma("unroll") for(int r=2;r<16;++r)sacc+=pB0[r]; _Pragma("unroll") for(int r=0;r<16;++r)sacc+=pB1[r]; l_reg+=sacc;
    pw0=(u32x4){PKW(pB0,0),PKW(pB0,2),PKW(pB0,4),PKW(pB0,6)};pw1=(u32x4){PKW(pB0,8),PKW(pB0,10),PKW(pB0,12),PKW(pB0,14)};pw2=(u32x4){PKW(pB1,0),PKW(pB1,2),PKW(pB1,4),PKW(pB1,6)};pw3=(u32x4){PKW(pB1,8),PKW(pB1,10),PKW(pB1,12),PKW(pB1,14)};
    SBAR(); pv(o,vb0+sl_cur,PAF(0),PAF(1),PAF(2),PAF(3)); }
  #undef PKW
  #undef PAF
  #undef VFR
  #undef PIN
  #undef MX3
  #undef GAPA
  #undef GAPB
  #undef EX
  #undef VRD
  #undef KRD
  #undef STEP
  #undef ENDW
  {auto rr=__builtin_amdgcn_permlane32_swap(__float_as_uint(l_reg),__float_as_uint(l_reg),false,false);l_reg=__uint_as_float(rr[0])+__uint_as_float(rr[1]);}
  if(hi==0)wsf[32+r32]=l_reg;asm volatile("s_waitcnt lgkmcnt(0)":::"memory");
  float rli[16];
  #pragma unroll
  for(int r=0;r<16;++r)rli[r]=__builtin_amdgcn_rcpf(wsf[32+crow(r,hi)]);
  bf16*Ow=O+(rowbase+q0+wid*QBLK)*OP+ocol;
  { bf16*stg=(bf16*)(shm+LDS_OST)+wid*2048;
    #pragma unroll
    for(int r=0;r<16;++r){const int orow=crow(r,hi);
      #pragma unroll
      for(int d0=0;d0<2;++d0)stg[orow*64+d0*32+r32]=__float2bfloat16(o[d0][r]*rli[r]);}
    asm volatile("s_waitcnt lgkmcnt(0)":::"memory");
    #pragma unroll
    for(int i=0;i<4;++i){const int row=i*8+(lane>>3),ch=lane&7; const u32x4 v=*(const u32x4*)(stg+row*64+ch*8); ATTN_STORE16(Ow+(long)row*OP+ch*8,v);} }
  asm volatile("s_waitcnt lgkmcnt(0)\n\ts_barrier":::"memory");
  #undef DMA_K
  #undef DMA_V
  #undef CMASK
  #undef START
  #undef RESC
  #undef ROT
}
#undef SBAR
#undef WAIT_BAR
}
namespace cg = cooperative_groups;
#define LAS __attribute__((address_space(3)))
typedef unsigned short bf16;
typedef unsigned v4u __attribute__((ext_vector_type(4)));
typedef unsigned v2u __attribute__((ext_vector_type(2)));
typedef float f32x4 __attribute__((ext_vector_type(4)));
typedef float f32x16 __attribute__((ext_vector_type(16)));
typedef short bf16x8 __attribute__((ext_vector_type(8)));

constexpr int NB = 8, SEQ = 4096, DM = 1024, TOK = NB * SEQ, FF = 2816, NIN = 3592, NINP = 3584, NMOD = 9216;
constexpr size_t MiB = 1u << 20;
constexpr size_t WS_CTL = 0, WS_MOD = 64 * 1024, WS_ROPE = 512 * 1024, WS_GATES = 1 * MiB;
constexpr size_t WS_W12A = 2 * MiB, WS_W3A = 13 * MiB, WS_W12B = 19 * MiB, WS_W3B = 30 * MiB, WS_WIN = 36 * MiB, WS_WOUT = 43 * MiB;
constexpr size_t WS_HN = 48 * MiB, WS_HID = 112 * MiB;
constexpr size_t WS_Q = WS_HID, WS_K = WS_HID + 32 * MiB, WS_V = WS_HID + 64 * MiB, WS_MLQK = WS_HID + 96 * MiB;
constexpr size_t WS_MLV = 288 * MiB, WS_MLO = 320 * MiB, WS_AO = 352 * MiB, WS_MLH = 416 * MiB, WS_IMGB = 448 * MiB, WS_END = 512 * MiB;
constexpr size_t WS_RSS = 47 * MiB, WS_SB3 = 47 * MiB + 256 * 1024, WS_XG3 = WS_AO;
constexpr size_t WS_BP = 45 * MiB, WS_RK = 46 * MiB, WS_IMGA = WS_HN;
constexpr int LDS_BYTES = 147456, MISC_OFF = 131072 + 320;
constexpr float C2Q = 0.125f * 1.4426950408889634f;

__device__ __forceinline__ unsigned f2bf(float f) { unsigned u = __builtin_bit_cast(unsigned, f); return (u + 0x7fffu + ((u >> 16) & 1u)) >> 16; }
__device__ __forceinline__ unsigned pk2(float lo, float hi) { return pg8::cvt_pk_bf16(lo, hi); }
__device__ __forceinline__ float bflo(unsigned u) { return __builtin_bit_cast(float, u << 16); }
__device__ __forceinline__ float bfhi(unsigned u) { return __builtin_bit_cast(float, u & 0xffff0000u); }
__device__ __forceinline__ float wave_sum(float v) {
#pragma unroll
    for (int o = 1; o < 64; o <<= 1) v += __shfl_xor(v, o);
    return v;
}
#define LDS_WAIT() asm volatile("s_waitcnt lgkmcnt(0)" ::: "memory")

#define XB_TMO      128
#define XB_XCNT(j)  (256  + 64 * (j))
#define XB_XSUB(j)  (1280 + 64 * (j))
#define XB_XGEN(j)  (2304 + 64 * (j))
#define XB_TOP      3328
#define XB_TOPGEN   3392
#define XCD_BAR_WORDS 3456
#define XB_SPIN_CAP (1u << 18)

__device__ __forceinline__ unsigned xb_ld(unsigned* p)              { return __hip_atomic_load(p, __ATOMIC_RELAXED, __HIP_MEMORY_SCOPE_AGENT); }
__device__ __forceinline__ unsigned xb_add(unsigned* p, unsigned v) { return __hip_atomic_fetch_add(p, v, __ATOMIC_RELAXED, __HIP_MEMORY_SCOPE_AGENT); }
__device__ __forceinline__ unsigned xb_xcc_id() { return (unsigned)__builtin_amdgcn_s_getreg((3 << 11) | 20) & 0xFu; }
#define XB_SPIN(cond, bar) do { unsigned _sp = 0; while (cond) { __builtin_amdgcn_s_sleep(1); \
    if ((++_sp & 255u) == 0u) { if (xb_ld(&(bar)[XB_TMO])) break; if (_sp > XB_SPIN_CAP) { atomicAdd(&(bar)[XB_TMO], 1u); break; } } } } while (0)

struct XcdBarrier {
    unsigned* bar; unsigned x;
    volatile LAS unsigned* st;
};

__device__ __forceinline__ XcdBarrier xcd_barrier_post(unsigned* bar, volatile LAS unsigned* st) {
    XcdBarrier b; b.bar = bar; b.x = xb_xcc_id(); b.st = st;
    if (threadIdx.x == 0) (void)xb_add(&bar[XB_XCNT(b.x)], 1u);
    return b;
}
__device__ __forceinline__ void xcd_barrier_complete(unsigned* bar, unsigned x, unsigned& nloc, unsigned& nx) {
    const unsigned G = gridDim.x * gridDim.y * gridDim.z;
    unsigned sum, cnt, mine, sp = 0u;
    for (;;) {
        sum = 0u; cnt = 0u; mine = 0u;
#pragma unroll
        for (unsigned j = 0; j < 16; ++j) { const unsigned c = xb_ld(&bar[XB_XCNT(j)]); sum += c; cnt += (c > 0u) ? 1u : 0u; mine = (j == x) ? c : mine; }
        if (sum == G) break;
        __builtin_amdgcn_s_sleep(1);
        if ((++sp & 255u) == 0u) { if (xb_ld(&bar[XB_TMO])) break; if (sp > XB_SPIN_CAP) { atomicAdd(&bar[XB_TMO], 1u); break; } }
    }
    nloc = mine > 0u ? mine : 1u; nx = cnt > 0u ? cnt : 1u;
}

__device__ __forceinline__ void xcd_barrier(const XcdBarrier& b) {
    asm volatile("s_waitcnt vmcnt(0)" ::: "memory");
    __syncthreads();
    if (threadIdx.x == 0) {
        unsigned* bar = b.bar;
        __builtin_amdgcn_s_waitcnt(0);
        unsigned nloc = b.st[0], nx = b.st[1];
        if (nloc == 0u) { xcd_barrier_complete(bar, b.x, nloc, nx); b.st[0] = nloc; b.st[1] = nx; }
        const unsigned old = xb_add(&bar[XB_XSUB(b.x)], 1u);
        const unsigned gen = old / nloc;
        if (old + 1u == (gen + 1u) * nloc) {
            __builtin_amdgcn_fence(__ATOMIC_RELEASE, "agent");
            asm volatile("s_waitcnt vmcnt(0)" ::: "memory");
            const unsigned og = xb_add(&bar[XB_TOP], 1u);
            const unsigned tg = og / nx;
            if (og + 1u == (tg + 1u) * nx) xb_add(&bar[XB_TOPGEN], 1u);
            else XB_SPIN(xb_ld(&bar[XB_TOPGEN]) == tg, bar);
            __builtin_amdgcn_fence(__ATOMIC_ACQUIRE, "agent");
            xb_add(&bar[XB_XGEN(b.x)], 1u);
            asm volatile("s_waitcnt vmcnt(0)" ::: "memory");
        } else {
            XB_SPIN(xb_ld(&bar[XB_XGEN(b.x)]) == gen, bar);
            __builtin_amdgcn_fence(__ATOMIC_ACQUIRE, "agent");
            asm volatile("s_waitcnt vmcnt(0)" ::: "memory");
        }
    }
    __syncthreads();
}


struct Args { const float* in[20]; float* out; unsigned char* ws; int ph_lo, ph_hi; };
enum { I_X = 0, I_C, I_WADA, I_BADA, I_GNORM, I_F1W12, I_F1W3, I_WIN, I_CONVW, I_CONVB, I_BIG, I_BFG, I_GQ, I_GK, I_LAMQK, I_GDA, I_GML, I_WOUT, I_F2W12, I_F2W3 };

__device__ __forceinline__ void transpose_item(const float* W, int K, int ldw, int nsrc0, bf16* WT, int ndst0, LAS float* scr, int k0, int lane) {
#pragma unroll 8
    for (int i = 0; i < 32; ++i) { const int kk = 2 * i + (lane >> 5); scr[kk * 33 + (lane & 31)] = W[(size_t)(k0 + kk) * ldw + nsrc0 + (lane & 31)]; }
    LDS_WAIT();
    const int c = lane & 7;
#pragma unroll
    for (int j = 0; j < 4; ++j) { const int n = (lane >> 3) + 8 * j; const LAS float* s = scr + (8 * c) * 33 + n;
        v4u o; o.x = pk2(s[0 * 33], s[1 * 33]); o.y = pk2(s[2 * 33], s[3 * 33]); o.z = pk2(s[4 * 33], s[5 * 33]); o.w = pk2(s[6 * 33], s[7 * 33]);
        *(v4u*)(WT + (size_t)(ndst0 + n) * K + k0 + 8 * c) = o; }
    LDS_WAIT();
}
__device__ __forceinline__ void p0_prologue(const Args& a, LAS unsigned char* lds) {
    const int tid = __tid_l(), lane = tid & 63, wave = __builtin_amdgcn_readfirstlane(tid >> 6), G = gridDim.x, bx = blockIdx.x;
    unsigned char* ws = a.ws;
    if (bx == 0 && tid < 64) ((unsigned*)(ws + WS_CTL))[tid * 64] = 0u;
    for (int i = bx * 512 + tid; i < TOK; i += G * 512) ((float*)(ws + WS_RSS))[i] = 0.f;
    {
        LAS float* sc = (LAS float*)lds;
        LAS float* red = (LAS float*)(lds + 32768);
        const float* c = a.in[I_C];
        for (int i = tid; i < 8192; i += 512) { const int b = i >> 10, k = i & 1023; const float v = c[i]; sc[k * 8 + b] = v / (1.0f + __expf(-v)); }
        __syncthreads();
        const float* wada = a.in[I_WADA]; const float* bada = a.in[I_BADA]; float* mod = (float*)(ws + WS_MOD);
        for (int jb = bx; jb < 256; jb += G) {
            const int j0 = jb * 36; float acc[8];
#pragma unroll
            for (int b = 0; b < 8; ++b) acc[b] = 0.f;
            if (lane < 36) {
                const float* wp = wada + (size_t)(wave * 128) * NMOD + j0 + lane;
#pragma unroll 32
                for (int k = 0; k < 128; ++k) {
                    const float wv = wp[(size_t)k * NMOD];
                    const f32x4 s0 = *(const LAS f32x4*)(sc + (wave * 128 + k) * 8), s1 = *(const LAS f32x4*)(sc + (wave * 128 + k) * 8 + 4);
                    acc[0] += wv * s0[0]; acc[1] += wv * s0[1]; acc[2] += wv * s0[2]; acc[3] += wv * s0[3];
                    acc[4] += wv * s1[0]; acc[5] += wv * s1[1]; acc[6] += wv * s1[2]; acc[7] += wv * s1[3];
                }
#pragma unroll
                for (int b = 0; b < 8; ++b) red[(wave * 8 + b) * 36 + lane] = acc[b];
            }
            __syncthreads();
            if (tid < 288) { const int b = tid / 36, j = tid % 36; float s = bada[j0 + j];
#pragma unroll
                for (int w = 0; w < 8; ++w) s += red[(w * 8 + b) * 36 + j];
                mod[(size_t)b * NMOD + j0 + j] = s; }
            __syncthreads();
        }
    }
    {
        float* rope = (float*)(ws + WS_ROPE);
        for (int e = bx * 512 + tid; e < SEQ * 8; e += G * 512) {
            const int pos = e >> 3, i = e & 7;
            const float invf = powf(500000.0f, -(float)i * 0.125f);
            const float ang = (float)pos * invf;
            const double k = rint((double)ang * 0.15915494309189535);
            const float r = (float)((double)ang - k * 6.283185307179586);
            rope[2 * e] = cosf(r); rope[2 * e + 1] = sinf(r);
        }
    }
    {
        LAS float* scr = (LAS float*)(lds + wave * 16384);
        const int gw = bx * 8 + wave, NGW = G * 8;
        constexpr int I_12 = 16 * 176, I_3 = 44 * 32, I_IN = 16 * 112, I_O = 16 * 32, NITEMS = 2 * I_12 + 2 * I_3 + I_IN + I_O;
        for (int it = gw; it < NITEMS; it += NGW) {
            int r = it;
            if (r < 2 * I_12) {
                const int which = r >= I_12; r -= which * I_12; const int kb = r / 176, nb = r % 176, n0 = nb * 32;
                const int src = ((n0 >> 7) & 1) * FF + (n0 >> 8) * 128 + (n0 & 127);
                transpose_item(a.in[which ? I_F2W12 : I_F1W12], 1024, 2 * FF, src, (bf16*)(ws + (which ? WS_W12B : WS_W12A)), n0, scr, kb * 64, lane); continue; }
            r -= 2 * I_12;
            if (r < 2 * I_3) { const int which = r >= I_3; r -= which * I_3; const int kb = r / 32, nb = r % 32;
                transpose_item(a.in[which ? I_F2W3 : I_F1W3], FF, 1024, nb * 32, (bf16*)(ws + (which ? WS_W3B : WS_W3A)), nb * 32, scr, kb * 64, lane); continue; }
            r -= 2 * I_3;
            if (r < I_IN) { const int kb = r / 112, nb = r % 112, n0 = nb * 32;
                const int src = (n0 & ~255) + ((n0 >> 5) & 3) * 64 + ((n0 >> 7) & 1) * 32;
                transpose_item(a.in[I_WIN], 1024, NIN, src, (bf16*)(ws + WS_WIN), n0, scr, kb * 64, lane); continue; }
            r -= I_IN;
            { const int kb = r / 32, nb = r % 32; transpose_item(a.in[I_WOUT], 1024, 1024, nb * 32, (bf16*)(ws + WS_WOUT), nb * 32, scr, kb * 64, lane); }
        }
    }
}

template <bool GATES, bool XBF>
__device__ __forceinline__ void norm_phase(const Args& a, const void* xin_, int sub, LAS unsigned char* lds) {
    const int tid = __tid_l(), lane = tid & 63, wave = __builtin_amdgcn_readfirstlane(tid >> 6), G = gridDim.x, bx = blockIdx.x;
    bf16* hn = (bf16*)(a.ws + WS_HN); const float* mod = (const float*)(a.ws + WS_MOD); float* gates = (float*)(a.ws + WS_GATES);
    const float* gn = a.in[I_GNORM] + sub * 1024;
    f32x4 wlo[GATES ? 16 : 1], whi[GATES ? 16 : 1];
    if (GATES) {
        const float* win = a.in[I_WIN];
#pragma unroll
        for (int j = 0; j < 4; ++j)
#pragma unroll
            for (int e = 0; e < 4; ++e) { const float* wp = win + (size_t)(256 * j + 4 * lane + e) * NIN + NINP; wlo[4 * j + e] = *(const f32x4*)wp; whi[4 * j + e] = *(const f32x4*)(wp + 4); }
    }
    const int gw = bx * 8 + wave, NGW = G * 8;
    if (!GATES && !XBF) {
        const bf16* Wt = (const bf16*)(a.ws + WS_W12B); float* sb = (float*)(a.ws + WS_SB3);
        for (int n = gw; n < 2 * FF; n += NGW) {
            float wv[16];
#pragma unroll
            for (int j = 0; j < 4; ++j) { const v2u w = *(const v2u*)(Wt + (size_t)n * 1024 + 256 * j + 4 * lane); wv[4 * j] = bflo(w.x); wv[4 * j + 1] = bfhi(w.x); wv[4 * j + 2] = bflo(w.y); wv[4 * j + 3] = bfhi(w.y); }
#pragma unroll
            for (int b = 0; b < 8; ++b) { const float* sh = mod + (size_t)b * NMOD + 6 * 1024 + 4 * lane; float s = 0.f;
#pragma unroll
                for (int j = 0; j < 4; ++j) { const f32x4 sv = *(const f32x4*)(sh + 256 * j); s += (wv[4 * j] * sv[0] + wv[4 * j + 1] * sv[1]) + (wv[4 * j + 2] * sv[2] + wv[4 * j + 3] * sv[3]); }
                s = wave_sum(s);
                if (lane == 0) sb[(size_t)b * (2 * FF) + n] = s; }
        }
    }
    for (int rb = gw; rb < TOK / 16; rb += NGW) {
        const int row0 = rb * 16, b = row0 >> 12;
        const float* mb = mod + (size_t)b * NMOD + sub * 3072;
        f32x4 gs[4], sh[4];
#pragma unroll
        for (int j = 0; j < 4; ++j) { const int col = 256 * j + 4 * lane; gs[j] = *(const f32x4*)(gn + col) * (*(const f32x4*)(mb + 1024 + col) + 1.0f); sh[j] = *(const f32x4*)(mb + col); }
#pragma unroll 2
        for (int r = 0; r < 16; ++r) {
            f32x4 v[4]; float ss = 0.f;
#pragma unroll
            for (int j = 0; j < 4; ++j) {
                if (XBF) { const v2u w = *(const v2u*)((const bf16*)xin_ + (size_t)(row0 + r) * 1024 + 4 * lane + 256 * j); v[j] = (f32x4){bflo(w.x), bfhi(w.x), bflo(w.y), bfhi(w.y)}; }
                else v[j] = *(const f32x4*)((const float*)xin_ + (size_t)(row0 + r) * 1024 + 4 * lane + 256 * j);
                ss += (v[j][0] * v[j][0] + v[j][1] * v[j][1]) + (v[j][2] * v[j][2] + v[j][3] * v[j][3]); }
            const float rinv = 1.0f / sqrtf(wave_sum(ss) * (1.0f / 1024.0f) + 1e-6f);
            bf16* orow = hn + (size_t)(row0 + r) * 1024 + 4 * lane;
#pragma unroll
            for (int j = 0; j < 4; ++j) { v[j] = v[j] * rinv * gs[j] + sh[j]; v2u o; o.x = pk2(v[j][0], v[j][1]); o.y = pk2(v[j][2], v[j][3]); *(v2u*)(orow + 256 * j) = o; }
            if (GATES) {
                f32x4 glo = (f32x4){0.f, 0.f, 0.f, 0.f}, ghi = (f32x4){0.f, 0.f, 0.f, 0.f};
#pragma unroll
                for (int j = 0; j < 4; ++j)
#pragma unroll
                    for (int e = 0; e < 4; ++e) { glo += wlo[4 * j + e] * v[j][e]; ghi += whi[4 * j + e] * v[j][e]; }
                const bool u32_ = (lane & 32) != 0, u16_ = (lane & 16) != 0, u8_ = (lane & 8) != 0;
                f32x4 keep = u32_ ? ghi : glo; const f32x4 send = u32_ ? glo : ghi;
#pragma unroll
                for (int e = 0; e < 4; ++e) keep[e] += __shfl_xor(send[e], 32);
                float k20 = u16_ ? keep[2] : keep[0], k21 = u16_ ? keep[3] : keep[1]; const float s20 = u16_ ? keep[0] : keep[2], s21 = u16_ ? keep[1] : keep[3];
                k20 += __shfl_xor(s20, 16); k21 += __shfl_xor(s21, 16);
                float k1 = u8_ ? k21 : k20; const float s1 = u8_ ? k20 : k21;
                k1 += __shfl_xor(s1, 8);
                k1 += __shfl_xor(k1, 4); k1 += __shfl_xor(k1, 2); k1 += __shfl_xor(k1, 1);
                if ((lane & 7) == 0) gates[(size_t)(row0 + r) * 8 + (lane >> 3)] = k1;
            }
        }
    }
}

namespace ml {
constexpr int QP = 136, SP = 72;
constexpr int L_QS = 0, L_KS = 17408, LP_EP = 71680;
constexpr int L_VS = 33792, L_WS = 41984, L_CT = 51200, L_N = 68608, L_QN = 69120, L_RS = 69376, L_RK = 69888, L_G = 70400, GSTRIDE = 1024, L_BPL = 72448;
typedef short v4i16_t __attribute__((ext_vector_type(4)));
__device__ __forceinline__ bf16x8 tr_frag(const LAS unsigned char* p0, const LAS unsigned char* p1) {
    const v4i16_t lo = __builtin_amdgcn_ds_read_tr16_b64_v4i16((LAS v4i16_t*)p0), hi = __builtin_amdgcn_ds_read_tr16_b64_v4i16((LAS v4i16_t*)p1);
    return (bf16x8){lo[0], lo[1], lo[2], lo[3], hi[0], hi[1], hi[2], hi[3]};
}
__device__ __forceinline__ float scan_add(float v, int lane) {
#pragma unroll
    for (int o = 1; o < 64; o <<= 1) { const float t = __shfl_up(v, o); if (lane >= o) v += t; }
    return v;
}
__device__ __forceinline__ float scan_max(float v, int lane) {
#pragma unroll
    for (int o = 1; o < 64; o <<= 1) { const float t = __shfl_up(v, o); if (lane >= o) v = fmaxf(v, t); }
    return v;
}
}

__device__ __forceinline__ void mlprep_phase(const Args& a, LAS unsigned char* lds) {
    using namespace ml;
    const int tid = __tid_l(), lane = tid & 63, wave = __builtin_amdgcn_readfirstlane(tid >> 6), G = gridDim.x, bx = blockIdx.x;
    const bf16* MLQK = (const bf16*)(a.ws + WS_MLQK);
    LAS bf16* Qs = (LAS bf16*)(lds + L_QS); LAS bf16* Ks = (LAS bf16*)(lds + L_KS); LAS float* EP = (LAS float*)(lds + LP_EP);
    const int cg_ = tid & 31, rg = tid >> 5; const bool isq = cg_ < 16;
    for (int it = bx; it < 2048; it += G) {
        const int bh = it >> 6, c = it & 63, b = bh >> 2, h = bh & 3;
        const int colq = isq ? (h * 128 + cg_ * 8) : (512 + h * 128 + (cg_ - 16) * 8);
        const bf16* qk_base = MLQK + (size_t)b * SEQ * 1024 + colq;
        v4u uq[7];
        { const int t0 = c * 64 + rg * 4 - 3;
#pragma unroll
          for (int i = 0; i < 7; ++i) { const int t = t0 + i; uq[i] = *(const v4u*)(qk_base + (size_t)(t < 0 ? 0 : t) * 1024); if (t < 0) uq[i] = (v4u){0u, 0u, 0u, 0u}; }
 }
        float cw[4][8], cb[8];
#pragma unroll
        for (int j = 0; j < 4; ++j) { const f32x4 w0 = *(const f32x4*)(a.in[I_CONVW] + j * 1024 + colq), w1 = *(const f32x4*)(a.in[I_CONVW] + j * 1024 + colq + 4);
            cw[j][0] = w0[0]; cw[j][1] = w0[1]; cw[j][2] = w0[2]; cw[j][3] = w0[3]; cw[j][4] = w1[0]; cw[j][5] = w1[1]; cw[j][6] = w1[2]; cw[j][7] = w1[3]; }
        { const f32x4 w0 = *(const f32x4*)(a.in[I_CONVB] + colq), w1 = *(const f32x4*)(a.in[I_CONVB] + colq + 4);
          cb[0] = w0[0]; cb[1] = w0[1]; cb[2] = w0[2]; cb[3] = w0[3]; cb[4] = w1[0]; cb[5] = w1[1]; cb[6] = w1[2]; cb[7] = w1[3]; }
        if (wave == 0) {
            const float* gp = (const float*)(a.ws + WS_GATES) + ((size_t)b * SEQ + c * 64 + lane) * 8;
            const float ig = gp[h] + a.in[I_BIG][h], fg = gp[4 + h] + a.in[I_BFG][h];
            const float fl = fminf(fg, 0.f) - log1pf(__expf(-fabsf(fg)));
            const float bb = scan_add(fl, lane), p = ig - bb;
            EP[lane] = __expf(p);
            float* bpo = (float*)(a.ws + WS_BP) + ((size_t)bh * SEQ + c * 64 + lane) * 2; bpo[0] = bb; bpo[1] = p;
        }
        __syncthreads();
        {
#pragma unroll
          for (int r = 0; r < 4; ++r) { float o[8];
#pragma unroll
              for (int i = 0; i < 8; ++i) o[i] = cb[i];
#pragma unroll
              for (int j = 0; j < 4; ++j) { const v4u u_ = uq[r + j];
                  o[0] += cw[j][0] * bflo(u_.x); o[1] += cw[j][1] * bfhi(u_.x); o[2] += cw[j][2] * bflo(u_.y); o[3] += cw[j][3] * bfhi(u_.y);
                  o[4] += cw[j][4] * bflo(u_.z); o[5] += cw[j][5] * bfhi(u_.z); o[6] += cw[j][6] * bflo(u_.w); o[7] += cw[j][7] * bfhi(u_.w); }
              const int t_ = rg * 4 + r;
              const float qs_ = isq ? 0.08838834764831845f : EP[t_];
#pragma unroll
              for (int i = 0; i < 8; ++i) o[i] = o[i] * __builtin_amdgcn_rcpf(1.0f + __builtin_amdgcn_exp2f(-1.4426950408889634f * o[i])) * qs_;
              v4u w_; w_.x = pk2(o[0], o[1]); w_.y = pk2(o[2], o[3]); w_.z = pk2(o[4], o[5]); w_.w = pk2(o[6], o[7]);
              if (isq) *(LAS v4u*)(Qs + t_ * QP + cg_ * 8) = w_; else *(LAS v4u*)(Ks + t_ * QP + (cg_ - 16) * 8) = w_;
          }
        }
        __syncthreads();
        { bf16* ga = (bf16*)(a.ws + WS_IMGA) + (size_t)it * 16384;
#pragma unroll
          for (int k = 0; k < 2; ++k) { const int idx = tid + 512 * k, row = idx >> 4, ch = idx & 15;
              *(v4u*)(ga + idx * 8) = *(const LAS v4u*)(Qs + row * QP + ch * 8); *(v4u*)(ga + 8192 + idx * 8) = *(const LAS v4u*)(Ks + row * QP + ch * 8); }
          { const int d = tid & 127, sq = tid >> 7; float s = 0.f;
#pragma unroll
            for (int k = 0; k < 16; ++k) s += __builtin_bit_cast(float, (unsigned)Ks[(sq * 16 + k) * QP + d] << 16);
            ((LAS float*)(lds + LP_EP + 1024))[sq * 128 + d] = s; }
        }
        __syncthreads();
        if (tid < 128) { LAS float* rp = (LAS float*)(lds + LP_EP + 1024); ((float*)(a.ws + WS_RK))[(size_t)it * 128 + tid] = (rp[tid] + rp[128 + tid]) + (rp[256 + tid] + rp[384 + tid]); }
        __syncthreads();
    }
}

__device__ __forceinline__ void mlstm_item(const Args& a, int item, LAS unsigned char* lds) {
    using namespace ml;
    const int tid = __tid_l(), lane = tid & 63, wave = __builtin_amdgcn_readfirstlane(tid >> 6), l31 = lane & 31, g = lane >> 5;
    const int b = item >> 3, h = (item >> 1) & 3, half = item & 1, bh = b * 4 + h;
    const bf16* imgA = (const bf16*)(a.ws + WS_IMGA) + (size_t)bh * 64 * 16384 + tid * 8;
    const bf16* vsrc = (const bf16*)(a.ws + WS_MLV) + ((size_t)b * SEQ + (tid >> 3)) * 512 + h * 128 + half * 64 + (tid & 7) * 8;
    const float* bp = (const float*)(a.ws + WS_BP) + (size_t)bh * SEQ * 2;
    const float* rkg = (const float*)(a.ws + WS_RK) + (size_t)bh * 64 * 128;
    bf16* h_base = (bf16*)(a.ws + WS_MLH) + (size_t)b * SEQ * 512 + h * 128 + half * 64;

    LAS bf16* Qs = (LAS bf16*)(lds + L_QS); LAS bf16* Ws = (LAS bf16*)(lds + L_WS); LAS bf16* CT = (LAS bf16*)(lds + L_CT);
    LAS unsigned char* KsB = lds + L_KS; LAS unsigned char* VsB = lds + L_VS;
    const int li_ = lane & 15, tq_ = li_ >> 2, tp_ = li_ & 3, tc16_ = (lane >> 4) & 1;
    const int vtrb = 1024 * g + 64 * tq_ + 16 * (2 * tc16_ + (tp_ >> 1)) + 8 * (tp_ & 1);
    LAS float* Nv = (LAS float*)(lds + L_N); LAS float* QN = (LAS float*)(lds + L_QN); LAS float* RS = (LAS float*)(lds + L_RS); LAS float* RK = (LAS float*)(lds + L_RK);
#define GB(buf) ((LAS float*)(lds + L_G + (buf) * GSTRIDE))
#define ML_BAR() asm volatile("s_waitcnt lgkmcnt(0)\n\ts_barrier" ::: "memory")
    v4u pfA[5], pfB[5]; unsigned rkA = 0u, rkB = 0u;
    const int crow_ = tid >> 4, cch = tid & 15, crow8 = tid >> 3, cch8 = tid & 7;
    const float* rkl = rkg + (tid & 127);
#define ALOAD4(r, p) asm volatile("global_load_dwordx4 %0, %1, off" : "=&v"(r) : "v"(p) : "memory")
#define ALOAD1(r, p) asm volatile("global_load_dword %0, %1, off" : "=&v"(r) : "v"(p) : "memory")
#define TILE_LOAD(c, pf, rk) do { const bf16* ga_ = imgA + (size_t)(c) * 16384; \
        ALOAD4(pf[0], ga_); ALOAD4(pf[1], ga_ + 4096); ALOAD4(pf[2], ga_ + 8192); ALOAD4(pf[3], ga_ + 12288); \
        ALOAD4(pf[4], vsrc + (size_t)(c) * 64 * 512); ALOAD1(rk, rkl + (c) * 128); } while (0)
#define TILE_WAIT(N, pf, rk) asm volatile("s_waitcnt vmcnt(" #N ")" : "+v"(pf[0]), "+v"(pf[1]), "+v"(pf[2]), "+v"(pf[3]), "+v"(pf[4]), "+v"(rk) : : "memory")
#define KSWZ(row) ((((row) & 3) << 2) | (((row) >> 2) & 3))
#define TILE_WRITE(pf, rk) do { \
        *(LAS v4u*)(Qs + crow_ * QP + cch * 8) = pf[0]; *(LAS v4u*)(Qs + (crow_ + 32) * QP + cch * 8) = pf[1]; \
        *(LAS v4u*)(KsB + 256 * crow_ + 16 * (cch ^ KSWZ(crow_))) = pf[2]; *(LAS v4u*)(KsB + 256 * (crow_ + 32) + 16 * (cch ^ KSWZ(crow_))) = pf[3];     \
        *(LAS v4u*)(VsB + 1024 * (crow8 >> 3) + 512 * (cch8 >> 2) + 64 * (crow8 & 7) + 16 * (cch8 & 3)) = pf[4]; \
        if (tid < 128) RK[tid] = __builtin_bit_cast(float, rk); } while (0)
#define TRF(p0_) tr_frag((p0_), (p0_) + 256)
    float Mc = 0.f;
    LAS float* BPL = (LAS float*)(lds + L_BPL);
#define GATE_SCAN(c, buf) do { LAS float* o_ = GB(buf); const float gb_b = BPL[((c) * 64 + lane) * 2], gb_p = BPL[((c) * 64 + lane) * 2 + 1]; \
        const float P_ = scan_max(gb_p, lane); const float gg_ = __shfl(gb_b, 63), Pm_ = __shfl(P_, 63); \
        const float mt_ = gb_b + fmaxf(Mc, P_); const float al_ = gb_b - mt_; const float Mn_ = gg_ + fmaxf(Mc, Pm_); \
        o_[lane] = __expf(al_); o_[64 + lane] = __expf(al_ + Mc); o_[128 + lane] = __expf(-mt_); \
        if (lane == 0) { o_[192] = __expf(gg_ + Mc - Mn_); o_[193] = __expf(gg_ - Mn_); } Mc = Mn_; } while (0)

    f32x16 C;
#pragma unroll
    for (int r = 0; r < 16; ++r) C[r] = 0.f;
    const int dq = wave & 3, eh2 = wave >> 2;
    const int kch_ = 4 * dq + 2 * tc16_ + (tp_ >> 1);
    const int kt0 = 256 * (8 * g + tq_) + 16 * (kch_ ^ ((tq_ << 2) | (2 * g))) + 8 * (tp_ & 1), kt1 = 256 * (8 * g + 4 + tq_) + 16 * (kch_ ^ ((tq_ << 2) | (2 * g + 1))) + 8 * (tp_ & 1);
    for (int i = tid; i < 64 * QP / 2; i += 512) ((LAS unsigned*)CT)[i] = 0u;
    if (tid < 128) Nv[tid] = 0.f;
#pragma unroll
    for (int k = 0; k < 4; ++k) *(LAS f32x4*)(BPL + (tid + 512 * k) * 4) = *(const f32x4*)(bp + (tid + 512 * k) * 4);
    asm volatile("s_waitcnt vmcnt(0)" ::: "memory");
    TILE_LOAD(0, pfA, rkA); TILE_WAIT(0, pfA, rkA); TILE_WRITE(pfA, rkA);
    TILE_LOAD(1, pfB, rkB); TILE_LOAD(2, pfA, rkA);
    __syncthreads();
    if (wave == 4) GATE_SCAN(0, 0);
    __syncthreads();

    for (int c2 = 0; c2 < 64; c2 += 2) {
        { const int c = c2; const int cur = c & 1; LAS float* gb = GB(cur);
        if (wave == 4 && c + 1 < 64) GATE_SCAN(c + 1, cur ^ 1);
        { const int t = tid >> 3, d0 = (tid & 7) * 16; float s = 0.f;
#pragma unroll
          for (int k = 0; k < 2; ++k) { const v4u q8 = *(const LAS v4u*)(Qs + t * QP + d0 + 8 * k); const f32x4 n0 = *(const LAS f32x4*)(Nv + d0 + 8 * k), n1 = *(const LAS f32x4*)(Nv + d0 + 8 * k + 4);
              s += bflo(q8.x) * n0[0] + bfhi(q8.x) * n0[1] + bflo(q8.y) * n0[2] + bfhi(q8.y) * n0[3] + bflo(q8.z) * n1[0] + bfhi(q8.z) * n1[1] + bflo(q8.w) * n1[2] + bfhi(q8.w) * n1[3]; }
          s += __shfl_xor(s, 1); s += __shfl_xor(s, 2); s += __shfl_xor(s, 4);
          if ((tid & 7) == 0) QN[t] = s; }
        f32x16 acc;
#pragma unroll
        for (int r = 0; r < 16; ++r) acc[r] = 0.f;
        const int th = (wave & 3) >> 1, xh = wave & 1;
        const int t = 32 * th + l31;
        if (wave < 4) {
#pragma unroll
            for (int kk = 0; kk < 8; ++kk) { const bf16x8 av = *(const LAS bf16x8*)(KsB + 256 * (32 * xh + l31) + 16 * ((2 * kk + g) ^ KSWZ(l31))), bv = *(const LAS bf16x8*)(Qs + t * QP + kk * 16 + 8 * g);
                acc = __builtin_amdgcn_mfma_f32_32x32x16_bf16(av, bv, acc, 0, 0, 0); }
            const float ea = gb[t]; float rsum = 0.f;
#pragma unroll
            for (int i = 0; i < 4; ++i) { float wv[4];
#pragma unroll
                for (int e = 0; e < 4; ++e) { const int s = 32 * xh + 8 * i + 4 * g + e; wv[e] = (s <= t) ? acc[4 * i + e] * ea : 0.f; rsum += wv[e]; }
                v2u w2; w2.x = pk2(wv[0], wv[1]); w2.y = pk2(wv[2], wv[3]); *(LAS v2u*)(Ws + t * SP + 32 * xh + 8 * i + 4 * g) = w2; }
            rsum += __shfl_xor(rsum, 32);
            if (g == 0) RS[xh * 64 + t] = rsum;
        } else {
#pragma unroll
            for (int kk = 0; kk < 8; ++kk) { const bf16x8 av = *(const LAS bf16x8*)(CT + (32 * xh + l31) * QP + kk * 16 + 8 * g), bv = *(const LAS bf16x8*)(Qs + t * QP + kk * 16 + 8 * g);
                acc = __builtin_amdgcn_mfma_f32_32x32x16_bf16(av, bv, acc, 0, 0, 0); }
            const float ei = gb[64 + t];
#pragma unroll
            for (int r = 0; r < 16; ++r) acc[r] *= ei;
        }
        ML_BAR();
        if (wave >= 4) {
#pragma unroll
            for (int kk = 0; kk < 4; ++kk) { const bf16x8 av = TRF(VsB + vtrb + 2048 * kk + 512 * xh), bv = *(const LAS bf16x8*)(Ws + t * SP + kk * 16 + 8 * g);
                acc = __builtin_amdgcn_mfma_f32_32x32x16_bf16(av, bv, acc, 0, 0, 0); }
            const float den = gb[64 + t] * QN[t] + RS[t] + RS[64 + t];
            const float inv = 1.0f / fmaxf(fabsf(den), gb[128 + t]);
            bf16* hp = h_base + (size_t)(c * 64 + t) * 512 + 32 * xh + 4 * g;
#pragma unroll
            for (int i = 0; i < 4; ++i) { v2u o; o.x = pk2(acc[4 * i] * inv, acc[4 * i + 1] * inv); o.y = pk2(acc[4 * i + 2] * inv, acc[4 * i + 3] * inv); *(v2u*)(hp + 8 * i) = o; }
        }
        const float decay = gb[192], ff = gb[193];
        { f32x16 P;
#pragma unroll
          for (int r = 0; r < 16; ++r) P[r] = 0.f;
#pragma unroll
          for (int kk = 0; kk < 4; ++kk) { const bf16x8 av = tr_frag(KsB + kt0 + 4096 * kk, KsB + kt1 + 4096 * kk), bv = TRF(VsB + vtrb + 2048 * kk + 512 * eh2);
              P = __builtin_amdgcn_mfma_f32_32x32x16_bf16(av, bv, P, 0, 0, 0); }
#pragma unroll
          for (int r = 0; r < 16; ++r) C[r] = decay * C[r] + ff * P[r]; }
        float nnew = 0.f;
        if (tid < 128) nnew = decay * Nv[tid] + ff * RK[tid];
        ML_BAR();
#pragma unroll
        for (int i = 0; i < 4; ++i) { v2u o; o.x = pk2(C[4 * i], C[4 * i + 1]); o.y = pk2(C[4 * i + 2], C[4 * i + 3]); *(LAS v2u*)(CT + (32 * eh2 + l31) * QP + 32 * dq + 8 * i + 4 * g) = o; }
        if (tid < 128) Nv[tid] = nnew;
        if (c + 1 < 64) { if (c + 2 < 64) TILE_WAIT(6, pfB, rkB); else TILE_WAIT(0, pfB, rkB); TILE_WRITE(pfB, rkB); }
        if (c + 3 < 64) TILE_LOAD(c + 3, pfB, rkB);
        ML_BAR();
                }
        { const int c = c2 + 1; const int cur = c & 1; LAS float* gb = GB(cur);
        if (wave == 4 && c + 1 < 64) GATE_SCAN(c + 1, cur ^ 1);
        { const int t = tid >> 3, d0 = (tid & 7) * 16; float s = 0.f;
#pragma unroll
          for (int k = 0; k < 2; ++k) { const v4u q8 = *(const LAS v4u*)(Qs + t * QP + d0 + 8 * k); const f32x4 n0 = *(const LAS f32x4*)(Nv + d0 + 8 * k), n1 = *(const LAS f32x4*)(Nv + d0 + 8 * k + 4);
              s += bflo(q8.x) * n0[0] + bfhi(q8.x) * n0[1] + bflo(q8.y) * n0[2] + bfhi(q8.y) * n0[3] + bflo(q8.z) * n1[0] + bfhi(q8.z) * n1[1] + bflo(q8.w) * n1[2] + bfhi(q8.w) * n1[3]; }
          s += __shfl_xor(s, 1); s += __shfl_xor(s, 2); s += __shfl_xor(s, 4);
          if ((tid & 7) == 0) QN[t] = s; }
        f32x16 acc;
#pragma unroll
        for (int r = 0; r < 16; ++r) acc[r] = 0.f;
        const int th = (wave & 3) >> 1, xh = wave & 1;
        const int t = 32 * th + l31;
        if (wave < 4) {
#pragma unroll
            for (int kk = 0; kk < 8; ++kk) { const bf16x8 av = *(const LAS bf16x8*)(KsB + 256 * (32 * xh + l31) + 16 * ((2 * kk + g) ^ KSWZ(l31))), bv = *(const LAS bf16x8*)(Qs + t * QP + kk * 16 + 8 * g);
                acc = __builtin_amdgcn_mfma_f32_32x32x16_bf16(av, bv, acc, 0, 0, 0); }
            const float ea = gb[t]; float rsum = 0.f;
#pragma unroll
            for (int i = 0; i < 4; ++i) { float wv[4];
#pragma unroll
                for (int e = 0; e < 4; ++e) { const int s = 32 * xh + 8 * i + 4 * g + e; wv[e] = (s <= t) ? acc[4 * i + e] * ea : 0.f; rsum += wv[e]; }
                v2u w2; w2.x = pk2(wv[0], wv[1]); w2.y = pk2(wv[2], wv[3]); *(LAS v2u*)(Ws + t * SP + 32 * xh + 8 * i + 4 * g) = w2; }
            rsum += __shfl_xor(rsum, 32);
            if (g == 0) RS[xh * 64 + t] = rsum;
        } else {
#pragma unroll
            for (int kk = 0; kk < 8; ++kk) { const bf16x8 av = *(const LAS bf16x8*)(CT + (32 * xh + l31) * QP + kk * 16 + 8 * g), bv = *(const LAS bf16x8*)(Qs + t * QP + kk * 16 + 8 * g);
                acc = __builtin_amdgcn_mfma_f32_32x32x16_bf16(av, bv, acc, 0, 0, 0); }
            const float ei = gb[64 + t];
#pragma unroll
            for (int r = 0; r < 16; ++r) acc[r] *= ei;
        }
        ML_BAR();
        if (wave >= 4) {
#pragma unroll
            for (int kk = 0; kk < 4; ++kk) { const bf16x8 av = TRF(VsB + vtrb + 2048 * kk + 512 * xh), bv = *(const LAS bf16x8*)(Ws + t * SP + kk * 16 + 8 * g);
                acc = __builtin_amdgcn_mfma_f32_32x32x16_bf16(av, bv, acc, 0, 0, 0); }
            const float den = gb[64 + t] * QN[t] + RS[t] + RS[64 + t];
            const float inv = 1.0f / fmaxf(fabsf(den), gb[128 + t]);
            bf16* hp = h_base + (size_t)(c * 64 + t) * 512 + 32 * xh + 4 * g;
#pragma unroll
            for (int i = 0; i < 4; ++i) { v2u o; o.x = pk2(acc[4 * i] * inv, acc[4 * i + 1] * inv); o.y = pk2(acc[4 * i + 2] * inv, acc[4 * i + 3] * inv); *(v2u*)(hp + 8 * i) = o; }
        }
        const float decay = gb[192], ff = gb[193];
        { f32x16 P;
#pragma unroll
          for (int r = 0; r < 16; ++r) P[r] = 0.f;
#pragma unroll
          for (int kk = 0; kk < 4; ++kk) { const bf16x8 av = tr_frag(KsB + kt0 + 4096 * kk, KsB + kt1 + 4096 * kk), bv = TRF(VsB + vtrb + 2048 * kk + 512 * eh2);
              P = __builtin_amdgcn_mfma_f32_32x32x16_bf16(av, bv, P, 0, 0, 0); }
#pragma unroll
          for (int r = 0; r < 16; ++r) C[r] = decay * C[r] + ff * P[r]; }
        float nnew = 0.f;
        if (tid < 128) nnew = decay * Nv[tid] + ff * RK[tid];
        ML_BAR();
#pragma unroll
        for (int i = 0; i < 4; ++i) { v2u o; o.x = pk2(C[4 * i], C[4 * i + 1]); o.y = pk2(C[4 * i + 2], C[4 * i + 3]); *(LAS v2u*)(CT + (32 * eh2 + l31) * QP + 32 * dq + 8 * i + 4 * g) = o; }
        if (tid < 128) Nv[tid] = nnew;
        if (c + 1 < 64) { if (c + 2 < 64) TILE_WAIT(6, pfA, rkA); else TILE_WAIT(0, pfA, rkA); TILE_WRITE(pfA, rkA); }
        if (c + 3 < 64) TILE_LOAD(c + 3, pfA, rkA);
        ML_BAR();
                }
    }
    asm volatile("s_waitcnt vmcnt(0)" ::: "memory");
#undef GB
#undef ML_BAR
#undef TILE_LOAD
#undef TILE_WRITE
#undef TILE_WAIT
#undef KSWZ
#undef TRF
#undef ALOAD4
#undef ALOAD1
#undef GATE_SCAN
}

__device__ __forceinline__ unsigned xcc_id() { return (unsigned)__builtin_amdgcn_s_getreg((3 << 11) | 20) & 7u; }
__device__ __forceinline__ void mix_phase(const Args& a, unsigned char* lds_generic, LAS unsigned char* lds, int coff, bool do_ml, bool do_attn) {
    const int tid = __tid_l();
    unsigned* ctr = (unsigned*)(a.ws + WS_CTL) + coff * 64;
    volatile LAS int* MISC = (volatile LAS int*)(lds + MISC_OFF);
    const unsigned myx = xcc_id();
    const attn_body::bf16* Q = (const attn_body::bf16*)(a.ws + WS_Q); const attn_body::bf16* K = (const attn_body::bf16*)(a.ws + WS_K);
    const attn_body::bf16* V = (const attn_body::bf16*)(a.ws + WS_V); attn_body::bf16* AO = (attn_body::bf16*)(a.ws + WS_AO);
    if (do_ml) for (;;) {
        if (tid == 0) { int found = -1;
            const unsigned j0 = __hip_atomic_fetch_add(ctr + (8 + myx) * 64, 1u, __ATOMIC_RELAXED, __HIP_MEMORY_SCOPE_AGENT);
            if (j0 < 8u) found = (int)(myx * 8u + j0);
            else { unsigned cnt[7];
#pragma unroll
                for (unsigned dx = 1; dx < 8; ++dx) cnt[dx - 1] = __hip_atomic_load(ctr + (8 + ((myx + dx) & 7u)) * 64, __ATOMIC_RELAXED, __HIP_MEMORY_SCOPE_AGENT);
#pragma unroll
                for (unsigned dx = 1; dx < 8; ++dx) if (found < 0 && cnt[dx - 1] < 8u) { const unsigned x = (myx + dx) & 7u; const unsigned j = __hip_atomic_fetch_add(ctr + (8 + x) * 64, 1u, __ATOMIC_RELAXED, __HIP_MEMORY_SCOPE_AGENT);
                    if (j < 8u) found = (int)(x * 8u + j); } }
            MISC[0] = found; }
        __syncthreads();
        const int f = __builtin_amdgcn_readfirstlane(MISC[0]);
        __syncthreads();
        if (f < 0) break;
        mlstm_item(a, f, lds);
        __syncthreads();
    }
    if (do_attn) {
        if (tid == 0) { int found = -1;
            const unsigned j0 = __hip_atomic_fetch_add(ctr + myx * 64, 1u, __ATOMIC_RELAXED, __HIP_MEMORY_SCOPE_AGENT);
            if (j0 < 256u) found = (int)(myx * 256u + j0);
            else { unsigned cnt[7];
#pragma unroll
                for (unsigned dx = 1; dx < 8; ++dx) cnt[dx - 1] = __hip_atomic_load(ctr + ((myx + dx) & 7u) * 64, __ATOMIC_RELAXED, __HIP_MEMORY_SCOPE_AGENT);
#pragma unroll
                for (unsigned dx = 1; dx < 8; ++dx) if (found < 0 && cnt[dx - 1] < 256u) { const unsigned x = (myx + dx) & 7u; const unsigned j = __hip_atomic_fetch_add(ctr + x * 64, 1u, __ATOMIC_RELAXED, __HIP_MEMORY_SCOPE_AGENT);
                    if (j < 256u) found = (int)(x * 256u + j); } }
            MISC[0] = found; }
        __syncthreads();
        int f = __builtin_amdgcn_readfirstlane(MISC[0]);
        __syncthreads();
        while (f >= 0) {
            const int x = f >> 8, jj = f & 255, qb = 15 - ((jj & 63) >> 2), bh = x + 8 * ((jj >> 6) * 4 + (jj & 3)), b = bh >> 4, hp = bh & 15;
            unsigned nj = 0u;
            if (tid == 0) nj = __hip_atomic_fetch_add(ctr + x * 64, 1u, __ATOMIC_RELAXED, __HIP_MEMORY_SCOPE_AGENT);
            attn_body::attn_unit<8>(b, (hp >> 1) * 64, ((hp >> 2) * 2 + (hp & 1)) * 64, hp * 64, qb, Q, K, V, AO, (char*)lds_generic);
            if (tid == 0) { int found = -1;
                if (nj < 256u) found = x * 256 + (int)nj;
                else { unsigned cnt[7];
#pragma unroll
                    for (unsigned dx = 1; dx < 8; ++dx) cnt[dx - 1] = __hip_atomic_load(ctr + (((unsigned)x + dx) & 7u) * 64, __ATOMIC_RELAXED, __HIP_MEMORY_SCOPE_AGENT);
#pragma unroll
                    for (unsigned dx = 1; dx < 8; ++dx) if (found < 0 && cnt[dx - 1] < 256u) { const unsigned x2 = ((unsigned)x + dx) & 7u; const unsigned j = __hip_atomic_fetch_add(ctr + x2 * 64, 1u, __ATOMIC_RELAXED, __HIP_MEMORY_SCOPE_AGENT);
                        if (j < 256u) found = (int)(x2 * 256u + j); } }
                MISC[0] = found; }
            __syncthreads();
            f = __builtin_amdgcn_readfirstlane(MISC[0]);
            __syncthreads();
        }
    }
}

__device__ __forceinline__ void combine_phase(const Args& a) {
    const int tid = __tid_l(), lane = tid & 63, wave = __builtin_amdgcn_readfirstlane(tid >> 6), G = gridDim.x, bx = blockIdx.x;
    const bf16* AO = (const bf16*)(a.ws + WS_AO); const bf16* MLH = (const bf16*)(a.ws + WS_MLH); const bf16* MLO = (const bf16*)(a.ws + WS_MLO); bf16* Y = (bf16*)(a.ws + WS_HN);
    const float* lq = a.in[I_LAMQK];
    const float lam = __expf(wave_sum(lq[lane] * lq[64 + lane])) - __expf(wave_sum(lq[128 + lane] * lq[192 + lane])) + 0.2f;
    const int head = lane >> 4, vh = (lane >> 3) & 1, d = (lane & 7) * 8;
    float gda[8], gml[8];
#pragma unroll
    for (int i = 0; i < 8; ++i) { gda[i] = a.in[I_GDA][(lane & 15) * 8 + i] * 0.8f; gml[i] = a.in[I_GML][lane * 8 + i]; }
    const int gw = bx * 8 + wave, NGW = G * 8;
    for (int rb = gw; rb < TOK / 16; rb += NGW) {
#pragma unroll 4
        for (int r = 0; r < 16; ++r) {
            const size_t row = (size_t)rb * 16 + r;
            const v4u a0 = *(const v4u*)(AO + row * 1024 + ((head * 2 + 0) * 2 + vh) * 64 + d), a1 = *(const v4u*)(AO + row * 1024 + ((head * 2 + 1) * 2 + vh) * 64 + d);
            const v4u hh = *(const v4u*)(MLH + row * 512 + lane * 8), oo = *(const v4u*)(MLO + row * 512 + lane * 8);
            const unsigned a0w[4] = {a0.x, a0.y, a0.z, a0.w}, a1w[4] = {a1.x, a1.y, a1.z, a1.w}, hw[4] = {hh.x, hh.y, hh.z, hh.w}, ow[4] = {oo.x, oo.y, oo.z, oo.w};
            float o[8], hv[8], s1 = 0.f, s2 = 0.f;
#pragma unroll
            for (int i = 0; i < 4; ++i) { o[2 * i] = bflo(a0w[i]) - lam * bflo(a1w[i]); o[2 * i + 1] = bfhi(a0w[i]) - lam * bfhi(a1w[i]); hv[2 * i] = bflo(hw[i]); hv[2 * i + 1] = bfhi(hw[i]);
                s1 += o[2 * i] * o[2 * i] + o[2 * i + 1] * o[2 * i + 1]; s2 += hv[2 * i] * hv[2 * i] + hv[2 * i + 1] * hv[2 * i + 1]; }
#pragma unroll
            for (int m = 1; m < 16; m <<= 1) { s1 += __shfl_xor(s1, m); s2 += __shfl_xor(s2, m); }
            const float r1 = __builtin_amdgcn_rsqf(s1 * (1.0f / 128.0f) + 1e-6f), r2 = __builtin_amdgcn_rsqf(s2 * (1.0f / 128.0f) + 1e-6f);
            float y1[8], y2[8];
#pragma unroll
            for (int i = 0; i < 8; ++i) { const float op = (i & 1) ? bfhi(ow[i >> 1]) : bflo(ow[i >> 1]);
                y1[i] = o[i] * r1 * gda[i]; y2[i] = hv[i] * r2 * gml[i] * __builtin_amdgcn_rcpf(1.0f + __builtin_amdgcn_exp2f(-1.4426950408889634f * op)); }
            v4u w1, w2; w1.x = pk2(y1[0], y1[1]); w1.y = pk2(y1[2], y1[3]); w1.z = pk2(y1[4], y1[5]); w1.w = pk2(y1[6], y1[7]);
            w2.x = pk2(y2[0], y2[1]); w2.y = pk2(y2[2], y2[3]); w2.z = pk2(y2[4], y2[5]); w2.w = pk2(y2[6], y2[7]);
            *(v4u*)(Y + row * 1024 + lane * 8) = w1; *(v4u*)(Y + row * 1024 + 512 + lane * 8) = w2;
        }
    }
}

constexpr int N_PHASES = 13;
#ifndef DUP_MASK
#define DUP_MASK 0
#endif
__global__ void __launch_bounds__(512, 2) mk_fwd(Args a) {
    extern __shared__ __attribute__((aligned(16))) unsigned char lds_raw[];
    LAS unsigned char* lds = (LAS unsigned char*)lds_raw;
    cg::grid_group grid = cg::this_grid();
    { volatile LAS unsigned* M_ = (volatile LAS unsigned*)(lds + MISC_OFF); if (threadIdx.x < 32) M_[threadIdx.x] = 0u; __syncthreads(); }
    XcdBarrier xbar = xcd_barrier_post((unsigned*)(a.ws + WS_CTL) + 4096, (volatile LAS unsigned*)(lds + MISC_OFF) + 8);
    if (a.ph_lo < 0) grid.sync();
    const int lo = a.ph_lo, hi = a.ph_hi, G = gridDim.x, bx = blockIdx.x;
    unsigned char* ws = a.ws;
    const float* mod = (const float*)(ws + WS_MOD);
    bf16* HN = (bf16*)(ws + WS_HN); bf16* HID = (bf16*)(ws + WS_HID);
    bf16* X1 = (bf16*)a.out;
    bf16* X2 = (bf16*)(ws + WS_MLV);
#define IN(k) (lo <= (k) && (k) < hi)
#define REP(k) for (int rep_ = 0; rep_ <= ((DUP_MASK >> (k)) & 1); ++rep_)
#define RSYNC() do { if (rep_) xcd_barrier(xbar); } while (0)
#define SEAM(k) do { if (IN(k) && IN((k) + 1)) xcd_barrier(xbar); } while (0)
    if (IN(0)) REP(0) { RSYNC(); p0_prologue(a, lds); } SEAM(0);
    if (DUP_MASK & 0x4000) { for (int i_ = 0; i_ < 10; ++i_) xcd_barrier(xbar); }
    if (IN(1)) REP(1) { RSYNC(); norm_phase<false, false>(a, a.in[I_X], 0, lds); } SEAM(1);
    if (IN(2)) REP(2) { RSYNC(); pg8::Gemm g{HN, (const bf16*)(ws + WS_W12A), TOK, 2 * FF, DM}; pg8::StaticOrder S; S.init(TOK, 2 * FF, G, bx);
        pg8::EpiSwiGLU E{HID, FF}; pg8::gemm_phase<pg8::EpiSwiGLU, pg8::StaticOrder, true, true>(lds, g, S, E); } SEAM(2);
    if (IN(3)) REP(3) { RSYNC(); pg8::Gemm g{HID, (const bf16*)(ws + WS_W3A), TOK, DM, FF}; pg8::StaticOrder S; S.init(TOK, DM, G, bx);
        pg8::EpiResid<0, 1> E{a.in[I_X], X1, mod + 2 * 1024, 0.5f}; pg8::gemm_phase<pg8::EpiResid<0, 1>, pg8::StaticOrder, true, true>(lds, g, S, E); } SEAM(3);
    if (IN(4)) REP(4) { RSYNC(); norm_phase<true, true>(a, X1, 1, lds); } SEAM(4);
    if (IN(5)) REP(5) { RSYNC(); pg8::Gemm g{HN, (const bf16*)(ws + WS_WIN), TOK, NINP, DM}; pg8::StaticOrder S; S.init(TOK, NINP, G, bx);
        pg8::EpiMix E{(bf16*)(ws + WS_Q), (bf16*)(ws + WS_K), (bf16*)(ws + WS_V), (bf16*)(ws + WS_MLQK), (bf16*)(ws + WS_MLV), (bf16*)(ws + WS_MLO), a.in[I_GQ], a.in[I_GK], (const float*)(ws + WS_ROPE), C2Q};
        pg8::gemm_phase<pg8::EpiMix, pg8::StaticOrder, true, true>(lds, g, S, E); } SEAM(5);
    if (IN(6)) REP(6) { RSYNC(); mlprep_phase(a, lds); } SEAM(6);
    if (IN(7)) { mix_phase(a, lds_raw, lds, 0, true, true); if (DUP_MASK & 0x80) { xcd_barrier(xbar); mix_phase(a, lds_raw, lds, 16, true, true); } if (DUP_MASK & 0x1000) { xcd_barrier(xbar); mix_phase(a, lds_raw, lds, 32, true, false); } if (DUP_MASK & 0x2000) { xcd_barrier(xbar); mix_phase(a, lds_raw, lds, 48, false, true); } } SEAM(7);
    if (IN(8)) REP(8) { RSYNC(); combine_phase(a); } SEAM(8);
    if (IN(9)) { pg8::Gemm g{HN, (const bf16*)(ws + WS_WOUT), TOK, DM, DM}; pg8::StaticOrder S; S.init(TOK, DM, G, bx);
        pg8::EpiResidXg E{X1, X2, mod + 5 * 1024, 1.0f, (bf16*)(ws + WS_XG3), a.in[I_GNORM] + 2048, mod + 7 * 1024, (float*)(ws + WS_RSS)}; pg8::gemm_phase<pg8::EpiResidXg, pg8::StaticOrder, true, true>(lds, g, S, E); } SEAM(9);
    if (IN(11)) REP(11) { RSYNC(); pg8::Gemm g{(const bf16*)(ws + WS_XG3), (const bf16*)(ws + WS_W12B), TOK, 2 * FF, DM}; pg8::StaticOrder S; S.init(TOK, 2 * FF, G, bx);
        pg8::EpiSwiGLUN E{HID, FF, (const float*)(ws + WS_RSS), (const float*)(ws + WS_SB3), 2 * FF}; pg8::gemm_phase<pg8::EpiSwiGLUN, pg8::StaticOrder, true, true>(lds, g, S, E); } SEAM(11);
    if (IN(12)) { pg8::Gemm g{HID, (const bf16*)(ws + WS_W3B), TOK, DM, FF}; pg8::StaticOrder S; S.init(TOK, DM, G, bx);
        pg8::EpiResid<1, 0> E{X2, a.out, mod + 8 * 1024, 0.5f}; pg8::gemm_phase<pg8::EpiResid<1, 0>, pg8::StaticOrder, true, true>(lds, g, S, E); }
#undef IN
#undef SEAM
}

#ifndef MK_MULTI
#define MK_MULTI 0
#endif
extern "C" void kernel_launch(void* const* d_in, const int* in_sizes, int n_in, void* d_out, int out_size, void* d_ws, size_t ws_size, hipStream_t stream) {
    static int grid = 0;
    if (grid == 0) {
        if (n_in != 20 || out_size != TOK * DM || ws_size < WS_END) { fprintf(stderr, "kernel_launch: unexpected shapes (n_in %d out %d ws %zu)\n", n_in, out_size, ws_size); grid = -1; return; }
        int dev = 0, cus = 0, per_cu = 0;
        hipGetDevice(&dev); hipDeviceGetAttribute(&cus, hipDeviceAttributeMultiprocessorCount, dev);
        if (hipFuncSetAttribute((const void*)mk_fwd, hipFuncAttributeMaxDynamicSharedMemorySize, LDS_BYTES) != hipSuccess) { fprintf(stderr, "kernel_launch: hipFuncSetAttribute failed\n"); grid = -1; return; }
        hipOccupancyMaxActiveBlocksPerMultiprocessor(&per_cu, (const void*)mk_fwd, 512, LDS_BYTES);
        (void)hipGetLastError();
        if (per_cu < 1) fprintf(stderr, "kernel_launch: occupancy query says %d blocks per CU\n", per_cu);
        grid = cus > 0 ? cus : 256;
    }
    if (grid < 0) return;
    if (hipMemsetAsync((char*)d_ws + WS_CTL, 0, 32768, stream) != hipSuccess) { fprintf(stderr, "kernel_launch: hipMemsetAsync failed\n"); return; }
    Args a{};
    for (int i = 0; i < 20; ++i) a.in[i] = (const float*)d_in[i];
    a.out = (float*)d_out; a.ws = (unsigned char*)d_ws;
#if MK_MULTI
    for (int p = 0; p < N_PHASES; ++p) { a.ph_lo = p; a.ph_hi = p + 1; hipLaunchKernelGGL(mk_fwd, dim3(grid), dim3(512), LDS_BYTES, stream, a); }
#else
    a.ph_lo = 0; a.ph_hi = N_PHASES;
    void* args[] = {&a};
    hipError_t e = hipLaunchCooperativeKernel((const void*)mk_fwd, dim3(grid), dim3(512), args, LDS_BYTES, stream);
    if (e != hipSuccess) fprintf(stderr, "kernel_launch: cooperative launch failed: %s (grid %d)\n", hipGetErrorString(e), grid);
#endif
}
```

```cpp
#include <hip/hip_runtime.h>
#include <hip/hip_cooperative_groups.h>
#include <cstdio>
#include <cstdint>
__device__ __forceinline__ int __tid_l() { int t = threadIdx.x; asm volatile("" : "+v"(t)); return t; }
namespace pg8 {
#define PG8_LAS __attribute__((address_space(3)))
typedef unsigned short bf16_t;
typedef short bf16x8 __attribute__((ext_vector_type(8)));
typedef float f32x4 __attribute__((ext_vector_type(4)));
typedef unsigned u32x4 __attribute__((ext_vector_type(4)));
constexpr int BM = 256, BK = 64, HALF = 128, HTB = HALF * BK * 2  , STAGE_BYTES = 8 * HTB, NXCD = 8, WGM = 8;

__host__ __device__ __forceinline__ int lds_byte(int r, int c) { const int st = (r >> 4) * 2 + (c >> 5), rr = r & 15, cc = c & 31, ob = rr * 64 + cc * 2; return st * 1024 + (ob ^ (((ob >> 9) & 1) << 5)); }
__host__ __device__ __forceinline__ void stage_rc(int b, int& R, int& C) { const int st = b / 1024, sb = b % 1024, swz = sb ^ (((sb >> 9) & 1) << 5); R = (st >> 1) * 16 + swz / 64; C = (st & 1) * 32 + (swz % 64) / 2; }
__host__ __device__ __forceinline__ int perm32(int rho) { const int n = rho >> 4, i = rho & 15; return 8 * (i >> 2) + 4 * n + (i & 3); }

struct Unit { int pm, pn; };
struct Gemm { const bf16_t* A; const bf16_t* Bt; int M, N, K; };

struct StaticOrder {
    int nM, nN, nwg, G, c;
    __host__ __device__ void init(int M, int N, int G_, int c_) { nM = M / BM; nN = N / BM; nwg = nM * nN; G = G_; c = c_; }
    __host__ __device__ bool next(int i, Unit& u) const {
        const long L = (long)i * G + c; if (L >= nwg) return false;
        int wgid = (int)L; { const int q = nwg / NXCD, r = nwg % NXCD, xcd = wgid % NXCD, off = wgid / NXCD; wgid = (xcd < r ? xcd * (q + 1) : r * (q + 1) + (xcd - r) * q) + off; }
        const int nig = WGM * nN, gid = wgid / nig, fm = gid * WGM, gsz = (nM - fm) < WGM ? (nM - fm) : WGM;
        u.pm = fm + ((wgid % nig) % gsz); u.pn = (wgid % nig) / gsz; return true;
    }
    __device__ __forceinline__ void a_ready(const Unit&) const {}
    __device__ __forceinline__ void done(const Unit&) const {}
};

__device__ __forceinline__ unsigned cvt_pk_bf16(float lo, float hi) { unsigned r; asm volatile("v_cvt_pk_bf16_f32 %0, %1, %2" : "=v"(r) : "v"(lo), "v"(hi)); return r; }
__device__ __forceinline__ f32x4 silu4(f32x4 x) {
    f32x4 r;
#pragma unroll
    for (int i = 0; i < 4; ++i) r[i] = x[i] * __builtin_amdgcn_rcpf(1.0f + __builtin_amdgcn_exp2f(-1.4426950408889634f * x[i]));
    return r;
}
struct EpiSwiGLU {
    static constexpr bool PERM = true, AFTER_DRAIN = false;
    bf16_t* O; int ldo;
    __device__ __forceinline__ void operator()(const f32x4 (&acc)[2][2][4][2], const Unit& u, int wr, int wc, int fr, int fq) const {
        const int row0 = u.pm * BM + wr * 64 + fr, col0 = u.pn * HALF + wc * 32 + 8 * fq;
#pragma unroll
        for (int ai = 0; ai < 2; ++ai)
#pragma unroll
            for (int m = 0; m < 4; ++m) {
                bf16_t* p = O + (size_t)(row0 + ai * HALF + m * 16) * ldo + col0;
                const f32x4 h0 = silu4(acc[ai][0][m][0]) * acc[ai][1][m][0], h1 = silu4(acc[ai][0][m][1]) * acc[ai][1][m][1];
                u32x4 w; w.x = cvt_pk_bf16(h0[0], h0[1]); w.y = cvt_pk_bf16(h0[2], h0[3]); w.z = cvt_pk_bf16(h1[0], h1[1]); w.w = cvt_pk_bf16(h1[2], h1[3]);
                *(u32x4*)p = w;
            }
    }
};
template <int BT, int OT>
struct EpiResid {
    static constexpr bool PERM = true, AFTER_DRAIN = false;
    const void* base; void* out; const float* gate; float gs;
    __device__ __forceinline__ void operator()(const f32x4 (&acc)[2][2][4][2], const Unit& u, int wr, int wc, int fr, int fq) const {
        const int row0 = u.pm * BM + wr * 64 + fr, col0 = u.pn * BM + wc * 32 + 8 * fq;
        const float* gp = gate + (size_t)(u.pm >> 4) * 9216 + col0;
        f32x4 gv[2][2];
#pragma unroll
        for (int bj = 0; bj < 2; ++bj)
#pragma unroll
            for (int n = 0; n < 2; ++n) gv[bj][n] = (*(const f32x4*)(gp + bj * HALF + 4 * n) + 1.0f) * gs;
#pragma unroll
        for (int ai = 0; ai < 2; ++ai) {
            f32x4 pre[4][2][2];
#pragma unroll
            for (int m = 0; m < 4; ++m) { const size_t off = (size_t)(row0 + ai * HALF + m * 16) * 1024 + col0;
#pragma unroll
                for (int bj = 0; bj < 2; ++bj) {
                    if (BT == 0) { pre[m][bj][0] = *(const f32x4*)((const float*)base + off + bj * HALF); pre[m][bj][1] = *(const f32x4*)((const float*)base + off + bj * HALF + 4); }
                    else { const u32x4 w = *(const u32x4*)((const bf16_t*)base + off + bj * HALF);
                        pre[m][bj][0] = (f32x4){__builtin_bit_cast(float, w.x << 16), __builtin_bit_cast(float, w.x & 0xffff0000u), __builtin_bit_cast(float, w.y << 16), __builtin_bit_cast(float, w.y & 0xffff0000u)};
                        pre[m][bj][1] = (f32x4){__builtin_bit_cast(float, w.z << 16), __builtin_bit_cast(float, w.z & 0xffff0000u), __builtin_bit_cast(float, w.w << 16), __builtin_bit_cast(float, w.w & 0xffff0000u)}; } } }
            asm volatile("" ::: "memory");
#pragma unroll
            for (int m = 0; m < 4; ++m) { const size_t off = (size_t)(row0 + ai * HALF + m * 16) * 1024 + col0;
#pragma unroll
                for (int bj = 0; bj < 2; ++bj) { const f32x4 o0 = pre[m][bj][0] + gv[bj][0] * acc[ai][bj][m][0], o1 = pre[m][bj][1] + gv[bj][1] * acc[ai][bj][m][1];
                    if (OT == 0) { *(f32x4*)((float*)out + off + bj * HALF) = o0; *(f32x4*)((float*)out + off + bj * HALF + 4) = o1; }
                    else { u32x4 w; w.x = cvt_pk_bf16(o0[0], o0[1]); w.y = cvt_pk_bf16(o0[2], o0[3]); w.z = cvt_pk_bf16(o1[0], o1[1]); w.w = cvt_pk_bf16(o1[2], o1[3]); *(u32x4*)((bf16_t*)out + off + bj * HALF) = w; } } }
            asm volatile("" ::: "memory");
        }
    }
};
struct EpiResidXg {
    static constexpr bool PERM = true, AFTER_DRAIN = false;
    const bf16_t* base; bf16_t* out; const float* gate; float gs; bf16_t* xg; const float* gn; const float* scn; float* rss;
    __device__ __forceinline__ void operator()(const f32x4 (&acc)[2][2][4][2], const Unit& u, int wr, int wc, int fr, int fq) const {
        const int row0 = u.pm * BM + wr * 64 + fr, col0 = u.pn * BM + wc * 32 + 8 * fq;
        const float* gp = gate + (size_t)(u.pm >> 4) * 9216 + col0; const float* sp = scn + (size_t)(u.pm >> 4) * 9216 + col0;
        f32x4 gv[2][2], gsn[2][2];
#pragma unroll
        for (int bj = 0; bj < 2; ++bj)
#pragma unroll
            for (int n = 0; n < 2; ++n) { gv[bj][n] = (*(const f32x4*)(gp + bj * HALF + 4 * n) + 1.0f) * gs; gsn[bj][n] = *(const f32x4*)(gn + col0 + bj * HALF + 4 * n) * (*(const f32x4*)(sp + bj * HALF + 4 * n) + 1.0f); }
#pragma unroll
        for (int ai = 0; ai < 2; ++ai)
#pragma unroll
        for (int mb = 0; mb < 4; mb += 2) {
            u32x4 prb[2][2];
#pragma unroll
            for (int mm = 0; mm < 2; ++mm) { const size_t off = (size_t)(row0 + ai * HALF + (mb + mm) * 16) * 1024 + col0;
#pragma unroll
                for (int bj = 0; bj < 2; ++bj) prb[mm][bj] = *(const u32x4*)(base + off + bj * HALF); }
            asm volatile("" ::: "memory");
#pragma unroll
            for (int mm = 0; mm < 2; ++mm) { const int m = mb + mm; const int row = row0 + ai * HALF + m * 16; const size_t off = (size_t)row * 1024 + col0; float ss = 0.f;
#pragma unroll
                for (int bj = 0; bj < 2; ++bj) { const u32x4 w = prb[mm][bj];
                    const f32x4 p0 = (f32x4){__builtin_bit_cast(float, w.x << 16), __builtin_bit_cast(float, w.x & 0xffff0000u), __builtin_bit_cast(float, w.y << 16), __builtin_bit_cast(float, w.y & 0xffff0000u)};
                    const f32x4 p1 = (f32x4){__builtin_bit_cast(float, w.z << 16), __builtin_bit_cast(float, w.z & 0xffff0000u), __builtin_bit_cast(float, w.w << 16), __builtin_bit_cast(float, w.w & 0xffff0000u)};
                    const f32x4 o0 = p0 + gv[bj][0] * acc[ai][bj][m][0], o1 = p1 + gv[bj][1] * acc[ai][bj][m][1];
                    u32x4 xo; xo.x = cvt_pk_bf16(o0[0], o0[1]); xo.y = cvt_pk_bf16(o0[2], o0[3]); xo.z = cvt_pk_bf16(o1[0], o1[1]); xo.w = cvt_pk_bf16(o1[2], o1[3]); *(u32x4*)(out + off + bj * HALF) = xo;
                    const f32x4 g0 = o0 * gsn[bj][0], g1 = o1 * gsn[bj][1];
                    u32x4 xw; xw.x = cvt_pk_bf16(g0[0], g0[1]); xw.y = cvt_pk_bf16(g0[2], g0[3]); xw.z = cvt_pk_bf16(g1[0], g1[1]); xw.w = cvt_pk_bf16(g1[2], g1[3]); *(u32x4*)(xg + off + bj * HALF) = xw;
                    ss += ((o0[0] * o0[0] + o0[1] * o0[1]) + (o0[2] * o0[2] + o0[3] * o0[3])) + ((o1[0] * o1[0] + o1[1] * o1[1]) + (o1[2] * o1[2] + o1[3] * o1[3])); }
                ss += __shfl_xor(ss, 16); ss += __shfl_xor(ss, 32);
                if (fq == 0) atomicAdd(rss + row, ss); }
            asm volatile("" ::: "memory");
        }
    }
};
struct EpiSwiGLUN {
    static constexpr bool PERM = true, AFTER_DRAIN = false;
    bf16_t* O; int ldo; const float* rss; const float* sb; int nphys;
    __device__ __forceinline__ void operator()(const f32x4 (&acc)[2][2][4][2], const Unit& u, int wr, int wc, int fr, int fq) const {
        const int row0 = u.pm * BM + wr * 64 + fr, col0 = u.pn * HALF + wc * 32 + 8 * fq;
        const float* sp = sb + (size_t)(u.pm >> 4) * nphys + u.pn * BM + wc * 32 + 8 * fq;
        f32x4 sv[2][2];
#pragma unroll
        for (int bj = 0; bj < 2; ++bj)
#pragma unroll
            for (int n = 0; n < 2; ++n) sv[bj][n] = *(const f32x4*)(sp + bj * HALF + 4 * n);
        float rinv[2][4];
#pragma unroll
        for (int ai = 0; ai < 2; ++ai)
#pragma unroll
            for (int m = 0; m < 4; ++m) rinv[ai][m] = __builtin_amdgcn_rsqf(rss[row0 + ai * HALF + m * 16] * (1.0f / 1024.0f) + 1e-6f);
#pragma unroll
        for (int ai = 0; ai < 2; ++ai)
#pragma unroll
            for (int m = 0; m < 4; ++m) {
                bf16_t* p = O + (size_t)(row0 + ai * HALF + m * 16) * ldo + col0; const float ri = rinv[ai][m];
                const f32x4 h0 = silu4(acc[ai][0][m][0] * ri + sv[0][0]) * (acc[ai][1][m][0] * ri + sv[1][0]), h1 = silu4(acc[ai][0][m][1] * ri + sv[0][1]) * (acc[ai][1][m][1] * ri + sv[1][1]);
                u32x4 w; w.x = cvt_pk_bf16(h0[0], h0[1]); w.y = cvt_pk_bf16(h0[2], h0[3]); w.z = cvt_pk_bf16(h1[0], h1[1]); w.w = cvt_pk_bf16(h1[2], h1[3]);
                *(u32x4*)p = w;
            }
    }
};
struct EpiMix {
    static constexpr bool PERM = true, AFTER_DRAIN = false;
    bf16_t *Q, *K, *V, *MLQK, *MLV, *MLO; const float *gq, *gk, *rope; float c2;
    __device__ __forceinline__ void operator()(const f32x4 (&acc)[2][2][4][2], const Unit& u, int wr, int wc, int fr, int fq) const {
        const int pn = u.pn, row0 = u.pm * BM + wr * 64 + fr;
        if (pn < 4) {
            const bool isq = pn < 2; const int grp = (pn & 1) * 4 + wc;
            bf16_t* dst = (isq ? Q : K) + grp * 64 + 8 * fq; const float* gvec = isq ? gq : gk; const float sc = isq ? c2 : 1.0f;
            f32x4 gv[2][2];
#pragma unroll
            for (int bj = 0; bj < 2; ++bj)
#pragma unroll
                for (int n = 0; n < 2; ++n) gv[bj][n] = *(const f32x4*)(gvec + 32 * bj + 8 * fq + 4 * n) * sc;
#pragma unroll
            for (int ai = 0; ai < 2; ++ai) {
                f32x4 cs[4][2][2];
#pragma unroll
                for (int m = 0; m < 4; ++m)
#pragma unroll
                    for (int n = 0; n < 2; ++n) { cs[m][n][0] = (f32x4){1.f, 0.f, 1.f, 0.f}; cs[m][n][1] = (f32x4){1.f, 0.f, 1.f, 0.f}; }
                if (fq < 2) {
#pragma unroll
                    for (int m = 0; m < 4; ++m) { const int pos = (row0 + ai * HALF + m * 16) & 4095;
#pragma unroll
                        for (int n = 0; n < 2; ++n) { cs[m][n][0] = *(const f32x4*)(rope + (size_t)pos * 16 + n * 8); cs[m][n][1] = *(const f32x4*)(rope + (size_t)pos * 16 + n * 8 + 4); } }
                }
#pragma unroll
                for (int m = 0; m < 4; ++m) {
                    const int row = row0 + ai * HALF + m * 16;
                    float ss = 0.f;
#pragma unroll
                    for (int bj = 0; bj < 2; ++bj)
#pragma unroll
                        for (int n = 0; n < 2; ++n) { const f32x4 x = acc[ai][bj][m][n]; ss += (x[0] * x[0] + x[1] * x[1]) + (x[2] * x[2] + x[3] * x[3]); }
                    ss += __shfl_xor(ss, 16); ss += __shfl_xor(ss, 32);
                    const float rinv = 1.0f / sqrtf(ss * (1.0f / 64.0f) + 1e-6f);
                    f32x4 v[2][2];
#pragma unroll
                    for (int bj = 0; bj < 2; ++bj)
#pragma unroll
                        for (int n = 0; n < 2; ++n) v[bj][n] = acc[ai][bj][m][n] * rinv * gv[bj][n];
                    const float sg = (fq == 0) ? -1.0f : 1.0f;
#pragma unroll
                    for (int n = 0; n < 2; ++n) {
                        const f32x4 x = v[0][n]; f32x4 pr;
#pragma unroll
                        for (int e = 0; e < 4; ++e) pr[e] = __shfl_xor(x[e], 16);
                        const f32x4 cs0 = cs[m][n][0], cs1 = cs[m][n][1];
                        f32x4 o;
                        o[0] = x[0] * cs0[0] + sg * pr[0] * cs0[1]; o[1] = x[1] * cs0[2] + sg * pr[1] * cs0[3];
                        o[2] = x[2] * cs1[0] + sg * pr[2] * cs1[1]; o[3] = x[3] * cs1[2] + sg * pr[3] * cs1[3];
                        v[0][n] = o;
                    }
#pragma unroll
                    for (int bj = 0; bj < 2; ++bj) {
                        u32x4 w; w.x = cvt_pk_bf16(v[bj][0][0], v[bj][0][1]); w.y = cvt_pk_bf16(v[bj][0][2], v[bj][0][3]); w.z = cvt_pk_bf16(v[bj][1][0], v[bj][1][1]); w.w = cvt_pk_bf16(v[bj][1][2], v[bj][1][3]);
                        *(u32x4*)(dst + (size_t)row * 512 + 32 * bj) = w;
                    }
                }
                asm volatile("" ::: "memory");
            }
        } else {
            bf16_t* dst; int ld; const int lc = 64 * wc + 8 * fq;
            if (pn < 6) { dst = V + (pn - 4) * 256 + lc; ld = 512; }
            else if (pn < 10) { dst = MLQK + (pn - 6) * 256 + lc; ld = 1024; }
            else if (pn < 12) { dst = MLV + (pn - 10) * 256 + lc; ld = 512; }
            else { dst = MLO + (pn - 12) * 256 + lc; ld = 512; }
#pragma unroll
            for (int ai = 0; ai < 2; ++ai)
#pragma unroll
                for (int m = 0; m < 4; ++m) {
                    bf16_t* p = dst + (size_t)(row0 + ai * HALF + m * 16) * ld;
#pragma unroll
                    for (int bj = 0; bj < 2; ++bj) {
                        const f32x4 a = acc[ai][bj][m][0], b = acc[ai][bj][m][1];
                        u32x4 w; w.x = cvt_pk_bf16(a[0], a[1]); w.y = cvt_pk_bf16(a[2], a[3]); w.z = cvt_pk_bf16(b[0], b[1]); w.w = cvt_pk_bf16(b[2], b[3]);
                        *(u32x4*)(p + 32 * bj) = w;
                    }
                }
        }
    }
};
template <class Epi, class Sched, bool ALIGN_EPI = false, bool SP2 = false>
__device__ __forceinline__ void gemm_phase(PG8_LAS unsigned char* lds, const Gemm g, const Sched& S, const Epi& E) {
    const int tid = __tid_l(), wid = __builtin_amdgcn_readfirstlane(tid >> 6), lane = tid & 63, wr = wid >> 2, wc = wid & 3, fr = lane & 15, fq = lane >> 4;
    const int K = g.K, nt = K / BK;
    unsigned voffA[2], voffB[2];
#pragma unroll
    for (int i = 0; i < 2; ++i) { int R, C; stage_rc(tid * 16 + i * 8192, R, C); const int Rb = Epi::PERM ? ((R & ~31) + perm32(R & 31)) : R;
        voffA[i] = (unsigned)(R * K + C) * 2u; voffB[i] = (unsigned)(Rb * K + C) * 2u; }
    const size_t kstep = (size_t)(BK * 2);
    const size_t hstep = (size_t)HALF * K * 2;
    const size_t tstep = 2 * hstep;
    const unsigned ldsw = (unsigned)wid * 1024u;
    const int aoff = lds_byte(wr * 64 + fr, fq * 8), boff = lds_byte(wc * 32 + fr, fq * 8);
#define PG8_SA(b, h) (((b) * 2 + (h)) * HTB)
#define PG8_SB(b, h) ((4 + (b) * 2 + (h)) * HTB)
#define PG8_STAGE(bufoff, gbase, voff) do { _Pragma("unroll") for (int _i = 0; _i < 2; ++_i) \
        __builtin_amdgcn_global_load_lds((const unsigned*)((const char*)(gbase) + (voff)[_i]), (PG8_LAS unsigned*)(lds + (bufoff) + ldsw + _i * 8192), 16, 0, 0); } while (0)
#define PG8_LDA(dst, b, h) do { _Pragma("unroll") for (int m = 0; m < 4; ++m) _Pragma("unroll") for (int k = 0; k < 2; ++k) dst[m][k] = *(const PG8_LAS bf16x8*)(lds + PG8_SA(b, h) + aoff + m * 2048 + k * 1024); } while (0)
#define PG8_LDB(dst, b, h) do { _Pragma("unroll") for (int n = 0; n < 2; ++n) _Pragma("unroll") for (int k = 0; k < 2; ++k) dst[n][k] = *(const PG8_LAS bf16x8*)(lds + PG8_SB(b, h) + boff + n * 2048 + k * 1024); } while (0)
#define PG8_MMA(ai, bj, At, Bt) do { __builtin_amdgcn_s_setprio(1); _Pragma("unroll") for (int m = 0; m < 4; ++m) _Pragma("unroll") for (int n = 0; n < 2; ++n) _Pragma("unroll") for (int k = 0; k < 2; ++k) \
        acc[ai][bj][m][n] = __builtin_amdgcn_mfma_f32_16x16x32_bf16(Bt[n][k], At[m][k], acc[ai][bj][m][n], 0, 0, 0); __builtin_amdgcn_s_setprio(0); } while (0)
#define PG8_WAIT_V(n) asm volatile("s_waitcnt vmcnt(" #n ")" ::: "memory")
#define PG8_WAIT_L(n) asm volatile("s_waitcnt lgkmcnt(" #n ")" ::: "memory")
#define PG8_BAR __builtin_amdgcn_s_barrier()
#define PG8_SCHED __builtin_amdgcn_sched_barrier(0)
    Unit cur, nxt; int ui = 0;
    if (!S.next(0, cur)) return;
    f32x4 acc[2][2][4][2];
#pragma unroll
    for (int a = 0; a < 2; ++a)
#pragma unroll
        for (int b = 0; b < 2; ++b)
#pragma unroll
            for (int m = 0; m < 4; ++m)
#pragma unroll
                for (int n = 0; n < 2; ++n) acc[a][b][m][n] = (f32x4){0.f, 0.f, 0.f, 0.f};
    bf16x8 At[4][2], B0[2][2], B1[2][2];
    const char* cA = (const char*)g.A + (size_t)cur.pm * tstep; const char* cB = (const char*)g.Bt + (size_t)cur.pn * tstep;
    S.a_ready(cur);
    if constexpr (SP2) {
        PG8_STAGE(PG8_SB(0, 0), cB, voffB); PG8_STAGE(PG8_SB(0, 1), cB + hstep, voffB); PG8_STAGE(PG8_SA(0, 0), cA, voffA); PG8_STAGE(PG8_SA(0, 1), cA + hstep, voffA);
        if (wr == 1) PG8_BAR;
        PG8_WAIT_V(2); PG8_BAR;
        PG8_STAGE(PG8_SB(1, 0), cB + kstep, voffB); PG8_STAGE(PG8_SA(1, 0), cA + kstep, voffA); PG8_STAGE(PG8_SB(1, 1), cB + hstep + kstep, voffB);
        PG8_WAIT_V(6); PG8_BAR;
    } else {
        PG8_STAGE(PG8_SB(0, 0), cB, voffB); PG8_STAGE(PG8_SA(0, 0), cA, voffA); PG8_STAGE(PG8_SB(0, 1), cB + hstep, voffB); PG8_STAGE(PG8_SA(0, 1), cA + hstep, voffA);
        if (wr == 1) PG8_BAR;
        PG8_WAIT_V(4); PG8_BAR;
        PG8_STAGE(PG8_SB(1, 0), cB + kstep, voffB); PG8_STAGE(PG8_SA(1, 0), cA + kstep, voffA); PG8_STAGE(PG8_SB(1, 1), cB + hstep + kstep, voffB);
        PG8_WAIT_V(6); PG8_BAR;
    }
    for (;;) {
        const bool has_next = S.next(ui + 1, nxt);
        const char* nA = has_next ? (const char*)g.A + (size_t)nxt.pm * tstep : cA; const char* nB = has_next ? (const char*)g.Bt + (size_t)nxt.pn * tstep : cB;
        for (int t = 0; t < nt; t += 2) {
            const bool last = (t == nt - 2);
            const char* a1 = cA + (size_t)(t + 1) * kstep;
            const char* a2 = last ? nA : cA + (size_t)(t + 2) * kstep; const char* b2 = last ? nB : cB + (size_t)(t + 2) * kstep;
            const char* a3 = a2 + kstep; const char* b3 = b2 + kstep;
            if (last && has_next) S.a_ready(nxt);
            if constexpr (SP2) {
            PG8_LDB(B0, 0, 0); PG8_LDB(B1, 0, 1); PG8_SCHED; PG8_LDA(At, 0, 0); PG8_STAGE(PG8_SA(1, 1), a1 + hstep, voffA);
            PG8_WAIT_V(8); PG8_WAIT_L(0); PG8_BAR; PG8_MMA(0, 0, At, B0); PG8_MMA(0, 1, At, B1); PG8_BAR; PG8_SCHED;
            PG8_LDA(At, 0, 1); PG8_STAGE(PG8_SB(0, 0), b2, voffB); PG8_STAGE(PG8_SB(0, 1), b2 + hstep, voffB); PG8_STAGE(PG8_SA(0, 0), a2, voffA);
            PG8_WAIT_V(8); PG8_WAIT_L(0); PG8_BAR; PG8_MMA(1, 0, At, B0); PG8_MMA(1, 1, At, B1); PG8_BAR; PG8_SCHED;
            PG8_LDB(B0, 1, 0); PG8_LDB(B1, 1, 1); PG8_SCHED; PG8_LDA(At, 1, 0); PG8_STAGE(PG8_SA(0, 1), a2 + hstep, voffA);
            PG8_WAIT_V(8); PG8_WAIT_L(0); PG8_BAR; PG8_MMA(0, 0, At, B0); PG8_MMA(0, 1, At, B1); PG8_BAR; PG8_SCHED;
            PG8_LDA(At, 1, 1); PG8_STAGE(PG8_SB(1, 0), b3, voffB); PG8_STAGE(PG8_SB(1, 1), b3 + hstep, voffB); PG8_STAGE(PG8_SA(1, 0), a3, voffA);
            PG8_WAIT_V(8); PG8_WAIT_L(0); PG8_BAR; PG8_MMA(1, 0, At, B0); PG8_MMA(1, 1, At, B1); PG8_BAR; PG8_SCHED;
            } else {
            PG8_LDB(B0, 0, 0); PG8_SCHED; PG8_LDA(At, 0, 0); PG8_STAGE(PG8_SA(1, 1), a1 + hstep, voffA);
            PG8_WAIT_L(8); PG8_BAR; PG8_WAIT_L(0); PG8_MMA(0, 0, At, B0); PG8_BAR; PG8_SCHED;
            PG8_LDB(B1, 0, 1); PG8_STAGE(PG8_SB(0, 0), b2, voffB);
            PG8_BAR; PG8_WAIT_L(0); PG8_MMA(0, 1, At, B1); PG8_BAR;
            PG8_LDA(At, 0, 1); PG8_STAGE(PG8_SA(0, 0), a2, voffA);
            PG8_BAR; PG8_WAIT_L(0); PG8_MMA(1, 0, At, B0); PG8_BAR; PG8_SCHED;
            PG8_STAGE(PG8_SB(0, 1), b2 + hstep, voffB);
            PG8_WAIT_V(6); PG8_BAR; PG8_MMA(1, 1, At, B1); PG8_BAR;
            PG8_LDB(B0, 1, 0); PG8_SCHED; PG8_LDA(At, 1, 0); PG8_STAGE(PG8_SA(0, 1), a2 + hstep, voffA);
            PG8_WAIT_L(8); PG8_BAR; PG8_WAIT_L(0); PG8_MMA(0, 0, At, B0); PG8_BAR; PG8_SCHED;
            PG8_LDB(B1, 1, 1); PG8_STAGE(PG8_SB(1, 0), b3, voffB);
            PG8_BAR; PG8_WAIT_L(0); PG8_MMA(0, 1, At, B1); PG8_BAR;
            PG8_LDA(At, 1, 1); PG8_STAGE(PG8_SA(1, 0), a3, voffA);
            PG8_BAR; PG8_WAIT_L(0); PG8_MMA(1, 0, At, B0); PG8_BAR; PG8_SCHED;
            PG8_STAGE(PG8_SB(1, 1), b3 + hstep, voffB);
            PG8_WAIT_V(6); PG8_BAR; PG8_MMA(1, 1, At, B1); PG8_BAR;
            }
        }
        if constexpr (ALIGN_EPI) { if (wr == 0) PG8_BAR; }
        if constexpr (!Epi::AFTER_DRAIN) { E(acc, cur, wr, wc, fr, fq); S.done(cur); }
        if (!has_next) break;
#pragma unroll
        for (int a = 0; a < 2; ++a)
#pragma unroll
            for (int b = 0; b < 2; ++b)
#pragma unroll
                for (int m = 0; m < 4; ++m)
#pragma unroll
                    for (int n = 0; n < 2; ++n) acc[a][b][m][n] = (f32x4){0.f, 0.f, 0.f, 0.f};
        cur = nxt; cA = nA; cB = nB; ++ui;
        if constexpr (ALIGN_EPI) { if (wr == 1) PG8_BAR; }
    }
    PG8_WAIT_V(0);
    if constexpr (!ALIGN_EPI) { if (wr == 0) PG8_BAR; }
    PG8_BAR;
    if constexpr (Epi::AFTER_DRAIN) { E.fused(acc, cur, wr, wc, fr, fq, lds, wid, lane); S.done(cur); }
#undef PG8_SA
#undef PG8_SB
#undef PG8_STAGE
#undef PG8_LDA
#undef PG8_LDB
#undef PG8_MMA
#undef PG8_WAIT_V
#undef PG8_WAIT_L
#undef PG8_BAR
#undef PG8_SCHED
}
}
#include <hip/hip_bf16.h>
#include <cmath>
namespace attn_body {
using bf16=__hip_bfloat16;
using bf16x8=__attribute__((ext_vector_type(8)))short;
using s16x4=__attribute__((ext_vector_type(4)))short;
using f32x16=__attribute__((ext_vector_type(16)))float;
using u32x4=__attribute__((ext_vector_type(4)))unsigned;
constexpr int BATCH=8,NHEAD=16,SEQ=4096,D=64,DM=NHEAD*D,QP=512,KP=512,VP=512,OP=1024;
constexpr int NW=8,QBLK=32,QB=QBLK*NW,KVBLK=64,NQB=SEQ/QB;
constexpr int ATTN_PITCH=DM, ATTN_UNIT_ROWS=QB;
__device__ __forceinline__ int crow(int r,int hi){return (r&3)+8*(r>>2)+4*hi;}
#define SBAR() __builtin_amdgcn_sched_barrier(0)
__device__ __forceinline__ void cmask(f32x16&p0,f32x16&p1,int jb,int qrel,int hi){
  const float NEG=-INFINITY; int kb=64*jb+4*hi;
  #pragma unroll
  for(int r=0;r<16;++r){int kv=kb+(r&3)+8*(r>>2); if(kv>qrel)p0[r]=NEG; if(kv+32>qrel)p1[r]=NEG;}
}

constexpr int NSLOT=3, SLOTB=8192;
constexpr int LDS_K=0, LDS_V=NSLOT*SLOTB, LDS_WS=2*NSLOT*SLOTB, LDS_OST=LDS_WS+NW*64*4, LDS_BYTES=LDS_OST+NW*4096;
constexpr float C2=0.125f*1.4426950408889634f;
__device__ __forceinline__ void glds16(const void*gsrc,unsigned lds_dst){unsigned keep;
  asm volatile("s_mov_b32 %0, m0\n\ts_mov_b32 m0, %2\n\ts_nop 0\n\tglobal_load_lds_dwordx4 %1, off\n\ts_mov_b32 m0, %0":"=&s"(keep):"v"(gsrc),"s"(lds_dst):"memory");}
__device__ __forceinline__ float max3f(float a,float b,float c){float r;asm("v_max3_f32 %0, %1, %2, %3":"=v"(r):"v"(a),"v"(b),"v"(c));return r;}
__device__ __forceinline__ float max2f(float a,float b){float r;asm("v_max_f32_e32 %0, %1, %2":"=v"(r):"v"(a),"v"(b));return r;}
__device__ __forceinline__ float fadd_s(float a,float b){float r;asm("v_add_f32_e32 %0, %1, %2":"=v"(r):"v"(a),"v"(b));return r;}
__device__ __forceinline__ float fsub_s(float a,float b){float r;asm("v_sub_f32_e32 %0, %1, %2":"=v"(r):"v"(a),"v"(b));return r;}
typedef float f32x2_t __attribute__((ext_vector_type(2))); typedef __bf16 bf16x2_t __attribute__((ext_vector_type(2)));
__device__ __forceinline__ unsigned cvtpk_s(float lo,float hi){f32x2_t v={lo,hi};bf16x2_t b=__builtin_convertvector(v,bf16x2_t);return __builtin_bit_cast(unsigned,b);}
#define WAIT_BAR(N) asm volatile("s_waitcnt vmcnt(" #N ") lgkmcnt(0)\n\ts_barrier":::"memory")

__device__ __forceinline__ void qkt(f32x16&p0,f32x16&p1,const char*Kslot,const bf16x8*qr,const f32x16&negm,int r32,int hi){
  const char*kb=Kslot+hi*1024+r32*16;
  #pragma unroll
  for(int d0=0;d0<4;++d0){
    const bf16x8 b0=*reinterpret_cast<const bf16x8*>(kb+d0*2048);
    const bf16x8 b1=*reinterpret_cast<const bf16x8*>(kb+d0*2048+512);
    if(d0==0){p0=__builtin_amdgcn_mfma_f32_32x32x16_bf16(b0,qr[0],negm,0,0,0);p1=__builtin_amdgcn_mfma_f32_32x32x16_bf16(b1,qr[0],negm,0,0,0);}
    else{p0=__builtin_amdgcn_mfma_f32_32x32x16_bf16(b0,qr[d0],p0,0,0,0);p1=__builtin_amdgcn_mfma_f32_32x32x16_bf16(b1,qr[d0],p1,0,0,0);}}
}
typedef __attribute__((address_space(3))) const char* lds_cptr;
typedef short v4i16_t __attribute__((ext_vector_type(4)));
__device__ __forceinline__ void kload8(bf16x8*kf,lds_cptr kp){
  kf[0]=*(const __attribute__((address_space(3))) bf16x8*)(kp);      kf[1]=*(const __attribute__((address_space(3))) bf16x8*)(kp+512);
  kf[2]=*(const __attribute__((address_space(3))) bf16x8*)(kp+2048); kf[3]=*(const __attribute__((address_space(3))) bf16x8*)(kp+2560);
  kf[4]=*(const __attribute__((address_space(3))) bf16x8*)(kp+4096); kf[5]=*(const __attribute__((address_space(3))) bf16x8*)(kp+4608);
  kf[6]=*(const __attribute__((address_space(3))) bf16x8*)(kp+6144); kf[7]=*(const __attribute__((address_space(3))) bf16x8*)(kp+6656);
}
__device__ __forceinline__ void kload2(bf16x8*kf,lds_cptr kp,int j){ kf[2*j]=*(const __attribute__((address_space(3))) bf16x8*)(kp+j*2048); kf[2*j+1]=*(const __attribute__((address_space(3))) bf16x8*)(kp+j*2048+512); }
__device__ __forceinline__ s16x4 vtr(lds_cptr p){ return __builtin_bit_cast(s16x4,__builtin_amdgcn_ds_read_tr16_b64_v4i16((__attribute__((address_space(3))) v4i16_t*)p)); }
__device__ __forceinline__ float rowmax(const f32x16&p0,const f32x16&p1){
  float a=max3f(p0[0],p0[1],p1[0]),b=max3f(p0[2],p0[3],p1[1]);a=max3f(a,p1[2],p1[3]);
  #pragma unroll
  for(int r=4;r<16;r+=4){a=max3f(a,p0[r],p0[r+1]);b=max3f(b,p0[r+2],p0[r+3]);a=max3f(a,p1[r],p1[r+1]);b=max3f(b,p1[r+2],p1[r+3]);}
  const float m=max2f(a,b);
  auto rr=__builtin_amdgcn_permlane32_swap(__float_as_uint(m),__float_as_uint(m),false,false);
  return max2f(__uint_as_float(rr[0]),__uint_as_float(rr[1]));
}
__device__ __forceinline__ void pv(f32x16*o,int vb,bf16x8 pa0,bf16x8 pa1,bf16x8 pa2,bf16x8 pa3){
  #pragma unroll
  for(int d0=0;d0<2;++d0){s16x4 lo[4],hi[4];
    #pragma unroll
    for(int ks=0;ks<4;++ks){
      asm volatile("ds_read_b64_tr_b16 %0,%1 offset:%c2":"=&v"(lo[ks]):"v"(vb),"i"(d0*4096+ks*1024):"memory");
      asm volatile("ds_read_b64_tr_b16 %0,%1 offset:%c2":"=&v"(hi[ks]):"v"(vb),"i"(d0*4096+ks*1024+512):"memory");}
    asm volatile("s_waitcnt lgkmcnt(0)":::"memory");SBAR();
    #define PK(k) (bf16x8){lo[k][0],lo[k][1],lo[k][2],lo[k][3],hi[k][0],hi[k][1],hi[k][2],hi[k][3]}
    o[d0]=__builtin_amdgcn_mfma_f32_32x32x16_bf16(pa0,PK(0),o[d0],0,0,0);
    o[d0]=__builtin_amdgcn_mfma_f32_32x32x16_bf16(pa1,PK(1),o[d0],0,0,0);
    o[d0]=__builtin_amdgcn_mfma_f32_32x32x16_bf16(pa2,PK(2),o[d0],0,0,0);
    o[d0]=__builtin_amdgcn_mfma_f32_32x32x16_bf16(pa3,PK(3),o[d0],0,0,0);
    #undef PK
  }
}

#ifndef ATTN_STORE16
#define ATTN_STORE16(p,v) (*(u32x4*)(p)=(v))
#endif
template<int THRL> __device__ __forceinline__ void attn_unit(int b,int qcol,int vcol,int ocol,int qb,const bf16*Q,const bf16*__restrict__ K,const bf16*__restrict__ V,bf16*O,char*shm){
  const int tid=__tid_l(),lane=tid&63,r32=lane&31,hi=lane>>5; const int wid=__builtin_amdgcn_readfirstlane(tid>>6);
  const long rowbase=(long)b*SEQ; const int q0=qb*QB;
  const bf16*Qw=Q+(rowbase+q0+wid*QBLK)*QP+qcol;
  const bf16*Kh=K+rowbase*KP+qcol,*Vh=V+rowbase*VP+vcol;
  const unsigned lds0=(unsigned)(uintptr_t)shm;
  float*wsf=(float*)(shm+LDS_WS)+wid*64;
  const bf16*ksrc=Kh+(long)lane*KP+wid*8;
  const bf16*vsrc=Vh+(long)(16*(wid&3)+(lane>>2))*VP+(wid>>2)*32+(lane&3)*8;
  const unsigned kdst=lds0+LDS_K+wid*1024, vdst=lds0+LDS_V+wid*1024;
  #define DMA_K(t,slot) glds16(ksrc+(long)(t)*KVBLK*KP,(unsigned)__builtin_amdgcn_readfirstlane(kdst+(slot)))
  #define DMA_V(t,slot) glds16(vsrc+(long)(t)*KVBLK*VP,(unsigned)__builtin_amdgcn_readfirstlane(vdst+(slot)))
  const int vb0=(int)(lds0+LDS_V)+((lane>>4)&1)*32+(lane&3)*8+(4*hi+((lane&15)>>2))*64;
  const char*Kbase=shm+LDS_K; bf16x8 kf[8];
  const lds_cptr shm3=(lds_cptr)shm; const lds_cptr kp0=shm3+LDS_K+hi*1024+r32*16; const lds_cptr vp0=shm3+LDS_V+((lane>>4)&1)*32+(lane&3)*8+(4*hi+((lane&15)>>2))*64;
  const int NT=(q0+QB)/KVBLK;
  DMA_K(0,0);DMA_V(0,0);DMA_K(1,SLOTB);
  bf16x8 qr[4];
  #pragma unroll
  for(int d0=0;d0<4;++d0)qr[d0]=*reinterpret_cast<const bf16x8*>(&Qw[(long)r32*QP+d0*16+hi*8]);
  float mhat=0.f,l_reg=0.f;f32x16 o[2];o[0]=f32x16{};o[1]=f32x16{};f32x16 negm=f32x16{};asm volatile("":"+v"(negm));
  const int qrel=wid*QBLK+r32;
  #define CMASK(P0,P1,t) do{int jb_=(t)-(NT-4); if(jb_>=0)cmask(P0,P1,jb_,qrel,hi);}while(0)
  bool resc=false;
  #define START(P0,P1) do{ const float rm=rowmax(P0,P1); resc=false; \
    { const float dl=rm; mhat=fadd_s(mhat,dl); \
      _Pragma("unroll") for(int r=0;r<16;++r){P0[r]=fsub_s(P0[r],dl);P1[r]=fsub_s(P1[r],dl);} \
      _Pragma("unroll") for(int r=0;r<16;++r)negm[r]=-mhat; asm volatile("":"+v"(negm)); } \
    _Pragma("unroll") for(int r=0;r<16;++r)P0[r]=__builtin_amdgcn_exp2f(P0[r]); }while(0)
  #define RESC() do{ if(resc){ asm volatile("s_waitcnt lgkmcnt(0)":::"memory"); \
      _Pragma("unroll") for(int d_=0;d_<2;++d_) _Pragma("unroll") for(int r=0;r<16;++r)o[d_][r]*=wsf[crow(r,hi)]; } }while(0)
  f32x16 pA0,pA1,pB0,pB1;
  int sl_prev=0,sl_cur=0,sl_next=SLOTB;
  #define ROT() do{sl_prev=sl_cur;sl_cur=sl_next;sl_next=(sl_next==(NSLOT-1)*SLOTB)?0:sl_next+SLOTB;}while(0)
  DMA_K(2,2*SLOTB);
  WAIT_BAR(3);
  qkt(pA0,pA1,Kbase,qr,negm,r32,hi);asm volatile("s_nop 15\n\ts_nop 7":"+v"(pA0),"+v"(pA1));CMASK(pA0,pA1,0);
  START(pA0,pA1);
  _Pragma("unroll") for(int r=0;r<16;++r)pA1[r]=__builtin_amdgcn_exp2f(pA1[r]);
  WAIT_BAR(0);
  DMA_K(3,0);DMA_V(1,SLOTB);
  ROT();
  kload8(kf,kp0+sl_cur);
  WAIT_BAR(2);
  s16x4 vlo[8],vhi[8]; u32x4 pw0,pw1,pw2,pw3;
  #define PKW(P,B) cvtpk_s(P[B],P[B+1])
  #define PAF(k) __builtin_bit_cast(bf16x8,pw##k)
  #define VFR(i) (bf16x8){vlo[i][0],vlo[i][1],vlo[i][2],vlo[i][3],vhi[i][0],vhi[i][1],vhi[i][2],vhi[i][3]}
  #define PIN(x) asm volatile("":"+v"(x))
  #define MX3(a,b,c) __builtin_fmaxf(__builtin_fmaxf((a),(b)),(c))
  #define GAPA(MF,A0,A1,A2,A3,W0,W1,PW) do{ MF; sacc+=A0; sacc+=A1; sacc+=A2; sacc+=A3; PIN(sacc); W0; W1; PIN(PW); SBAR(); }while(0)
  #define EX(v) __builtin_amdgcn_exp2f(v)
  #define GAPB(MF,X,B) do{ MF; X[B]=EX(X[B]); X[B+1]=EX(X[B+1]); X[B+2]=EX(X[B+2]); X[B+3]=EX(X[B+3]); PIN(X); SBAR(); }while(0)
  #define VRD(i) do{ vlo[i]=vtr(vp_+(((i)>>2)*4096+((i)&3)*1024)); vhi[i]=vtr(vp_+(((i)>>2)*4096+((i)&3)*1024+512)); }while(0)
  #define KRD(G,j) do{ if(G){ kload2(kf,kp0+sl_next,j); SBAR(); } }while(0)
  #define STEP(C0,C1,P0,P1,t,GK,GV,GL) do{ SBAR(); \
    const lds_cptr vp_=vp0+sl_prev; \
    VRD(0); SBAR(); float sacc=(P0[0]+P0[1]); \
    GAPA(C0=__builtin_amdgcn_mfma_f32_32x32x16_bf16(kf[0],qr[0],negm,0,0,0), P0[2],P0[3],P0[4],P0[5],     pw0[0]=PKW(P0,0), pw0[1]=PKW(P0,2), pw0); \
    VRD(4); SBAR(); GAPA(C1=__builtin_amdgcn_mfma_f32_32x32x16_bf16(kf[1],qr[0],negm,0,0,0), P0[6],P0[7],P0[8],P0[9],     pw0[2]=PKW(P0,4), pw0[3]=PKW(P0,6), pw0); \
    VRD(1); SBAR(); GAPA(C0=__builtin_amdgcn_mfma_f32_32x32x16_bf16(kf[2],qr[1],C0,0,0,0),   P0[10],P0[11],P0[12],P0[13], pw1[0]=PKW(P0,8), pw1[1]=PKW(P0,10), pw1); \
    VRD(5); SBAR(); GAPA(C1=__builtin_amdgcn_mfma_f32_32x32x16_bf16(kf[3],qr[1],C1,0,0,0),   P0[14],P0[15],P1[0],P1[1],   pw1[2]=PKW(P0,12),pw1[3]=PKW(P0,14), pw1); \
    VRD(2); SBAR(); GAPA(C0=__builtin_amdgcn_mfma_f32_32x32x16_bf16(kf[4],qr[2],C0,0,0,0),   P1[2],P1[3],P1[4],P1[5],     pw2[0]=PKW(P1,0), pw2[1]=PKW(P1,2), pw2); \
    VRD(6); SBAR(); GAPA(C1=__builtin_amdgcn_mfma_f32_32x32x16_bf16(kf[5],qr[2],C1,0,0,0),   P1[6],P1[7],P1[8],P1[9],     pw2[2]=PKW(P1,4), pw2[3]=PKW(P1,6), pw2); \
    VRD(3); SBAR(); GAPA(C0=__builtin_amdgcn_mfma_f32_32x32x16_bf16(kf[6],qr[3],C0,0,0,0),   P1[10],P1[11],P1[12],P1[13], pw3[0]=PKW(P1,8), pw3[1]=PKW(P1,10), pw3); \
    VRD(7); SBAR(); GAPA(C1=__builtin_amdgcn_mfma_f32_32x32x16_bf16(kf[7],qr[3],C1,0,0,0),   P1[14],P1[15],0.f,0.f,       pw3[2]=PKW(P1,12),pw3[3]=PKW(P1,14), pw3); \
    l_reg+=sacc; \
    if(GK){DMA_K((t)+3,sl_cur);} if(GV){DMA_V((t)+1,sl_next);} \
    CMASK(C0,C1,t); \
    { float a=MX3(C0[0],C0[1],C1[0]),b=MX3(C0[2],C0[3],C1[1]); a=MX3(a,C1[2],C1[3]); \
      _Pragma("unroll") for(int r=4;r<16;r+=4){a=MX3(a,C0[r],C0[r+1]);b=MX3(b,C0[r+2],C0[r+3]);a=MX3(a,C1[r],C1[r+1]);b=MX3(b,C1[r+2],C1[r+3]);} \
      float rm=__builtin_fmaxf(a,b); { auto rr=__builtin_amdgcn_permlane32_swap(__float_as_uint(rm),__float_as_uint(rm),false,false); rm=__builtin_fmaxf(__uint_as_float(rr[0]),__uint_as_float(rr[1])); } \
      resc=false; \
      if(__builtin_expect(__any(rm>(float)THRL),0)){ const float dl=__builtin_fmaxf(rm,0.f); mhat+=dl; \
        _Pragma("unroll") for(int r=0;r<16;++r){C0[r]-=dl;C1[r]-=dl;} \
        _Pragma("unroll") for(int r=0;r<16;++r)negm[r]=-mhat; asm volatile("":"+v"(negm)); \
        const float f=__builtin_amdgcn_exp2f(-dl); l_reg*=f; if(hi==0)wsf[r32]=f; resc=true; } } \
    SBAR(); \
    GAPB(o[0]=__builtin_amdgcn_mfma_f32_32x32x16_bf16(PAF(0),VFR(0),o[0],0,0,0), C0,0); \
    GAPB(o[1]=__builtin_amdgcn_mfma_f32_32x32x16_bf16(PAF(0),VFR(4),o[1],0,0,0), C0,4); \
    KRD(GL,0); GAPB(o[0]=__builtin_amdgcn_mfma_f32_32x32x16_bf16(PAF(1),VFR(1),o[0],0,0,0), C0,8); \
    KRD(GL,1); GAPB(o[1]=__builtin_amdgcn_mfma_f32_32x32x16_bf16(PAF(1),VFR(5),o[1],0,0,0), C0,12); \
    KRD(GL,2); GAPB(o[0]=__builtin_amdgcn_mfma_f32_32x32x16_bf16(PAF(2),VFR(2),o[0],0,0,0), C1,0); \
    KRD(GL,3); GAPB(o[1]=__builtin_amdgcn_mfma_f32_32x32x16_bf16(PAF(2),VFR(6),o[1],0,0,0), C1,4); \
    GAPB(o[0]=__builtin_amdgcn_mfma_f32_32x32x16_bf16(PAF(3),VFR(3),o[0],0,0,0), C1,8); \
    GAPB(o[1]=__builtin_amdgcn_mfma_f32_32x32x16_bf16(PAF(3),VFR(7),o[1],0,0,0), C1,12); \
    }while(0)
  int t=1;
  #undef CMASK
  #define CMASK(P0,P1,t) do{}while(0)
  for(;t+5<NT;t+=2){
    STEP(pB0,pB1,pA0,pA1,t,true,true,true);     WAIT_BAR(2); RESC(); ROT();
    STEP(pA0,pA1,pB0,pB1,t+1,true,true,true);   WAIT_BAR(2); RESC(); ROT();
  }
  #undef CMASK
  #define CMASK(P0,P1,t) do{int jb_=(t)-(NT-4); if(jb_>=0)cmask(P0,P1,jb_,qrel,hi);}while(0)
  #define ENDW(tt) do{ if((tt)+3<NT){WAIT_BAR(2);} else if((tt)+2<NT){WAIT_BAR(1);} else {WAIT_BAR(0);} }while(0)
  for(;t+1<NT;t+=2){
    STEP(pB0,pB1,pA0,pA1,t,(t+3<NT),(t+1<NT),(t+1<NT));       ENDW(t);   RESC(); ROT();
    STEP(pA0,pA1,pB0,pB1,t+1,(t+4<NT),(t+2<NT),(t+2<NT));     ENDW(t+1); RESC(); ROT();
  }
  STEP(pB0,pB1,pA0,pA1,NT-1,false,false,false); RESC();
  { float sacc=pB0[0]+pB0[1]; _Pragma("unroll") for(int r=2;r<16;++r)sacc+=pB0[r]; _Pragma("unroll") for(int r=0;r<16;++r)sacc+=pB1[r]; l_reg+=sacc;
    pw0=(u32x4){PKW(pB0,0),PKW(pB0,2),PKW(pB0,4),PKW(pB0,6)};pw1=(u32x4){PKW(pB0,8),PKW(pB0,10),PKW(pB0,12),PKW(pB0,14)};pw2=(u32x4){PKW(pB1,0),PKW(pB1,2),PKW(pB1,4),PKW(pB1,6)};pw3=(u32x4){PKW(pB1,8),PKW(pB1,10),PKW(pB1,12),PKW(pB1,14)};
    SBAR(); pv(o,vb0+sl_cur,PAF(0),PAF(1),PAF(2),PAF(3)); }
  #undef PKW
  #undef PAF
  #undef VFR
  #undef PIN
  #undef MX3
  #undef GAPA
  #undef GAPB
  #undef EX
  #undef VRD
  #undef KRD
  #undef STEP
  #undef ENDW
  {auto rr=__builtin_amdgcn_permlane32_swap(__float_as_uint(l_reg),__float_as_uint(l_reg),false,false);l_reg=__uint_as_float(rr[0])+__uint_as_float(rr[1]);}
  if(hi==0)wsf[32+r32]=l_reg;asm volatile("s_waitcnt lgkmcnt(0)":::"memory");
  float rli[16];
  #pragma unroll
  for(int r=0;r<16;++r)rli[r]=__builtin_amdgcn_rcpf(wsf[32+crow(r,hi)]);
  bf16*Ow=O+(rowbase+q0+wid*QBLK)*OP+ocol;
  { bf16*stg=(bf16*)(shm+LDS_OST)+wid*2048;
    #pragma unroll
    for(int r=0;r<16;++r){const int orow=crow(r,hi);
      #pragma unroll
      for(int d0=0;d0<2;++d0)stg[orow*64+d0*32+r32]=__float2bfloat16(o[d0][r]*rli[r]);}
    asm volatile("s_waitcnt lgkmcnt(0)":::"memory");
    #pragma unroll
    for(int i=0;i<4;++i){const int row=i*8+(lane>>3),ch=lane&7; const u32x4 v=*(const u32x4*)(stg+row*64+ch*8); ATTN_STORE16(Ow+(long)row*OP+ch*8,v);} }
  asm volatile("s_waitcnt lgkmcnt(0)\n\ts_barrier":::"memory");
  #undef DMA_K
  #undef DMA_V
  #undef CMASK
  #undef START
  #undef RESC
  #undef ROT
}
#undef SBAR
#undef WAIT_BAR
}
namespace cg = cooperative_groups;
#define LAS __attribute__((address_space(3)))
typedef unsigned short bf16;
typedef unsigned v4u __attribute__((ext_vector_type(4)));
typedef unsigned v2u __attribute__((ext_vector_type(2)));
typedef float f32x4 __attribute__((ext_vector_type(4)));
typedef float f32x16 __attribute__((ext_vector_type(16)));
typedef short bf16x8 __attribute__((ext_vector_type(8)));

constexpr int NB = 8, SEQ = 4096, DM = 1024, TOK = NB * SEQ, FF = 2816, NIN = 3592, NINP = 3584, NMOD = 9216;
constexpr size_t MiB = 1u << 20;
constexpr size_t WS_CTL = 0, WS_MOD = 64 * 1024, WS_ROPE = 512 * 1024, WS_GATES = 1 * MiB;
constexpr size_t WS_W12A = 2 * MiB, WS_W3A = 13 * MiB, WS_W12B = 19 * MiB, WS_W3B = 30 * MiB, WS_WIN = 36 * MiB, WS_WOUT = 43 * MiB;
constexpr size_t WS_HN = 48 * MiB, WS_HID = 112 * MiB;
constexpr size_t WS_Q = WS_HID, WS_K = WS_HID + 32 * MiB, WS_V = WS_HID + 64 * MiB, WS_MLQK = WS_HID + 96 * MiB;
constexpr size_t WS_MLV = 288 * MiB, WS_MLO = 320 * MiB, WS_AO = 352 * MiB, WS_MLH = 416 * MiB, WS_IMGB = 448 * MiB, WS_END = 512 * MiB;
constexpr size_t WS_RSS = 47 * MiB, WS_SB3 = 47 * MiB + 256 * 1024, WS_XG3 = WS_AO;
constexpr size_t WS_BP = 45 * MiB, WS_RK = 46 * MiB, WS_IMGA = WS_HN;
constexpr int LDS_BYTES = 147456, MISC_OFF = 131072 + 320;
constexpr float C2Q = 0.125f * 1.4426950408889634f;

__device__ __forceinline__ unsigned f2bf(float f) { unsigned u = __builtin_bit_cast(unsigned, f); return (u + 0x7fffu + ((u >> 16) & 1u)) >> 16; }
__device__ __forceinline__ unsigned pk2(float lo, float hi) { return pg8::cvt_pk_bf16(lo, hi); }
__device__ __forceinline__ float bflo(unsigned u) { return __builtin_bit_cast(float, u << 16); }
__device__ __forceinline__ float bfhi(unsigned u) { return __builtin_bit_cast(float, u & 0xffff0000u); }
__device__ __forceinline__ float wave_sum(float v) {
#pragma unroll
    for (int o = 1; o < 64; o <<= 1) v += __shfl_xor(v, o);
    return v;
}
#define LDS_WAIT() asm volatile("s_waitcnt lgkmcnt(0)" ::: "memory")

#define XB_TMO      128
#define XB_XCNT(j)  (256  + 64 * (j))
#define XB_XSUB(j)  (1280 + 64 * (j))
#define XB_XGEN(j)  (2304 + 64 * (j))
#define XB_TOP      3328
#define XB_TOPGEN   3392
#define XCD_BAR_WORDS 3456
#define XB_SPIN_CAP (1u << 18)

__device__ __forceinline__ unsigned xb_ld(unsigned* p)              { return __hip_atomic_load(p, __ATOMIC_RELAXED, __HIP_MEMORY_SCOPE_AGENT); }
__device__ __forceinline__ unsigned xb_add(unsigned* p, unsigned v) { return __hip_atomic_fetch_add(p, v, __ATOMIC_RELAXED, __HIP_MEMORY_SCOPE_AGENT); }
__device__ __forceinline__ unsigned xb_xcc_id() { return (unsigned)__builtin_amdgcn_s_getreg((3 << 11) | 20) & 0xFu; }
#define XB_SPIN(cond, bar) do { unsigned _sp = 0; while (cond) { __builtin_amdgcn_s_sleep(1); \
    if ((++_sp & 255u) == 0u) { if (xb_ld(&(bar)[XB_TMO])) break; if (_sp > XB_SPIN_CAP) { atomicAdd(&(bar)[XB_TMO], 1u); break; } } } } while (0)

struct XcdBarrier {
    unsigned* bar; unsigned x;
    volatile LAS unsigned* st;
};

__device__ __forceinline__ XcdBarrier xcd_barrier_post(unsigned* bar, volatile LAS unsigned* st) {
    XcdBarrier b; b.bar = bar; b.x = xb_xcc_id(); b.st = st;
    if (threadIdx.x == 0) (void)xb_add(&bar[XB_XCNT(b.x)], 1u);
    return b;
}
__device__ __forceinline__ void xcd_barrier_complete(unsigned* bar, unsigned x, unsigned& nloc, unsigned& nx) {
    const unsigned G = gridDim.x * gridDim.y * gridDim.z;
    unsigned sum, cnt, mine, sp = 0u;
    for (;;) {
        sum = 0u; cnt = 0u; mine = 0u;
#pragma unroll
        for (unsigned j = 0; j < 16; ++j) { const unsigned c = xb_ld(&bar[XB_XCNT(j)]); sum += c; cnt += (c > 0u) ? 1u : 0u; mine = (j == x) ? c : mine; }
        if (sum == G) break;
        __builtin_amdgcn_s_sleep(1);
        if ((++sp & 255u) == 0u) { if (xb_ld(&bar[XB_TMO])) break; if (sp > XB_SPIN_CAP) { atomicAdd(&bar[XB_TMO], 1u); break; } }
    }
    nloc = mine > 0u ? mine : 1u; nx = cnt > 0u ? cnt : 1u;
}

__device__ __forceinline__ void xcd_barrier(const XcdBarrier& b) {
    asm volatile("s_waitcnt vmcnt(0)" ::: "memory");
    __syncthreads();
    if (threadIdx.x == 0) {
        unsigned* bar = b.bar;
        __builtin_amdgcn_s_waitcnt(0);
        unsigned nloc = b.st[0], nx = b.st[1];
        if (nloc == 0u) { xcd_barrier_complete(bar, b.x, nloc, nx); b.st[0] = nloc; b.st[1] = nx; }
        const unsigned old = xb_add(&bar[XB_XSUB(b.x)], 1u);
        const unsigned gen = old / nloc;
        if (old + 1u == (gen + 1u) * nloc) {
            __builtin_amdgcn_fence(__ATOMIC_RELEASE, "agent");
            asm volatile("s_waitcnt vmcnt(0)" ::: "memory");
            const unsigned og = xb_add(&bar[XB_TOP], 1u);
            const unsigned tg = og / nx;
            if (og + 1u == (tg + 1u) * nx) xb_add(&bar[XB_TOPGEN], 1u);
            else XB_SPIN(xb_ld(&bar[XB_TOPGEN]) == tg, bar);
            __builtin_amdgcn_fence(__ATOMIC_ACQUIRE, "agent");
            xb_add(&bar[XB_XGEN(b.x)], 1u);
            asm volatile("s_waitcnt vmcnt(0)" ::: "memory");
        } else {
            XB_SPIN(xb_ld(&bar[XB_XGEN(b.x)]) == gen, bar);
            __builtin_amdgcn_fence(__ATOMIC_ACQUIRE, "agent");
            asm volatile("s_waitcnt vmcnt(0)" ::: "memory");
        }
    }
    __syncthreads();
}


struct Args { const float* in[20]; float* out; unsigned char* ws; int ph_lo, ph_hi; };
enum { I_X = 0, I_C, I_WADA, I_BADA, I_GNORM, I_F1W12, I_F1W3, I_WIN, I_CONVW, I_CONVB, I_BIG, I_BFG, I_GQ, I_GK, I_LAMQK, I_GDA, I_GML, I_WOUT, I_F2W12, I_F2W3 };

__device__ __forceinline__ void transpose_item(const float* W, int K, int ldw, int nsrc0, bf16* WT, int ndst0, LAS float* scr, int k0, int lane) {
#pragma unroll 8
    for (int i = 0; i < 32; ++i) { const int kk = 2 * i + (lane >> 5); scr[kk * 33 + (lane & 31)] = W[(size_t)(k0 + kk) * ldw + nsrc0 + (lane & 31)]; }
    LDS_WAIT();
    const int c = lane & 7;
#pragma unroll
    for (int j = 0; j < 4; ++j) { const int n = (lane >> 3) + 8 * j; const LAS float* s = scr + (8 * c) * 33 + n;
        v4u o; o.x = pk2(s[0 * 33], s[1 * 33]); o.y = pk2(s[2 * 33], s[3 * 33]); o.z = pk2(s[4 * 33], s[5 * 33]); o.w = pk2(s[6 * 33], s[7 * 33]);
        *(v4u*)(WT + (size_t)(ndst0 + n) * K + k0 + 8 * c) = o; }
    LDS_WAIT();
}
__device__ __forceinline__ void p0_prologue(const Args& a, LAS unsigned char* lds) {
    const int tid = __tid_l(), lane = tid & 63, wave = __builtin_amdgcn_readfirstlane(tid >> 6), G = gridDim.x, bx = blockIdx.x;
    unsigned char* ws = a.ws;
    if (bx == 0 && tid < 64) ((unsigned*)(ws + WS_CTL))[tid * 64] = 0u;
    for (int i = bx * 512 + tid; i < TOK; i += G * 512) ((float*)(ws + WS_RSS))[i] = 0.f;
    {
        LAS float* sc = (LAS float*)lds;
        LAS float* red = (LAS float*)(lds + 32768);
        const float* c = a.in[I_C];
        for (int i = tid; i < 8192; i += 512) { const int b = i >> 10, k = i & 1023; const float v = c[i]; sc[k * 8 + b] = v / (1.0f + __expf(-v)); }
        __syncthreads();
        const float* wada = a.in[I_WADA]; const float* bada = a.in[I_BADA]; float* mod = (float*)(ws + WS_MOD);
        for (int jb = bx; jb < 256; jb += G) {
            const int j0 = jb * 36; float acc[8];
#pragma unroll
            for (int b = 0; b < 8; ++b) acc[b] = 0.f;
            if (lane < 36) {
                const float* wp = wada + (size_t)(wave * 128) * NMOD + j0 + lane;
#pragma unroll 32
                for (int k = 0; k < 128; ++k) {
                    const float wv = wp[(size_t)k * NMOD];
                    const f32x4 s0 = *(const LAS f32x4*)(sc + (wave * 128 + k) * 8), s1 = *(const LAS f32x4*)(sc + (wave * 128 + k) * 8 + 4);
                    acc[0] += wv * s0[0]; acc[1] += wv * s0[1]; acc[2] += wv * s0[2]; acc[3] += wv * s0[3];
                    acc[4] += wv * s1[0]; acc[5] += wv * s1[1]; acc[6] += wv * s1[2]; acc[7] += wv * s1[3];
                }
#pragma unroll
                for (int b = 0; b < 8; ++b) red[(wave * 8 + b) * 36 + lane] = acc[b];
            }
            __syncthreads();
            if (tid < 288) { const int b = tid / 36, j = tid % 36; float s = bada[j0 + j];
#pragma unroll
                for (int w = 0; w < 8; ++w) s += red[(w * 8 + b) * 36 + j];
                mod[(size_t)b * NMOD + j0 + j] = s; }
            __syncthreads();
        }
    }
    {
        float* rope = (float*)(ws + WS_ROPE);
        for (int e = bx * 512 + tid; e < SEQ * 8; e += G * 512) {
            const int pos = e >> 3, i = e & 7;
            const float invf = powf(500000.0f, -(float)i * 0.125f);
            const float ang = (float)pos * invf;
            const double k = rint((double)ang * 0.15915494309189535);
            const float r = (float)((double)ang - k * 6.283185307179586);
            rope[2 * e] = cosf(r); rope[2 * e + 1] = sinf(r);
        }
    }
    {
        LAS float* scr = (LAS float*)(lds + wave * 16384);
        const int gw = bx * 8 + wave, NGW = G * 8;
        constexpr int I_12 = 16 * 176, I_3 = 44 * 32, I_IN = 16 * 112, I_O = 16 * 32, NITEMS = 2 * I_12 + 2 * I_3 + I_IN + I_O;
        for (int it = gw; it < NITEMS; it += NGW) {
            int r = it;
            if (r < 2 * I_12) {
                const int which = r >= I_12; r -= which * I_12; const int kb = r / 176, nb = r % 176, n0 = nb * 32;
                const int src = ((n0 >> 7) & 1) * FF + (n0 >> 8) * 128 + (n0 & 127);
                transpose_item(a.in[which ? I_F2W12 : I_F1W12], 1024, 2 * FF, src, (bf16*)(ws + (which ? WS_W12B : WS_W12A)), n0, scr, kb * 64, lane); continue; }
            r -= 2 * I_12;
            if (r < 2 * I_3) { const int which = r >= I_3; r -= which * I_3; const int kb = r / 32, nb = r % 32;
                transpose_item(a.in[which ? I_F2W3 : I_F1W3], FF, 1024, nb * 32, (bf16*)(ws + (which ? WS_W3B : WS_W3A)), nb * 32, scr, kb * 64, lane); continue; }
            r -= 2 * I_3;
            if (r < I_IN) { const int kb = r / 112, nb = r % 112, n0 = nb * 32;
                const int src = (n0 & ~255) + ((n0 >> 5) & 3) * 64 + ((n0 >> 7) & 1) * 32;
                transpose_item(a.in[I_WIN], 1024, NIN, src, (bf16*)(ws + WS_WIN), n0, scr, kb * 64, lane); continue; }
            r -= I_IN;
            { const int kb = r / 32, nb = r % 32; transpose_item(a.in[I_WOUT], 1024, 1024, nb * 32, (bf16*)(ws + WS_WOUT), nb * 32, scr, kb * 64, lane); }
        }
    }
}

template <bool GATES, bool XBF>
__device__ __forceinline__ void norm_phase(const Args& a, const void* xin_, int sub, LAS unsigned char* lds) {
    const int tid = __tid_l(), lane = tid & 63, wave = __builtin_amdgcn_readfirstlane(tid >> 6), G = gridDim.x, bx = blockIdx.x;
    bf16* hn = (bf16*)(a.ws + WS_HN); const float* mod = (const float*)(a.ws + WS_MOD); float* gates = (float*)(a.ws + WS_GATES);
    const float* gn = a.in[I_GNORM] + sub * 1024;
    f32x4 wlo[GATES ? 16 : 1], whi[GATES ? 16 : 1];
    if (GATES) {
        const float* win = a.in[I_WIN];
#pragma unroll
        for (int j = 0; j < 4; ++j)
#pragma unroll
            for (int e = 0; e < 4; ++e) { const float* wp = win + (size_t)(256 * j + 4 * lane + e) * NIN + NINP; wlo[4 * j + e] = *(const f32x4*)wp; whi[4 * j + e] = *(const f32x4*)(wp + 4); }
    }
    const int gw = bx * 8 + wave, NGW = G * 8;
    if (!GATES && !XBF) {
        const bf16* Wt = (const bf16*)(a.ws + WS_W12B); float* sb = (float*)(a.ws + WS_SB3);
        for (int n = gw; n < 2 * FF; n += NGW) {
            float wv[16];
#pragma unroll
            for (int j = 0; j < 4; ++j) { const v2u w = *(const v2u*)(Wt + (size_t)n * 1024 + 256 * j + 4 * lane); wv[4 * j] = bflo(w.x); wv[4 * j + 1] = bfhi(w.x); wv[4 * j + 2] = bflo(w.y); wv[4 * j + 3] = bfhi(w.y); }
#pragma unroll
            for (int b = 0; b < 8; ++b) { const float* sh = mod + (size_t)b * NMOD + 6 * 1024 + 4 * lane; float s = 0.f;
#pragma unroll
                for (int j = 0; j < 4; ++j) { const f32x4 sv = *(const f32x4*)(sh + 256 * j); s += (wv[4 * j] * sv[0] + wv[4 * j + 1] * sv[1]) + (wv[4 * j + 2] * sv[2] + wv[4 * j + 3] * sv[3]); }
                s = wave_sum(s);
                if (lane == 0) sb[(size_t)b * (2 * FF) + n] = s; }
        }
    }
    for (int rb = gw; rb < TOK / 16; rb += NGW) {
        const int row0 = rb * 16, b = row0 >> 12;
        const float* mb = mod + (size_t)b * NMOD + sub * 3072;
        f32x4 gs[4], sh[4];
#pragma unroll
        for (int j = 0; j < 4; ++j) { const int col = 256 * j + 4 * lane; gs[j] = *(const f32x4*)(gn + col) * (*(const f32x4*)(mb + 1024 + col) + 1.0f); sh[j] = *(const f32x4*)(mb + col); }
#pragma unroll 2
        for (int r = 0; r < 16; ++r) {
            f32x4 v[4]; float ss = 0.f;
#pragma unroll
            for (int j = 0; j < 4; ++j) {
                if (XBF) { const v2u w = *(const v2u*)((const bf16*)xin_ + (size_t)(row0 + r) * 1024 + 4 * lane + 256 * j); v[j] = (f32x4){bflo(w.x), bfhi(w.x), bflo(w.y), bfhi(w.y)}; }
                else v[j] = *(const f32x4*)((const float*)xin_ + (size_t)(row0 + r) * 1024 + 4 * lane + 256 * j);
                ss += (v[j][0] * v[j][0] + v[j][1] * v[j][1]) + (v[j][2] * v[j][2] + v[j][3] * v[j][3]); }
            const float rinv = 1.0f / sqrtf(wave_sum(ss) * (1.0f / 1024.0f) + 1e-6f);
            bf16* orow = hn + (size_t)(row0 + r) * 1024 + 4 * lane;
#pragma unroll
            for (int j = 0; j < 4; ++j) { v[j] = v[j] * rinv * gs[j] + sh[j]; v2u o; o.x = pk2(v[j][0], v[j][1]); o.y = pk2(v[j][2], v[j][3]); *(v2u*)(orow + 256 * j) = o; }
            if (GATES) {
                f32x4 glo = (f32x4){0.f, 0.f, 0.f, 0.f}, ghi = (f32x4){0.f, 0.f, 0.f, 0.f};
#pragma unroll
                for (int j = 0; j < 4; ++j)
#pragma unroll
                    for (int e = 0; e < 4; ++e) { glo += wlo[4 * j + e] * v[j][e]; ghi += whi[4 * j + e] * v[j][e]; }
                const bool u32_ = (lane & 32) != 0, u16_ = (lane & 16) != 0, u8_ = (lane & 8) != 0;
                f32x4 keep = u32_ ? ghi : glo; const f32x4 send = u32_ ? glo : ghi;
#pragma unroll
                for (int e = 0; e < 4; ++e) keep[e] += __shfl_xor(send[e], 32);
                float k20 = u16_ ? keep[2] : keep[0], k21 = u16_ ? keep[3] : keep[1]; const float s20 = u16_ ? keep[0] : keep[2], s21 = u16_ ? keep[1] : keep[3];
                k20 += __shfl_xor(s20, 16); k21 += __shfl_xor(s21, 16);
                float k1 = u8_ ? k21 : k20; const float s1 = u8_ ? k20 : k21;
                k1 += __shfl_xor(s1, 8);
                k1 += __shfl_xor(k1, 4); k1 += __shfl_xor(k1, 2); k1 += __shfl_xor(k1, 1);
                if ((lane & 7) == 0) gates[(size_t)(row0 + r) * 8 + (lane >> 3)] = k1;
            }
        }
    }
}

namespace ml {
constexpr int QP = 136, SP = 72;
constexpr int L_QS = 0, L_KS = 17408, LP_EP = 71680;
constexpr int L_VS = 33792, L_WS = 41984, L_CT = 51200, L_N = 68608, L_QN = 69120, L_RS = 69376, L_RK = 69888, L_G = 70400, GSTRIDE = 1024, L_BPL = 72448;
typedef short v4i16_t __attribute__((ext_vector_type(4)));
__device__ __forceinline__ bf16x8 tr_frag(const LAS unsigned char* p0, const LAS unsigned char* p1) {
    const v4i16_t lo = __builtin_amdgcn_ds_read_tr16_b64_v4i16((LAS v4i16_t*)p0), hi = __builtin_amdgcn_ds_read_tr16_b64_v4i16((LAS v4i16_t*)p1);
    return (bf16x8){lo[0], lo[1], lo[2], lo[3], hi[0], hi[1], hi[2], hi[3]};
}
__device__ __forceinline__ float scan_add(float v, int lane) {
#pragma unroll
    for (int o = 1; o < 64; o <<= 1) { const float t = __shfl_up(v, o); if (lane >= o) v += t; }
    return v;
}
__device__ __forceinline__ float scan_max(float v, int lane) {
#pragma unroll
    for (int o = 1; o < 64; o <<= 1) { const float t = __shfl_up(v, o); if (lane >= o) v = fmaxf(v, t); }
    return v;
}
}

__device__ __forceinline__ void mlprep_phase(const Args& a, LAS unsigned char* lds) {
    using namespace ml;
    const int tid = __tid_l(), lane = tid & 63, wave = __builtin_amdgcn_readfirstlane(tid >> 6), G = gridDim.x, bx = blockIdx.x;
    const bf16* MLQK = (const bf16*)(a.ws + WS_MLQK);
    LAS bf16* Qs = (LAS bf16*)(lds + L_QS); LAS bf16* Ks = (LAS bf16*)(lds + L_KS); LAS float* EP = (LAS float*)(lds + LP_EP); LAS float* RP = (LAS float*)(lds + LP_EP + 1024);
    const int cg_ = tid & 31, rg = tid >> 5; const bool isq = cg_ < 16;
#define PP_BAR() asm volatile("s_waitcnt lgkmcnt(0)\n\ts_barrier" ::: "memory")
    v4u uq[7]; float gi_ = 0.f, gf_ = 0.f; int hprev = -1;
    float cw[4][8], cb[8];
#define PP_LOAD(it_) do { const int bh_ = (it_) >> 6, c_ = (it_) & 63, b_ = bh_ >> 2, h_ = bh_ & 3; \
        const int colq_ = isq ? (h_ * 128 + cg_ * 8) : (512 + h_ * 128 + (cg_ - 16) * 8); const bf16* qkb_ = MLQK + (size_t)b_ * SEQ * 1024 + colq_; const int t0_ = c_ * 64 + rg * 4 - 3; \
        _Pragma("unroll") for (int i = 0; i < 7; ++i) { const int t_ = t0_ + i; uq[i] = *(const v4u*)(qkb_ + (size_t)(t_ < 0 ? 0 : t_) * 1024); if (t_ < 0) uq[i] = (v4u){0u, 0u, 0u, 0u}; } \
        if (wave == 0) { const float* gp_ = (const float*)(a.ws + WS_GATES) + ((size_t)b_ * SEQ + c_ * 64 + lane) * 8; gi_ = gp_[h_]; gf_ = gp_[4 + h_]; } } while (0)
    if (bx < 2048) PP_LOAD(bx);
    for (int it = bx; it < 2048; it += G) {
        const int bh = it >> 6, c = it & 63, b = bh >> 2, h = bh & 3;
        if (h != hprev) {
            const int colq = isq ? (h * 128 + cg_ * 8) : (512 + h * 128 + (cg_ - 16) * 8);
#pragma unroll
            for (int j = 0; j < 4; ++j) { const f32x4 w0 = *(const f32x4*)(a.in[I_CONVW] + j * 1024 + colq), w1 = *(const f32x4*)(a.in[I_CONVW] + j * 1024 + colq + 4);
                cw[j][0] = w0[0]; cw[j][1] = w0[1]; cw[j][2] = w0[2]; cw[j][3] = w0[3]; cw[j][4] = w1[0]; cw[j][5] = w1[1]; cw[j][6] = w1[2]; cw[j][7] = w1[3]; }
            { const f32x4 w0 = *(const f32x4*)(a.in[I_CONVB] + colq), w1 = *(const f32x4*)(a.in[I_CONVB] + colq + 4);
              cb[0] = w0[0]; cb[1] = w0[1]; cb[2] = w0[2]; cb[3] = w0[3]; cb[4] = w1[0]; cb[5] = w1[1]; cb[6] = w1[2]; cb[7] = w1[3]; }
            hprev = h;
        }
        if (wave == 0) {
            const float ig = gi_ + a.in[I_BIG][h], fg = gf_ + a.in[I_BFG][h];
            const float fl = fminf(fg, 0.f) - log1pf(__expf(-fabsf(fg)));
            const float bb = scan_add(fl, lane), p = ig - bb;
            EP[lane] = __expf(p);
            float* bpo = (float*)(a.ws + WS_BP) + ((size_t)bh * SEQ + c * 64 + lane) * 2; bpo[0] = bb; bpo[1] = p;
        }
        PP_BAR();
#pragma unroll
        for (int r = 0; r < 4; ++r) { float o[8];
#pragma unroll
            for (int i = 0; i < 8; ++i) o[i] = cb[i];
#pragma unroll
            for (int j = 0; j < 4; ++j) { const v4u u_ = uq[r + j];
                o[0] += cw[j][0] * bflo(u_.x); o[1] += cw[j][1] * bfhi(u_.x); o[2] += cw[j][2] * bflo(u_.y); o[3] += cw[j][3] * bfhi(u_.y);
                o[4] += cw[j][4] * bflo(u_.z); o[5] += cw[j][5] * bfhi(u_.z); o[6] += cw[j][6] * bflo(u_.w); o[7] += cw[j][7] * bfhi(u_.w); }
            const int t_ = rg * 4 + r;
            const float qs_ = isq ? 0.08838834764831845f : EP[t_];
#pragma unroll
            for (int i = 0; i < 8; ++i) o[i] = o[i] * __builtin_amdgcn_rcpf(1.0f + __builtin_amdgcn_exp2f(-1.4426950408889634f * o[i])) * qs_;
            v4u w_; w_.x = pk2(o[0], o[1]); w_.y = pk2(o[2], o[3]); w_.z = pk2(o[4], o[5]); w_.w = pk2(o[6], o[7]);
            if (isq) *(LAS v4u*)(Qs + t_ * QP + cg_ * 8) = w_; else *(LAS v4u*)(Ks + t_ * QP + (cg_ - 16) * 8) = w_;
        }
        if (it + G < 2048) PP_LOAD(it + G);
        PP_BAR();
        { bf16* ga = (bf16*)(a.ws + WS_IMGA) + (size_t)it * 16384;
#pragma unroll
          for (int k = 0; k < 2; ++k) { const int idx = tid + 512 * k, row = idx >> 4, ch = idx & 15;
              *(v4u*)(ga + idx * 8) = *(const LAS v4u*)(Qs + row * QP + ch * 8); *(v4u*)(ga + 8192 + idx * 8) = *(const LAS v4u*)(Ks + row * QP + ch * 8); }
          { const int d = tid & 127, sq = tid >> 7; float s = 0.f;
#pragma unroll
            for (int k = 0; k < 16; ++k) s += __builtin_bit_cast(float, (unsigned)Ks[(sq * 16 + k) * QP + d] << 16);
            RP[sq * 128 + d] = s; }
        }
        PP_BAR();
        if (tid < 128) ((float*)(a.ws + WS_RK))[(size_t)it * 128 + tid] = (RP[tid] + RP[128 + tid]) + (RP[256 + tid] + RP[384 + tid]);
        PP_BAR();
    }
#undef PP_BAR
#undef PP_LOAD
}

__device__ __forceinline__ void mlstm_item(const Args& a, int item, LAS unsigned char* lds) {
    using namespace ml;
    const int tid = __tid_l(), lane = tid & 63, wave = __builtin_amdgcn_readfirstlane(tid >> 6), l31 = lane & 31, g = lane >> 5;
    const int b = item >> 3, h = (item >> 1) & 3, half = item & 1, bh = b * 4 + h;
    const bf16* imgA = (const bf16*)(a.ws + WS_IMGA) + (size_t)bh * 64 * 16384 + tid * 8;
    const bf16* vsrc = (const bf16*)(a.ws + WS_MLV) + ((size_t)b * SEQ + (tid >> 3)) * 512 + h * 128 + half * 64 + (tid & 7) * 8;
    const float* bp = (const float*)(a.ws + WS_BP) + (size_t)bh * SEQ * 2;
    const float* rkg = (const float*)(a.ws + WS_RK) + (size_t)bh * 64 * 128;
    bf16* h_base = (bf16*)(a.ws + WS_MLH) + (size_t)b * SEQ * 512 + h * 128 + half * 64;

    LAS bf16* Qs = (LAS bf16*)(lds + L_QS); LAS bf16* Ws = (LAS bf16*)(lds + L_WS); LAS bf16* CT = (LAS bf16*)(lds + L_CT);
    LAS unsigned char* KsB = lds + L_KS; LAS unsigned char* VsB = lds + L_VS;
    const int li_ = lane & 15, tq_ = li_ >> 2, tp_ = li_ & 3, tc16_ = (lane >> 4) & 1;
    const int vtrb = 1024 * g + 64 * tq_ + 16 * (2 * tc16_ + (tp_ >> 1)) + 8 * (tp_ & 1);
    LAS float* Nv = (LAS float*)(lds + L_N); LAS float* QN = (LAS float*)(lds + L_QN); LAS float* RS = (LAS float*)(lds + L_RS); LAS float* RK = (LAS float*)(lds + L_RK);
#define GB(buf) ((LAS float*)(lds + L_G + (buf) * GSTRIDE))
#define ML_BAR() asm volatile("s_waitcnt lgkmcnt(0)\n\ts_barrier" ::: "memory")
    v4u pfA[5], pfB[5]; unsigned rkA = 0u, rkB = 0u;
    const int crow_ = tid >> 4, cch = tid & 15, crow8 = tid >> 3, cch8 = tid & 7;
    const float* rkl = rkg + (tid & 127);
#define ALOAD4(r, p) asm volatile("global_load_dwordx4 %0, %1, off" : "=&v"(r) : "v"(p) : "memory")
#define ALOAD1(r, p) asm volatile("global_load_dword %0, %1, off" : "=&v"(r) : "v"(p) : "memory")
#define TILE_LOAD(c, pf, rk) do { const bf16* ga_ = imgA + (size_t)(c) * 16384; \
        ALOAD4(pf[0], ga_); ALOAD4(pf[1], ga_ + 4096); ALOAD4(pf[2], ga_ + 8192); ALOAD4(pf[3], ga_ + 12288); \
        ALOAD4(pf[4], vsrc + (size_t)(c) * 64 * 512); ALOAD1(rk, rkl + (c) * 128); } while (0)
#define TILE_WAIT(N, pf, rk) asm volatile("s_waitcnt vmcnt(" #N ")" : "+v"(pf[0]), "+v"(pf[1]), "+v"(pf[2]), "+v"(pf[3]), "+v"(pf[4]), "+v"(rk) : : "memory")
#define KSWZ(row) ((((row) & 3) << 2) | (((row) >> 2) & 3))
#define TILE_WRITE(pf, rk) do { \
        *(LAS v4u*)(Qs + crow_ * QP + cch * 8) = pf[0]; *(LAS v4u*)(Qs + (crow_ + 32) * QP + cch * 8) = pf[1]; \
        *(LAS v4u*)(KsB + 256 * crow_ + 16 * (cch ^ KSWZ(crow_))) = pf[2]; *(LAS v4u*)(KsB + 256 * (crow_ + 32) + 16 * (cch ^ KSWZ(crow_))) = pf[3];     \
        *(LAS v4u*)(VsB + 1024 * (crow8 >> 3) + 512 * (cch8 >> 2) + 64 * (crow8 & 7) + 16 * (cch8 & 3)) = pf[4]; \
        if (tid < 128) RK[tid] = __builtin_bit_cast(float, rk); } while (0)
#define TRF(p0_) tr_frag((p0_), (p0_) + 256)
    float Mc = 0.f;
    LAS float* BPL = (LAS float*)(lds + L_BPL);
#define GATE_SCAN(c, buf) do { LAS float* o_ = GB(buf); const float gb_b = BPL[((c) * 64 + lane) * 2], gb_p = BPL[((c) * 64 + lane) * 2 + 1]; \
        const float P_ = scan_max(gb_p, lane); const float gg_ = __shfl(gb_b, 63), Pm_ = __shfl(P_, 63); \
        const float mt_ = gb_b + fmaxf(Mc, P_); const float al_ = gb_b - mt_; const float Mn_ = gg_ + fmaxf(Mc, Pm_); \
        o_[lane] = __expf(al_); o_[64 + lane] = __expf(al_ + Mc); o_[128 + lane] = __expf(-mt_); \
        if (lane == 0) { o_[192] = __expf(gg_ + Mc - Mn_); o_[193] = __expf(gg_ - Mn_); } Mc = Mn_; } while (0)

    f32x16 C;
#pragma unroll
    for (int r = 0; r < 16; ++r) C[r] = 0.f;
    const int dq = wave & 3, eh2 = wave >> 2;
    const int kch_ = 4 * dq + 2 * tc16_ + (tp_ >> 1);
    const int kt0 = 256 * (8 * g + tq_) + 16 * (kch_ ^ ((tq_ << 2) | (2 * g))) + 8 * (tp_ & 1), kt1 = 256 * (8 * g + 4 + tq_) + 16 * (kch_ ^ ((tq_ << 2) | (2 * g + 1))) + 8 * (tp_ & 1);
    for (int i = tid; i < 64 * QP / 2; i += 512) ((LAS unsigned*)CT)[i] = 0u;
    if (tid < 128) Nv[tid] = 0.f;
#pragma unroll
    for (int k = 0; k < 4; ++k) *(LAS f32x4*)(BPL + (tid + 512 * k) * 4) = *(const f32x4*)(bp + (tid + 512 * k) * 4);
    asm volatile("s_waitcnt vmcnt(0)" ::: "memory");
    TILE_LOAD(0, pfA, rkA); TILE_WAIT(0, pfA, rkA); TILE_WRITE(pfA, rkA);
    TILE_LOAD(1, pfB, rkB); TILE_LOAD(2, pfA, rkA);
    __syncthreads();
    if (wave == 4) GATE_SCAN(0, 0);
    __syncthreads();

    for (int c2 = 0; c2 < 64; c2 += 2) {
        { const int c = c2; const int cur = c & 1; LAS float* gb = GB(cur);
        if (wave == 4 && c + 1 < 64) GATE_SCAN(c + 1, cur ^ 1);
        { const int t = tid >> 3, d0 = (tid & 7) * 16; float s = 0.f;
#pragma unroll
          for (int k = 0; k < 2; ++k) { const v4u q8 = *(const LAS v4u*)(Qs + t * QP + d0 + 8 * k); const f32x4 n0 = *(const LAS f32x4*)(Nv + d0 + 8 * k), n1 = *(const LAS f32x4*)(Nv + d0 + 8 * k + 4);
              s += bflo(q8.x) * n0[0] + bfhi(q8.x) * n0[1] + bflo(q8.y) * n0[2] + bfhi(q8.y) * n0[3] + bflo(q8.z) * n1[0] + bfhi(q8.z) * n1[1] + bflo(q8.w) * n1[2] + bfhi(q8.w) * n1[3]; }
          s += __shfl_xor(s, 1); s += __shfl_xor(s, 2); s += __shfl_xor(s, 4);
          if ((tid & 7) == 0) QN[t] = s; }
        f32x16 acc;
#pragma unroll
        for (int r = 0; r < 16; ++r) acc[r] = 0.f;
        const int th = (wave & 3) >> 1, xh = wave & 1;
        const int t = 32 * th + l31;
        if (wave < 4) {
#pragma unroll
            for (int kk = 0; kk < 8; ++kk) { const bf16x8 av = *(const LAS bf16x8*)(KsB + 256 * (32 * xh + l31) + 16 * ((2 * kk + g) ^ KSWZ(l31))), bv = *(const LAS bf16x8*)(Qs + t * QP + kk * 16 + 8 * g);
                acc = __builtin_amdgcn_mfma_f32_32x32x16_bf16(av, bv, acc, 0, 0, 0); }
            const float ea = gb[t]; float rsum = 0.f;
#pragma unroll
            for (int i = 0; i < 4; ++i) { float wv[4];
#pragma unroll
                for (int e = 0; e < 4; ++e) { const int s = 32 * xh + 8 * i + 4 * g + e; wv[e] = (s <= t) ? acc[4 * i + e] * ea : 0.f; rsum += wv[e]; }
                v2u w2; w2.x = pk2(wv[0], wv[1]); w2.y = pk2(wv[2], wv[3]); *(LAS v2u*)(Ws + t * SP + 32 * xh + 8 * i + 4 * g) = w2; }
            rsum += __shfl_xor(rsum, 32);
            if (g == 0) RS[xh * 64 + t] = rsum;
        } else {
#pragma unroll
            for (int kk = 0; kk < 8; ++kk) { const bf16x8 av = *(const LAS bf16x8*)(CT + (32 * xh + l31) * QP + kk * 16 + 8 * g), bv = *(const LAS bf16x8*)(Qs + t * QP + kk * 16 + 8 * g);
                acc = __builtin_amdgcn_mfma_f32_32x32x16_bf16(av, bv, acc, 0, 0, 0); }
            const float ei = gb[64 + t];
#pragma unroll
            for (int r = 0; r < 16; ++r) acc[r] *= ei;
        }
        ML_BAR();
        if (wave >= 4) {
#pragma unroll
            for (int kk = 0; kk < 4; ++kk) { const bf16x8 av = TRF(VsB + vtrb + 2048 * kk + 512 * xh), bv = *(const LAS bf16x8*)(Ws + t * SP + kk * 16 + 8 * g);
                acc = __builtin_amdgcn_mfma_f32_32x32x16_bf16(av, bv, acc, 0, 0, 0); }
            const float den = gb[64 + t] * QN[t] + RS[t] + RS[64 + t];
            const float inv = 1.0f / fmaxf(fabsf(den), gb[128 + t]);
            bf16* hp = h_base + (size_t)(c * 64 + t) * 512 + 32 * xh + 4 * g;
#pragma unroll
            for (int i = 0; i < 4; ++i) { v2u o; o.x = pk2(acc[4 * i] * inv, acc[4 * i + 1] * inv); o.y = pk2(acc[4 * i + 2] * inv, acc[4 * i + 3] * inv); *(v2u*)(hp + 8 * i) = o; }
        }
        const float decay = gb[192], ff = gb[193];
        { f32x16 P;
#pragma unroll
          for (int r = 0; r < 16; ++r) P[r] = 0.f;
#pragma unroll
          for (int kk = 0; kk < 4; ++kk) { const bf16x8 av = tr_frag(KsB + kt0 + 4096 * kk, KsB + kt1 + 4096 * kk), bv = TRF(VsB + vtrb + 2048 * kk + 512 * eh2);
              P = __builtin_amdgcn_mfma_f32_32x32x16_bf16(av, bv, P, 0, 0, 0); }
#pragma unroll
          for (int r = 0; r < 16; ++r) C[r] = decay * C[r] + ff * P[r]; }
        float nnew = 0.f;
        if (tid < 128) nnew = decay * Nv[tid] + ff * RK[tid];
        ML_BAR();
#pragma unroll
        for (int i = 0; i < 4; ++i) { v2u o; o.x = pk2(C[4 * i], C[4 * i + 1]); o.y = pk2(C[4 * i + 2], C[4 * i + 3]); *(LAS v2u*)(CT + (32 * eh2 + l31) * QP + 32 * dq + 8 * i + 4 * g) = o; }
        if (tid < 128) Nv[tid] = nnew;
        if (c + 1 < 64) { if (c + 2 < 64) TILE_WAIT(6, pfB, rkB); else TILE_WAIT(0, pfB, rkB); TILE_WRITE(pfB, rkB); }
        if (c + 3 < 64) TILE_LOAD(c + 3, pfB, rkB);
        ML_BAR();
                }
        { const int c = c2 + 1; const int cur = c & 1; LAS float* gb = GB(cur);
        if (wave == 4 && c + 1 < 64) GATE_SCAN(c + 1, cur ^ 1);
        { const int t = tid >> 3, d0 = (tid & 7) * 16; float s = 0.f;
#pragma unroll
          for (int k = 0; k < 2; ++k) { const v4u q8 = *(const LAS v4u*)(Qs + t * QP + d0 + 8 * k); const f32x4 n0 = *(const LAS f32x4*)(Nv + d0 + 8 * k), n1 = *(const LAS f32x4*)(Nv + d0 + 8 * k + 4);
              s += bflo(q8.x) * n0[0] + bfhi(q8.x) * n0[1] + bflo(q8.y) * n0[2] + bfhi(q8.y) * n0[3] + bflo(q8.z) * n1[0] + bfhi(q8.z) * n1[1] + bflo(q8.w) * n1[2] + bfhi(q8.w) * n1[3]; }
          s += __shfl_xor(s, 1); s += __shfl_xor(s, 2); s += __shfl_xor(s, 4);
          if ((tid & 7) == 0) QN[t] = s; }
        f32x16 acc;
#pragma unroll
        for (int r = 0; r < 16; ++r) acc[r] = 0.f;
        const int th = (wave & 3) >> 1, xh = wave & 1;
        const int t = 32 * th + l31;
        if (wave < 4) {
#pragma unroll
            for (int kk = 0; kk < 8; ++kk) { const bf16x8 av = *(const LAS bf16x8*)(KsB + 256 * (32 * xh + l31) + 16 * ((2 * kk + g) ^ KSWZ(l31))), bv = *(const LAS bf16x8*)(Qs + t * QP + kk * 16 + 8 * g);
                acc = __builtin_amdgcn_mfma_f32_32x32x16_bf16(av, bv, acc, 0, 0, 0); }
            const float ea = gb[t]; float rsum = 0.f;
#pragma unroll
            for (int i = 0; i < 4; ++i) { float wv[4];
#pragma unroll
                for (int e = 0; e < 4; ++e) { const int s = 32 * xh + 8 * i + 4 * g + e; wv[e] = (s <= t) ? acc[4 * i + e] * ea : 0.f; rsum += wv[e]; }
                v2u w2; w2.x = pk2(wv[0], wv[1]); w2.y = pk2(wv[2], wv[3]); *(LAS v2u*)(Ws + t * SP + 32 * xh + 8 * i + 4 * g) = w2; }
            rsum += __shfl_xor(rsum, 32);
            if (g == 0) RS[xh * 64 + t] = rsum;
        } else {
#pragma unroll
            for (int kk = 0; kk < 8; ++kk) { const bf16x8 av = *(const LAS bf16x8*)(CT + (32 * xh + l31) * QP + kk * 16 + 8 * g), bv = *(const LAS bf16x8*)(Qs + t * QP + kk * 16 + 8 * g);
                acc = __builtin_amdgcn_mfma_f32_32x32x16_bf16(av, bv, acc, 0, 0, 0); }
            const float ei = gb[64 + t];
#pragma unroll
            for (int r = 0; r < 16; ++r) acc[r] *= ei;
        }
        ML_BAR();
        if (wave >= 4) {
#pragma unroll
            for (int kk = 0; kk < 4; ++kk) { const bf16x8 av = TRF(VsB + vtrb + 2048 * kk + 512 * xh), bv = *(const LAS bf16x8*)(Ws + t * SP + kk * 16 + 8 * g);
                acc = __builtin_amdgcn_mfma_f32_32x32x16_bf16(av, bv, acc, 0, 0, 0); }
            const float den = gb[64 + t] * QN[t] + RS[t] + RS[64 + t];
            const float inv = 1.0f / fmaxf(fabsf(den), gb[128 + t]);
            bf16* hp = h_base + (size_t)(c * 64 + t) * 512 + 32 * xh + 4 * g;
#pragma unroll
            for (int i = 0; i < 4; ++i) { v2u o; o.x = pk2(acc[4 * i] * inv, acc[4 * i + 1] * inv); o.y = pk2(acc[4 * i + 2] * inv, acc[4 * i + 3] * inv); *(v2u*)(hp + 8 * i) = o; }
        }
        const float decay = gb[192], ff = gb[193];
        { f32x16 P;
#pragma unroll
          for (int r = 0; r < 16; ++r) P[r] = 0.f;
#pragma unroll
          for (int kk = 0; kk < 4; ++kk) { const bf16x8 av = tr_frag(KsB + kt0 + 4096 * kk, KsB + kt1 + 4096 * kk), bv = TRF(VsB + vtrb + 2048 * kk + 512 * eh2);
              P = __builtin_amdgcn_mfma_f32_32x32x16_bf16(av, bv, P, 0, 0, 0); }
#pragma unroll
          for (int r = 0; r < 16; ++r) C[r] = decay * C[r] + ff * P[r]; }
        float nnew = 0.f;
        if (tid < 128) nnew = decay * Nv[tid] + ff * RK[tid];
        ML_BAR();
#pragma unroll
        for (int i = 0; i < 4; ++i) { v2u o; o.x = pk2(C[4 * i], C[4 * i + 1]); o.y = pk2(C[4 * i + 2], C[4 * i + 3]); *(LAS v2u*)(CT + (32 * eh2 + l31) * QP + 32 * dq + 8 * i + 4 * g) = o; }
        if (tid < 128) Nv[tid] = nnew;
        if (c + 1 < 64) { if (c + 2 < 64) TILE_WAIT(6, pfA, rkA); else TILE_WAIT(0, pfA, rkA); TILE_WRITE(pfA, rkA); }
        if (c + 3 < 64) TILE_LOAD(c + 3, pfA, rkA);
        ML_BAR();
                }
    }
    asm volatile("s_waitcnt vmcnt(0)" ::: "memory");
#undef GB
#undef ML_BAR
#undef TILE_LOAD
#undef TILE_WRITE
#undef TILE_WAIT
#undef KSWZ
#undef TRF
#undef ALOAD4
#undef ALOAD1
#undef GATE_SCAN
}

__device__ __forceinline__ unsigned xcc_id() { return (unsigned)__builtin_amdgcn_s_getreg((3 << 11) | 20) & 7u; }
__device__ __forceinline__ void mix_phase(const Args& a, unsigned char* lds_generic, LAS unsigned char* lds, int coff, bool do_ml, bool do_attn) {
    const int tid = __tid_l();
    unsigned* ctr = (unsigned*)(a.ws + WS_CTL) + coff * 64;
    volatile LAS int* MISC = (volatile LAS int*)(lds + MISC_OFF);
    const unsigned myx = xcc_id();
    const attn_body::bf16* Q = (const attn_body::bf16*)(a.ws + WS_Q); const attn_body::bf16* K = (const attn_body::bf16*)(a.ws + WS_K);
    const attn_body::bf16* V = (const attn_body::bf16*)(a.ws + WS_V); attn_body::bf16* AO = (attn_body::bf16*)(a.ws + WS_AO);
    if (do_ml) for (;;) {
        if (tid == 0) { int found = -1;
            const unsigned j0 = __hip_atomic_fetch_add(ctr + (8 + myx) * 64, 1u, __ATOMIC_RELAXED, __HIP_MEMORY_SCOPE_AGENT);
            if (j0 < 8u) found = (int)(myx * 8u + j0);
            else { unsigned cnt[7];
#pragma unroll
                for (unsigned dx = 1; dx < 8; ++dx) cnt[dx - 1] = __hip_atomic_load(ctr + (8 + ((myx + dx) & 7u)) * 64, __ATOMIC_RELAXED, __HIP_MEMORY_SCOPE_AGENT);
#pragma unroll
                for (unsigned dx = 1; dx < 8; ++dx) if (found < 0 && cnt[dx - 1] < 8u) { const unsigned x = (myx + dx) & 7u; const unsigned j = __hip_atomic_fetch_add(ctr + (8 + x) * 64, 1u, __ATOMIC_RELAXED, __HIP_MEMORY_SCOPE_AGENT);
                    if (j < 8u) found = (int)(x * 8u + j); } }
            MISC[0] = found; }
        __syncthreads();
        const int f = __builtin_amdgcn_readfirstlane(MISC[0]);
        __syncthreads();
        if (f < 0) break;
        mlstm_item(a, f, lds);
        __syncthreads();
    }
    if (do_attn) {
        if (tid == 0) { int found = -1;
            const unsigned j0 = __hip_atomic_fetch_add(ctr + myx * 64, 1u, __ATOMIC_RELAXED, __HIP_MEMORY_SCOPE_AGENT);
            if (j0 < 256u) found = (int)(myx * 256u + j0);
            else { unsigned cnt[7];
#pragma unroll
                for (unsigned dx = 1; dx < 8; ++dx) cnt[dx - 1] = __hip_atomic_load(ctr + ((myx + dx) & 7u) * 64, __ATOMIC_RELAXED, __HIP_MEMORY_SCOPE_AGENT);
#pragma unroll
                for (unsigned dx = 1; dx < 8; ++dx) if (found < 0 && cnt[dx - 1] < 256u) { const unsigned x = (myx + dx) & 7u; const unsigned j = __hip_atomic_fetch_add(ctr + x * 64, 1u, __ATOMIC_RELAXED, __HIP_MEMORY_SCOPE_AGENT);
                    if (j < 256u) found = (int)(x * 256u + j); } }
            MISC[0] = found; }
        __syncthreads();
        int f = __builtin_amdgcn_readfirstlane(MISC[0]);
        __syncthreads();
        while (f >= 0) {
            const int x = f >> 8, jj = f & 255, qb = 15 - ((jj & 63) >> 2), bh = x + 8 * ((jj >> 6) * 4 + (jj & 3)), b = bh >> 4, hp = bh & 15;
            unsigned nj = 0u;
            if (tid == 0) nj = __hip_atomic_fetch_add(ctr + x * 64, 1u, __ATOMIC_RELAXED, __HIP_MEMORY_SCOPE_AGENT);
            attn_body::attn_unit<8>(b, (hp >> 1) * 64, ((hp >> 2) * 2 + (hp & 1)) * 64, hp * 64, qb, Q, K, V, AO, (char*)lds_generic);
            if (tid == 0) { int found = -1;
                if (nj < 256u) found = x * 256 + (int)nj;
                else { unsigned cnt[7];
#pragma unroll
                    for (unsigned dx = 1; dx < 8; ++dx) cnt[dx - 1] = __hip_atomic_load(ctr + (((unsigned)x + dx) & 7u) * 64, __ATOMIC_RELAXED, __HIP_MEMORY_SCOPE_AGENT);
#pragma unroll
                    for (unsigned dx = 1; dx < 8; ++dx) if (found < 0 && cnt[dx - 1] < 256u) { const unsigned x2 = ((unsigned)x + dx) & 7u; const unsigned j = __hip_atomic_fetch_add(ctr + x2 * 64, 1u, __ATOMIC_RELAXED, __HIP_MEMORY_SCOPE_AGENT);
                        if (j < 256u) found = (int)(x2 * 256u + j); } }
                MISC[0] = found; }
            __syncthreads();
            f = __builtin_amdgcn_readfirstlane(MISC[0]);
            __syncthreads();
        }
    }
}

__device__ __forceinline__ void combine_phase(const Args& a) {
    const int tid = __tid_l(), lane = tid & 63, wave = __builtin_amdgcn_readfirstlane(tid >> 6), G = gridDim.x, bx = blockIdx.x;
    const bf16* AO = (const bf16*)(a.ws + WS_AO); const bf16* MLH = (const bf16*)(a.ws + WS_MLH); const bf16* MLO = (const bf16*)(a.ws + WS_MLO); bf16* Y = (bf16*)(a.ws + WS_HN);
    const float* lq = a.in[I_LAMQK];
    const float lam = __expf(wave_sum(lq[lane] * lq[64 + lane])) - __expf(wave_sum(lq[128 + lane] * lq[192 + lane])) + 0.2f;
    const int head = lane >> 4, vh = (lane >> 3) & 1, d = (lane & 7) * 8;
    float gda[8], gml[8];
#pragma unroll
    for (int i = 0; i < 8; ++i) { gda[i] = a.in[I_GDA][(lane & 15) * 8 + i] * 0.8f; gml[i] = a.in[I_GML][lane * 8 + i]; }
    const int gw = bx * 8 + wave, NGW = G * 8;
    for (int rb = gw; rb < TOK / 16; rb += NGW) {
#pragma unroll 4
        for (int r = 0; r < 16; ++r) {
            const size_t row = (size_t)rb * 16 + r;
            const v4u a0 = *(const v4u*)(AO + row * 1024 + ((head * 2 + 0) * 2 + vh) * 64 + d), a1 = *(const v4u*)(AO + row * 1024 + ((head * 2 + 1) * 2 + vh) * 64 + d);
            const v4u hh = *(const v4u*)(MLH + row * 512 + lane * 8), oo = *(const v4u*)(MLO + row * 512 + lane * 8);
            const unsigned a0w[4] = {a0.x, a0.y, a0.z, a0.w}, a1w[4] = {a1.x, a1.y, a1.z, a1.w}, hw[4] = {hh.x, hh.y, hh.z, hh.w}, ow[4] = {oo.x, oo.y, oo.z, oo.w};
            float o[8], hv[8], s1 = 0.f, s2 = 0.f;
#pragma unroll
            for (int i = 0; i < 4; ++i) { o[2 * i] = bflo(a0w[i]) - lam * bflo(a1w[i]); o[2 * i + 1] = bfhi(a0w[i]) - lam * bfhi(a1w[i]); hv[2 * i] = bflo(hw[i]); hv[2 * i + 1] = bfhi(hw[i]);
                s1 += o[2 * i] * o[2 * i] + o[2 * i + 1] * o[2 * i + 1]; s2 += hv[2 * i] * hv[2 * i] + hv[2 * i + 1] * hv[2 * i + 1]; }
#pragma unroll
            for (int m = 1; m < 16; m <<= 1) { s1 += __shfl_xor(s1, m); s2 += __shfl_xor(s2, m); }
            const float r1 = __builtin_amdgcn_rsqf(s1 * (1.0f / 128.0f) + 1e-6f), r2 = __builtin_amdgcn_rsqf(s2 * (1.0f / 128.0f) + 1e-6f);
            float y1[8], y2[8];
#pragma unroll
            for (int i = 0; i < 8; ++i) { const float op = (i & 1) ? bfhi(ow[i >> 1]) : bflo(ow[i >> 1]);
                y1[i] = o[i] * r1 * gda[i]; y2[i] = hv[i] * r2 * gml[i] * __builtin_amdgcn_rcpf(1.0f + __builtin_amdgcn_exp2f(-1.4426950408889634f * op)); }
            v4u w1, w2; w1.x = pk2(y1[0], y1[1]); w1.y = pk2(y1[2], y1[3]); w1.z = pk2(y1[4], y1[5]); w1.w = pk2(y1[6], y1[7]);
            w2.x = pk2(y2[0], y2[1]); w2.y = pk2(y2[2], y2[3]); w2.z = pk2(y2[4], y2[5]); w2.w = pk2(y2[6], y2[7]);
            *(v4u*)(Y + row * 1024 + lane * 8) = w1; *(v4u*)(Y + row * 1024 + 512 + lane * 8) = w2;
        }
    }
}

constexpr int N_PHASES = 13;
#ifndef DUP_MASK
#define DUP_MASK 0
#endif
__global__ void __launch_bounds__(512, 2) mk_fwd(Args a) {
    extern __shared__ __attribute__((aligned(16))) unsigned char lds_raw[];
    LAS unsigned char* lds = (LAS unsigned char*)lds_raw;
    cg::grid_group grid = cg::this_grid();
    { volatile LAS unsigned* M_ = (volatile LAS unsigned*)(lds + MISC_OFF); if (threadIdx.x < 32) M_[threadIdx.x] = 0u; __syncthreads(); }
    XcdBarrier xbar = xcd_barrier_post((unsigned*)(a.ws + WS_CTL) + 4096, (volatile LAS unsigned*)(lds + MISC_OFF) + 8);
    if (a.ph_lo < 0) grid.sync();
    const int lo = a.ph_lo, hi = a.ph_hi, G = gridDim.x, bx = blockIdx.x;
    unsigned char* ws = a.ws;
    const float* mod = (const float*)(ws + WS_MOD);
    bf16* HN = (bf16*)(ws + WS_HN); bf16* HID = (bf16*)(ws + WS_HID);
    bf16* X1 = (bf16*)a.out;
    bf16* X2 = (bf16*)(ws + WS_MLV);
#define IN(k) (lo <= (k) && (k) < hi)
#define REP(k) for (int rep_ = 0; rep_ <= ((DUP_MASK >> (k)) & 1); ++rep_)
#define RSYNC() do { if (rep_) xcd_barrier(xbar); } while (0)
#define SEAM(k) do { if (IN(k) && IN((k) + 1)) xcd_barrier(xbar); } while (0)
    if (IN(0)) REP(0) { RSYNC(); p0_prologue(a, lds); } SEAM(0);
    if (DUP_MASK & 0x4000) { for (int i_ = 0; i_ < 10; ++i_) xcd_barrier(xbar); }
    if (IN(1)) REP(1) { RSYNC(); norm_phase<false, false>(a, a.in[I_X], 0, lds); } SEAM(1);
    if (IN(2)) REP(2) { RSYNC(); pg8::Gemm g{HN, (const bf16*)(ws + WS_W12A), TOK, 2 * FF, DM}; pg8::StaticOrder S; S.init(TOK, 2 * FF, G, bx);
        pg8::EpiSwiGLU E{HID, FF}; pg8::gemm_phase<pg8::EpiSwiGLU, pg8::StaticOrder, true, true>(lds, g, S, E); } SEAM(2);
    if (IN(3)) REP(3) { RSYNC(); pg8::Gemm g{HID, (const bf16*)(ws + WS_W3A), TOK, DM, FF}; pg8::StaticOrder S; S.init(TOK, DM, G, bx);
        pg8::EpiResid<0, 1> E{a.in[I_X], X1, mod + 2 * 1024, 0.5f}; pg8::gemm_phase<pg8::EpiResid<0, 1>, pg8::StaticOrder, true, true>(lds, g, S, E); } SEAM(3);
    if (IN(4)) REP(4) { RSYNC(); norm_phase<true, true>(a, X1, 1, lds); } SEAM(4);
    if (IN(5)) REP(5) { RSYNC(); pg8::Gemm g{HN, (const bf16*)(ws + WS_WIN), TOK, NINP, DM}; pg8::StaticOrder S; S.init(TOK, NINP, G, bx);
        pg8::EpiMix E{(bf16*)(ws + WS_Q), (bf16*)(ws + WS_K), (bf16*)(ws + WS_V), (bf16*)(ws + WS_MLQK), (bf16*)(ws + WS_MLV), (bf16*)(ws + WS_MLO), a.in[I_GQ], a.in[I_GK], (const float*)(ws + WS_ROPE), C2Q};
        pg8::gemm_phase<pg8::EpiMix, pg8::StaticOrder, true, true>(lds, g, S, E); } SEAM(5);
    if (IN(6)) REP(6) { RSYNC(); mlprep_phase(a, lds); } SEAM(6);
    if (IN(7)) { mix_phase(a, lds_raw, lds, 0, true, true); if (DUP_MASK & 0x80) { xcd_barrier(xbar); mix_phase(a, lds_raw, lds, 16, true, true); } if (DUP_MASK & 0x1000) { xcd_barrier(xbar); mix_phase(a, lds_raw, lds, 32, true, false); } if (DUP_MASK & 0x2000) { xcd_barrier(xbar); mix_phase(a, lds_raw, lds, 48, false, true); } } SEAM(7);
    if (IN(8)) REP(8) { RSYNC(); combine_phase(a); } SEAM(8);
    if (IN(9)) { pg8::Gemm g{HN, (const bf16*)(ws + WS_WOUT), TOK, DM, DM}; pg8::StaticOrder S; S.init(TOK, DM, G, bx);
        pg8::EpiResidXg E{X1, X2, mod + 5 * 1024, 1.0f, (bf16*)(ws + WS_XG3), a.in[I_GNORM] + 2048, mod + 7 * 1024, (float*)(ws + WS_RSS)}; pg8::gemm_phase<pg8::EpiResidXg, pg8::StaticOrder, true, true>(lds, g, S, E); } SEAM(9);
    if (IN(11)) REP(11) { RSYNC(); pg8::Gemm g{(const bf16*)(ws + WS_XG3), (const bf16*)(ws + WS_W12B), TOK, 2 * FF, DM}; pg8::StaticOrder S; S.init(TOK, 2 * FF, G, bx);
        pg8::EpiSwiGLUN E{HID, FF, (const float*)(ws + WS_RSS), (const float*)(ws + WS_SB3), 2 * FF}; pg8::gemm_phase<pg8::EpiSwiGLUN, pg8::StaticOrder, true, true>(lds, g, S, E); } SEAM(11);
    if (IN(12)) { pg8::Gemm g{HID, (const bf16*)(ws + WS_W3B), TOK, DM, FF}; pg8::StaticOrder S; S.init(TOK, DM, G, bx);
        pg8::EpiResid<1, 0> E{X2, a.out, mod + 8 * 1024, 0.5f}; pg8::gemm_phase<pg8::EpiResid<1, 0>, pg8::StaticOrder, true, true>(lds, g, S, E); }
#undef IN
#undef SEAM
}

#ifndef MK_MULTI
#define MK_MULTI 0
#endif
extern "C" void kernel_launch(void* const* d_in, const int* in_sizes, int n_in, void* d_out, int out_size, void* d_ws, size_t ws_size, hipStream_t stream) {
    static int grid = 0;
    if (grid == 0) {
        if (n_in != 20 || out_size != TOK * DM || ws_size < WS_END) { fprintf(stderr, "kernel_launch: unexpected shapes (n_in %d out %d ws %zu)\n", n_in, out_size, ws_size); grid = -1; return; }
        int dev = 0, cus = 0, per_cu = 0;
        hipGetDevice(&dev); hipDeviceGetAttribute(&cus, hipDeviceAttributeMultiprocessorCount, dev);
        if (hipFuncSetAttribute((const void*)mk_fwd, hipFuncAttributeMaxDynamicSharedMemorySize, LDS_BYTES) != hipSuccess) { fprintf(stderr, "kernel_launch: hipFuncSetAttribute failed\n"); grid = -1; return; }
        hipOccupancyMaxActiveBlocksPerMultiprocessor(&per_cu, (const void*)mk_fwd, 512, LDS_BYTES);
        (void)hipGetLastError();
        if (per_cu < 1) fprintf(stderr, "kernel_launch: occupancy query says %d blocks per CU\n", per_cu);
        grid = cus > 0 ? cus : 256;
    }
    if (grid < 0) return;
    if (hipMemsetAsync((char*)d_ws + WS_CTL, 0, 32768, stream) != hipSuccess) { fprintf(stderr, "kernel_launch: hipMemsetAsync failed\n"); return; }
    Args a{};
    for (int i = 0; i < 20; ++i) a.in[i] = (const float*)d_in[i];
    a.out = (float*)d_out; a.ws = (unsigned char*)d_ws;
#if MK_MULTI
    for (int p = 0; p < N_PHASES; ++p) { a.ph_lo = p; a.ph_hi = p + 1; hipLaunchKernelGGL(mk_fwd, dim3(grid), dim3(512), LDS_BYTES, stream, a); }
#else
    a.ph_lo = 0; a.ph_hi = N_PHASES;
    void* args[] = {&a};
    hipError_t e = hipLaunchCooperativeKernel((const void*)mk_fwd, dim3(grid), dim3(512), args, LDS_BYTES, stream);
    if (e != hipSuccess) fprintf(stderr, "kernel_launch: cooperative launch failed: %s (grid %d)\n", hipGetErrorString(e), grid);
#endif
}
```
